# Optimizing an MI355X kernel written in HIP

```python
import functools
import jax, jax.numpy as jnp
from jax import lax
import numpy as np

D_MODEL = 2048
BATCH = 2
SEQ = 4096
DEPTH = 4
DEC_BATCH = 8
DEC_SEQ = 8
PAST_LEN = 16384
PAGE_SIZE = 128

N_EVEN = (DEPTH + 1) // 2
N_ODD = DEPTH // 2
D_ATTN = D_MODEL // 2
HEAD_DIM = 128
N_HEADS = D_ATTN // HEAD_DIM
PATTERNS = ((128, 1), (512, 4), (2048, 16))
WINDOW_MAX = max(w for w, _ in PATTERNS)
Q_BLOCK = 128
ROPE_THETA = 10000.0
D_POOL = D_MODEL // 2
POOL_WINDOWS = (2, 4, 8, 16)
N_POOL_GROUPS = len(POOL_WINDOWS)
POOL_GROUP = D_POOL // N_POOL_GROUPS
POOL_MAX = max(POOL_WINDOWS)
D_CONV = D_MODEL
CONV_WIDTH = 3
EVEN_SPLITS = (D_ATTN, 2 * D_ATTN, 3 * D_ATTN, 4 * D_ATTN, 4 * D_ATTN + D_POOL)
D_IN_EVEN = 4 * D_ATTN + 2 * D_POOL
D_IN_ODD = 4 * D_CONV
RMS_EPS = 1e-6
NEG_INF = -1e30

kernel_name = 'hybrid_dilated_pool_shortconv_decoder_step'


def rms_norm(x, g):
    xf = x.astype(jnp.float32)
    y = xf * lax.rsqrt(jnp.mean(xf * xf, axis=-1, keepdims=True) + RMS_EPS)
    return (y * g.astype(jnp.float32)).astype(x.dtype)


def ada_modulation(c, w, b):
    m = jax.nn.silu(c) @ w + b
    shift, scale, gate = jnp.split(m[:, None, :], 3, axis=-1)
    return shift, scale, gate


def rotary(x, pos):
    half = HEAD_DIM // 2
    inv = jnp.power(ROPE_THETA, -jnp.arange(half, dtype=jnp.float32) / half)
    ang = pos.astype(jnp.float32)[:, None] * inv[None, :]
    cos = jnp.cos(ang)[None, :, None, :]
    sin = jnp.sin(ang)[None, :, None, :]
    xf = x.astype(jnp.float32)
    x1, x2 = xf[..., :half], xf[..., half:]
    return jnp.concatenate([x1 * cos - x2 * sin, x2 * cos + x1 * sin], axis=-1).astype(x.dtype)


def dilated_attention(q, k_ext, v_ext, n_prefix):
    b, t = q.shape[0], q.shape[1]
    qb = Q_BLOCK if t % Q_BLOCK == 0 else t
    scale = HEAD_DIM ** -0.5
    kf = k_ext.astype(jnp.float32)
    vf = v_ext.astype(jnp.float32)

    def block(i):
        qs = lax.dynamic_slice_in_dim(q, i * qb, qb, axis=1).astype(jnp.float32) * scale
        e = n_prefix + i * qb + jnp.arange(qb, dtype=jnp.int32)
        ms, dens, nums = [], [], []
        for w, d in PATTERNS:
            idx = e[:, None] - d * jnp.arange(w // d + 1, dtype=jnp.int32)[None, :]
            valid = idx >= 0
            idx = jnp.maximum(idx, 0)
            kg = kf[:, idx]
            vg = vf[:, idx]
            s = jnp.einsum('bqhd,bqjhd->bhqj', qs, kg)
            s = jnp.where(valid[None, None], s, NEG_INF)
            m = jnp.max(s, axis=-1, keepdims=True)
            p = jnp.exp(s - m)
            ms.append(m)
            dens.append(jnp.sum(p, axis=-1, keepdims=True))
            nums.append(jnp.einsum('bhqj,bqjhd->bhqd', p, vg))
        m_all = functools.reduce(jnp.maximum, ms)
        a = [jnp.exp(m - m_all) for m in ms]
        num = a[0] * nums[0]
        den = a[0] * dens[0]
        for ai, ni, di in zip(a[1:], nums[1:], dens[1:]):
            num = num + ai * ni
            den = den + ai * di
        return jnp.transpose(num / den, (0, 2, 1, 3))

    out = lax.map(block, jnp.arange(t // qb, dtype=jnp.int32))
    out = jnp.transpose(out, (1, 0, 2, 3, 4)).reshape(b, t, N_HEADS * HEAD_DIM)
    return out.astype(q.dtype)


def pool_mixer(u, prefix, pos, pool_w, pool_scale):
    b, t = u.shape[0], u.shape[1]
    npre = POOL_MAX - 1
    ext = jnp.concatenate([prefix, u], axis=1).astype(jnp.float32)
    cs = jnp.concatenate([jnp.zeros((b, 1, D_POOL), jnp.float32), jnp.cumsum(ext, axis=1)], axis=1)
    uf = u.astype(jnp.float32)
    outs = []
    for gi, w in enumerate(POOL_WINDOWS):
        lo, hi = gi * POOL_GROUP, (gi + 1) * POOL_GROUP
        win_sum = cs[:, npre + 1:npre + 1 + t, lo:hi] - cs[:, npre + 1 - w:npre + 1 - w + t, lo:hi]
        cnt = jnp.minimum(w, pos + 1).astype(jnp.float32)[None, :, None]
        outs.append(win_sum / cnt - uf[..., lo:hi])
    pooled = jnp.stack(outs, axis=2)
    mixed = jnp.einsum('btgc,gcd->btgd', pooled, pool_w.astype(jnp.float32)).reshape(b, t, D_POOL)
    return (mixed * pool_scale.astype(jnp.float32)).astype(u.dtype)


def short_conv(z, prefix, conv_w):
    t = z.shape[1]
    ext = jnp.concatenate([prefix, z], axis=1)
    y = ext[:, 0:t] * conv_w[0]
    for kk in range(1, CONV_WIDTH):
        y = y + ext[:, kk:kk + t] * conv_w[kk]
    return y, ext[:, -(CONV_WIDTH - 1):]


def run_trunk(x, c, pos, win_k, win_v, pool_st, conv_st, ada_w, ada_b, norm_g, w_in_even,
              w_out_even, pool_w, pool_scale, w_in_odd, conv_w, w_out_odd, final_g):
    b, t = x.shape[0], x.shape[1]
    fresh = win_k is None
    new_k, new_v, new_pool, new_conv = [], [], [], []
    for layer in range(DEPTH):
        shift, scale, gate = ada_modulation(c, ada_w[layer], ada_b[layer])
        h = rms_norm(x, norm_g[layer]) * (1 + scale) + shift
        li = layer // 2
        if layer % 2 == 0:
            q, k, v, g_a, u, g_p = jnp.split(h @ w_in_even[li], EVEN_SPLITS, axis=-1)
            q = rotary(q.reshape(b, t, N_HEADS, HEAD_DIM), pos)
            k = rotary(k.reshape(b, t, N_HEADS, HEAD_DIM), pos)
            v = v.reshape(b, t, N_HEADS, HEAD_DIM)
            if fresh:
                k_ext, v_ext, n_prefix = k, v, 0
                keep = min(WINDOW_MAX, t)
                new_k.append(k[:, t - keep:])
                new_v.append(v[:, t - keep:])
                pool_prefix = jnp.zeros((b, POOL_MAX - 1, D_POOL), u.dtype)
            else:
                k_ext = jnp.concatenate([win_k[li], k], axis=1)
                v_ext = jnp.concatenate([win_v[li], v], axis=1)
                n_prefix = win_k.shape[2]
                new_k.append(k)
                new_v.append(v)
                pool_prefix = pool_st[li]
            attn = dilated_attention(q, k_ext, v_ext, n_prefix)
            pooled = pool_mixer(u, pool_prefix, pos, pool_w[li], pool_scale[li])
            new_pool.append(jnp.concatenate([pool_prefix, u], axis=1)[:, -(POOL_MAX - 1):])
            merged = jnp.concatenate([attn * jax.nn.silu(g_a), pooled * jax.nn.silu(g_p)], axis=-1)
            mix = merged @ w_out_even[li]
        else:
            bg, cg, hh, g = jnp.split(h @ w_in_odd[li], 4, axis=-1)
            z = cg * hh
            prefix = jnp.zeros((b, CONV_WIDTH - 1, D_CONV), z.dtype) if fresh else conv_st[li]
            yc, tail = short_conv(z, prefix, conv_w[li])
            new_conv.append(tail)
            mix = (bg * yc * jax.nn.silu(g)) @ w_out_odd[li]
        x = x + gate * mix
    return (rms_norm(x, final_g), jnp.stack(new_k), jnp.stack(new_v),
            jnp.stack(new_pool), jnp.stack(new_conv))


def setup_inputs(seed: int = 0) -> dict:
    key = jax.random.key(seed)
    ks = jax.random.split(key, 20)
    f32 = jnp.float32
    wbuf = min(WINDOW_MAX, PAST_LEN)
    nrm = lambda k, s: jax.random.normal(k, s, f32)
    return {
        'x_prompt': nrm(ks[0], (BATCH, SEQ, D_MODEL)),
        'x_sample': nrm(ks[1], (DEC_BATCH, DEC_SEQ, D_MODEL)),
        'c_prompt': nrm(ks[2], (BATCH, D_MODEL)),
        'c_sample': nrm(ks[3], (DEC_BATCH, D_MODEL)),
        'state_win_k': nrm(ks[4], (N_EVEN, DEC_BATCH, wbuf, N_HEADS, HEAD_DIM)),
        'state_win_v': nrm(ks[5], (N_EVEN, DEC_BATCH, wbuf, N_HEADS, HEAD_DIM)),
        'state_pool': nrm(ks[6], (N_EVEN, DEC_BATCH, POOL_MAX - 1, D_POOL)),
        'state_conv': nrm(ks[7], (N_ODD, DEC_BATCH, CONV_WIDTH - 1, D_CONV)),
        'ada_w': nrm(ks[8], (DEPTH, D_MODEL, 3 * D_MODEL)) * (0.5 * D_MODEL ** -0.5),
        'ada_b': nrm(ks[9], (DEPTH, 3 * D_MODEL)) * 0.02,
        'norm_g': 1.0 + 0.02 * nrm(ks[10], (DEPTH, D_MODEL)),
        'w_in_even': nrm(ks[11], (N_EVEN, D_MODEL, D_IN_EVEN)) * D_MODEL ** -0.5,
        'w_out_even': nrm(ks[12], (N_EVEN, D_ATTN + D_POOL, D_MODEL)) * (D_ATTN + D_POOL) ** -0.5,
        'pool_w': nrm(ks[13], (N_EVEN, N_POOL_GROUPS, POOL_GROUP, POOL_GROUP)) * POOL_GROUP ** -0.5,
        'pool_scale': 1.0 + 0.1 * nrm(ks[14], (N_EVEN, D_POOL)),
        'w_in_odd': nrm(ks[15], (N_ODD, D_MODEL, D_IN_ODD)) * D_MODEL ** -0.5,
        'conv_w': nrm(ks[16], (N_ODD, CONV_WIDTH, D_CONV)) * CONV_WIDTH ** -0.5,
        'w_out_odd': nrm(ks[17], (N_ODD, D_CONV, D_MODEL)) * D_CONV ** -0.5,
        'final_g': 1.0 + 0.02 * nrm(ks[18], (D_MODEL,)),
    }


def reference(x_prompt, x_sample, c_prompt, c_sample, state_win_k, state_win_v, state_pool,
              state_conv, ada_w, ada_b, norm_g, w_in_even, w_out_even, pool_w, pool_scale,
              w_in_odd, conv_w, w_out_odd, final_g):
    params = (ada_w, ada_b, norm_g, w_in_even, w_out_even, pool_w, pool_scale,
              w_in_odd, conv_w, w_out_odd, final_g)
    pos_p = jnp.arange(x_prompt.shape[1], dtype=jnp.int32)
    pos_s = PAST_LEN + jnp.arange(x_sample.shape[1], dtype=jnp.int32)
    y_prompt, kp, vp, poolp, convp = run_trunk(x_prompt, c_prompt, pos_p, None, None, None, None, *params)
    y_sample, ksm, vsm, pools, convs = run_trunk(x_sample, c_sample, pos_s, state_win_k, state_win_v,
                                                 state_pool, state_conv, *params)
    return (y_prompt, y_sample, kp, vp, poolp, convp, ksm, vsm, pools, convs)
```

```cpp
#include <hip/hip_runtime.h>
#include <cstdio>
#include <cstdint>
#include <cmath>

constexpr int DM = 2048, NB_P = 2, T_P = 4096, NB_S = 8, T_S = 8, DEPTH = 4;
constexpr int D_ATTN = 1024, HD = 128, NH = 8, D_POOL = 1024, PG = 256, D_CONV = 2048;
constexpr int N_EVEN_IN = 6144, N_ODD_IN = 8192, WBUF = 2048, PAST = 16384;
constexpr float EPS = 1e-6f;

__device__ __forceinline__ float silu_f(float x) { return x / (1.f + expf(-x)); }

__global__ void k_siluc(const float* __restrict__ cp, const float* __restrict__ cs, float* __restrict__ sc) {
    const int i = blockIdx.x * blockDim.x + threadIdx.x;
    if (i < 10 * DM) { const int b = i / DM, k = i % DM; const float c = b < 2 ? cp[b * DM + k] : cs[(b - 2) * DM + k]; sc[i] = silu_f(c); }
}
__global__ void k_ada(const float* __restrict__ sc, const float* __restrict__ aw, const float* __restrict__ ab, float* __restrict__ mod) {
    const int j = blockIdx.x * blockDim.x + threadIdx.x;
    const int l = blockIdx.y;
    if (j >= 3 * DM) return;
    float acc[10];
#pragma unroll
    for (int b = 0; b < 10; ++b) acc[b] = 0.f;
    const float* w = aw + (size_t)l * DM * 3 * DM + j;
    for (int k = 0; k < DM; ++k) {
        const float wv = w[(size_t)k * 3 * DM];
#pragma unroll
        for (int b = 0; b < 10; ++b) {
            acc[b] += sc[b * DM + k] * wv;
        }
    }
#pragma unroll
    for (int b = 0; b < 10; ++b) mod[((size_t)l * 10 + b) * 3 * DM + j] = acc[b] + ab[l * 3 * DM + j];
}

__global__ void k_norm(const float* __restrict__ x, const float* __restrict__ g, const float* __restrict__ modp  , int T, float* __restrict__ h) {
    const int row = blockIdx.x, b = row / T;
    __shared__ float red[256];
    float s = 0.f;
    for (int c = threadIdx.x; c < DM; c += 256) { const float v = x[(size_t)row * DM + c]; s += v * v; }
    red[threadIdx.x] = s; __syncthreads();
    for (int o = 128; o > 0; o >>= 1) { if (threadIdx.x < o) red[threadIdx.x] += red[threadIdx.x + o]; __syncthreads(); }
    const float rstd = rsqrtf(red[0] / DM + EPS);
    for (int c = threadIdx.x; c < DM; c += 256) {
        float v = x[(size_t)row * DM + c] * rstd * g[c];
        if (modp) { const float sh = modp[(size_t)b * 3 * DM + c], sc = modp[(size_t)b * 3 * DM + DM + c]; v = v * (1.f + sc) + sh; }
        h[(size_t)row * DM + c] = v;
    }
}

__global__ void __launch_bounds__(256) k_gemm(const float* __restrict__ A, int lda, const float* __restrict__ W, int ldw, float* __restrict__ C, int ldc, int K) {
    __shared__ float As[16][64 + 4], Ws[16][64 + 4];
    const int tx = threadIdx.x & 15, ty = threadIdx.x >> 4;
    const int m0 = blockIdx.y * 64, n0 = blockIdx.x * 64;
    float acc[4][4] = {};
    for (int k0 = 0; k0 < K; k0 += 16) {
        for (int i = threadIdx.x; i < 64 * 16; i += 256) { const int r = i >> 4, kk = i & 15; As[kk][r] = A[(size_t)(m0 + r) * lda + k0 + kk]; }
        for (int i = threadIdx.x; i < 16 * 64; i += 256) { const int kk = i >> 6, c = i & 63; Ws[kk][c] = W[(size_t)(k0 + kk) * ldw + n0 + c]; }
        __syncthreads();
#pragma unroll
        for (int kk = 0; kk < 16; ++kk) {
            float a[4], w[4];
#pragma unroll
            for (int i = 0; i < 4; ++i) { a[i] = As[kk][ty * 4 + i]; w[i] = Ws[kk][tx * 4 + i]; }
#pragma unroll
            for (int i = 0; i < 4; ++i)
#pragma unroll
                for (int j = 0; j < 4; ++j) acc[i][j] += a[i] * w[j];
        }
        __syncthreads();
    }
#pragma unroll
    for (int i = 0; i < 4; ++i)
#pragma unroll
        for (int j = 0; j < 4; ++j) C[(size_t)(m0 + ty * 4 + i) * ldc + n0 + tx * 4 + j] = acc[i][j];
}

__global__ void k_rotary(float* __restrict__ proj, int T, int pos0) {
    const int row = blockIdx.x, t = row % T;
    const float pos = (float)(pos0 + t);
    for (int i = threadIdx.x; i < 2 * NH * 64; i += blockDim.x) {
        const int which = i / (NH * 64), r = i % (NH * 64), hh = r / 64, dd = r % 64;
        const float inv = powf(10000.f, -(float)dd / 64.f);
        const float ang = pos * inv, c = cosf(ang), s = sinf(ang);
        float* p = proj + (size_t)row * N_EVEN_IN + which * D_ATTN + hh * HD;
        const float x1 = p[dd], x2 = p[dd + 64];
        p[dd] = x1 * c - x2 * s; p[dd + 64] = x2 * c + x1 * s;
    }
}

__global__ void __launch_bounds__(64) k_attn(const float* __restrict__ proj, const float* __restrict__ stk, const float* __restrict__ stv, int T, int npre, float* __restrict__ attn) {
    const int row = blockIdx.x, h = blockIdx.y, b = row / T, t = row % T, lane = threadIdx.x;
    __shared__ float qs[HD];
    __shared__ float ps[3 * 129];
    __shared__ int pidx[3 * 129];
    const float scale = 0.08838834764831845f;
    for (int d = lane; d < HD; d += 64) qs[d] = proj[(size_t)row * N_EVEN_IN + h * HD + d] * scale;
    __syncthreads();
    const int e = npre + t;
    const int dil[3] = {1, 4, 16};
    float mymax = -1e30f;
    for (int i = lane; i < 3 * 129; i += 64) {
        const int p = i / 129, j = i % 129;
        const int idx = e - j * dil[p];
        float s = -1e30f;
        if (idx >= 0) {
            const float* kr = idx < npre ? stk + (((size_t)b * npre + idx) * NH + h) * HD : proj + (size_t)(b * T + idx - npre) * N_EVEN_IN + D_ATTN + h * HD;
            float a = 0.f;
            for (int d = 0; d < HD; ++d) a += qs[d] * kr[d];
            s = a;
        }
        ps[i] = s; pidx[i] = idx;
        mymax = fmaxf(mymax, s);
    }
    for (int o = 32; o > 0; o >>= 1) mymax = fmaxf(mymax, __shfl_xor(mymax, o));
    __syncthreads();
    float mysum = 0.f;
    for (int i = lane; i < 3 * 129; i += 64) { const float pv = pidx[i] >= 0 ? expf(ps[i] - mymax) : 0.f; ps[i] = pv; mysum += pv; }
    for (int o = 32; o > 0; o >>= 1) mysum += __shfl_xor(mysum, o);
    __syncthreads();
    float o0 = 0.f, o1 = 0.f;
    for (int i = 0; i < 3 * 129; ++i) {
        const int idx = pidx[i];
        if (idx < 0) continue;
        const float* vr = idx < npre ? stv + (((size_t)b * npre + idx) * NH + h) * HD : proj + (size_t)(b * T + idx - npre) * N_EVEN_IN + 2 * D_ATTN + h * HD;
        const float pv = ps[i];
        o0 += pv * vr[lane]; o1 += pv * vr[lane + 64];
    }
    attn[(size_t)row * D_ATTN + h * HD + lane] = o0 / mysum;
    attn[(size_t)row * D_ATTN + h * HD + lane + 64] = o1 / mysum;
}

__global__ void k_pooled(const float* __restrict__ proj, const float* __restrict__ prefix, int T, int pos0, float* __restrict__ pooled) {
    const int row = blockIdx.x, b = row / T, t = row % T;
    for (int c = threadIdx.x; c < D_POOL; c += blockDim.x) {
        const int gi = c / PG, w = 2 << gi;
        float s = 0.f;
        for (int j = 0; j < w; ++j) {
            const int tt = t - j;
            float v;
            if (tt >= 0) v = proj[(size_t)(b * T + tt) * N_EVEN_IN + 4 * D_ATTN + c];
            else v = prefix ? prefix[((size_t)b * 15 + (15 + tt)) * D_POOL + c] : 0.f;
            s += v;
        }
        const int pos = pos0 + t;
        const float cnt = (float)(w < pos + 1 ? w : pos + 1);
        pooled[(size_t)row * D_POOL + c] = s / cnt - proj[(size_t)row * N_EVEN_IN + 4 * D_ATTN + c];
    }
}

__global__ void k_merge(const float* __restrict__ proj, const float* __restrict__ attn, const float* __restrict__ mixed, const float* __restrict__ pscale, float* __restrict__ merged) {
    const int row = blockIdx.x;
    for (int c = threadIdx.x; c < D_ATTN; c += blockDim.x) {
        merged[(size_t)row * DM + c] = attn[(size_t)row * D_ATTN + c] * silu_f(proj[(size_t)row * N_EVEN_IN + 3 * D_ATTN + c]);
        merged[(size_t)row * DM + D_ATTN + c] = mixed[(size_t)row * D_POOL + c] * pscale[c] * silu_f(proj[(size_t)row * N_EVEN_IN + 4 * D_ATTN + D_POOL + c]);
    }
}

__global__ void k_resid(float* __restrict__ x, const float* __restrict__ mix, const float* __restrict__ modp, int T) {
    const int row = blockIdx.x, b = row / T;
    for (int c = threadIdx.x; c < DM; c += blockDim.x) x[(size_t)row * DM + c] += modp[(size_t)b * 3 * DM + 2 * DM + c] * mix[(size_t)row * DM + c];
}

__global__ void k_convgate(const float* __restrict__ proj, const float* __restrict__ prefix, const float* __restrict__ cw, int T, float* __restrict__ v, float* __restrict__ newconv) {
    const int row = blockIdx.x, b = row / T, t = row % T;
    for (int c = threadIdx.x; c < D_CONV; c += blockDim.x) {
        float y = 0.f;
        for (int kk = 0; kk < 3; ++kk) {
            const int tt = t - 2 + kk;
            float z;
            if (tt >= 0) { const float* p = proj + (size_t)(b * T + tt) * N_ODD_IN; z = p[D_CONV + c] * p[2 * D_CONV + c]; }
            else z = prefix ? prefix[((size_t)b * 2 + (2 + tt)) * D_CONV + c] : 0.f;
            y += z * cw[kk * D_CONV + c];
        }
        const float* p = proj + (size_t)row * N_ODD_IN;
        v[(size_t)row * DM + c] = p[c] * y * silu_f(p[3 * D_CONV + c]);
        if (t >= T - 2) newconv[((size_t)b * 2 + (t - (T - 2))) * D_CONV + c] = p[D_CONV + c] * p[2 * D_CONV + c];
    }
}

__global__ void k_copykv(const float* __restrict__ proj, int T, int keep, float* __restrict__ ok, float* __restrict__ ov) {
    const int row = blockIdx.x, b = row / T, t = row % T;
    if (t < T - keep) return;
    for (int c = threadIdx.x; c < D_ATTN; c += blockDim.x) {
        ok[((size_t)b * keep + t - (T - keep)) * D_ATTN + c] = proj[(size_t)row * N_EVEN_IN + D_ATTN + c];
        ov[((size_t)b * keep + t - (T - keep)) * D_ATTN + c] = proj[(size_t)row * N_EVEN_IN + 2 * D_ATTN + c];
    }
}
__global__ void k_newpool(const float* __restrict__ proj, const float* __restrict__ prefix, int T, float* __restrict__ out) {
    const int b = blockIdx.x / 15, i = blockIdx.x % 15;
    const int e = T + i;
    for (int c = threadIdx.x; c < D_POOL; c += blockDim.x) {
        float v;
        if (e < 15) v = prefix ? prefix[((size_t)b * 15 + e) * D_POOL + c] : 0.f;
        else v = proj[(size_t)(b * T + e - 15) * N_EVEN_IN + 4 * D_ATTN + c];
        out[((size_t)b * 15 + i) * D_POOL + c] = v;
    }
}

struct Trunk {
    int B, T, pos0, npre; const float* x_in; const float* st_k; const float* st_v; const float* st_pool; const float* st_conv; int bmod0;
    float *y, *nk, *nv, *npool, *nconv; size_t nk_l, npool_l, nconv_l; int keep;
};

extern "C" void kernel_launch(void* const* d_in, const int* in_sizes, int n_in, void* d_out, int out_size, void* d_ws, size_t ws_size, hipStream_t stream) {
    const float* x_prompt = (const float*)d_in[0]; const float* x_sample = (const float*)d_in[1];
    const float* c_prompt = (const float*)d_in[2]; const float* c_sample = (const float*)d_in[3];
    const float* st_k = (const float*)d_in[4]; const float* st_v = (const float*)d_in[5];
    const float* st_pool = (const float*)d_in[6]; const float* st_conv = (const float*)d_in[7];
    const float* ada_w = (const float*)d_in[8]; const float* ada_b = (const float*)d_in[9]; const float* norm_g = (const float*)d_in[10];
    const float* w_in_even = (const float*)d_in[11]; const float* w_out_even = (const float*)d_in[12];
    const float* pool_w = (const float*)d_in[13]; const float* pool_scale = (const float*)d_in[14];
    const float* w_in_odd = (const float*)d_in[15]; const float* conv_w = (const float*)d_in[16]; const float* w_out_odd = (const float*)d_in[17];
    const float* final_g = (const float*)d_in[18];
    float* out = (float*)d_out;
    size_t o = 0;
    float* y_prompt = out + o; o += (size_t)NB_P * T_P * DM;
    float* y_sample = out + o; o += (size_t)NB_S * T_S * DM;
    float* nkp = out + o; o += (size_t)2 * NB_P * 2048 * D_ATTN;
    float* nvp = out + o; o += (size_t)2 * NB_P * 2048 * D_ATTN;
    float* npoolp = out + o; o += (size_t)2 * NB_P * 15 * D_POOL;
    float* nconvp = out + o; o += (size_t)2 * NB_P * 2 * D_CONV;
    float* nks = out + o; o += (size_t)2 * NB_S * T_S * D_ATTN;
    float* nvs = out + o; o += (size_t)2 * NB_S * T_S * D_ATTN;
    float* npools = out + o; o += (size_t)2 * NB_S * 15 * D_POOL;
    float* nconvs = out + o; o += (size_t)2 * NB_S * 2 * D_CONV;
    float* ws = (float*)d_ws; size_t w = 0;
    float* mod = ws + w; w += (size_t)4 * 10 * 3 * DM;
    const size_t MR = (size_t)NB_P * T_P;
    float* xb = ws + w; w += MR * DM;
    float* hb = ws + w; w += MR * DM;
    float* proj = ws + w; w += MR * N_ODD_IN;
    float* attn = ws + w; w += MR * D_ATTN;
    float* pooled = ws + w; w += MR * D_POOL;
    float* mixed = ws + w; w += MR * D_POOL;
    float* merged = ws + w; w += MR * DM;
    float* mix = ws + w; w += MR * DM;

    float* scb = ws + w; w += (size_t)10 * DM;
    k_siluc<<<10 * DM / 256, 256, 0, stream>>>(c_prompt, c_sample, scb);
    k_ada<<<dim3(3 * DM / 256, 4), 256, 0, stream>>>(scb, ada_w, ada_b, mod);

    Trunk tr[2];
    tr[0] = Trunk{NB_P, T_P, 0, 0, x_prompt, nullptr, nullptr, nullptr, nullptr, 0, y_prompt, nkp, nvp, npoolp, nconvp, (size_t)NB_P * 2048 * D_ATTN, (size_t)NB_P * 15 * D_POOL, (size_t)NB_P * 2 * D_CONV, 2048};
    tr[1] = Trunk{NB_S, T_S, PAST, WBUF, x_sample, st_k, st_v, st_pool, st_conv, 2, y_sample, nks, nvs, npools, nconvs, (size_t)NB_S * T_S * D_ATTN, (size_t)NB_S * 15 * D_POOL, (size_t)NB_S * 2 * D_CONV, T_S};
    for (int ti = 0; ti < 2; ++ti) {
        const Trunk& R = tr[ti];
        const int M = R.B * R.T;
        hipMemcpyAsync(xb, R.x_in, (size_t)M * DM * sizeof(float), hipMemcpyDeviceToDevice, stream);
        for (int l = 0; l < DEPTH; ++l) {
            const int li = l / 2;
            const float* modp = mod + ((size_t)l * 10 + R.bmod0) * 3 * DM;
            k_norm<<<M, 256, 0, stream>>>(xb, norm_g + l * DM, modp, R.T, hb);
            if (l % 2 == 0) {
                k_gemm<<<dim3(N_EVEN_IN / 64, M / 64), 256, 0, stream>>>(hb, DM, w_in_even + (size_t)li * DM * N_EVEN_IN, N_EVEN_IN, proj, N_EVEN_IN, DM);
                k_rotary<<<M, 256, 0, stream>>>(proj, R.T, R.pos0);
                k_copykv<<<M, 256, 0, stream>>>(proj, R.T, R.keep, R.nk + li * R.nk_l, R.nv + li * R.nk_l);
                const float* sk = R.st_k ? R.st_k + (size_t)li * NB_S * WBUF * D_ATTN : nullptr;
                const float* sv = R.st_v ? R.st_v + (size_t)li * NB_S * WBUF * D_ATTN : nullptr;
                k_attn<<<dim3(M, NH), 64, 0, stream>>>(proj, sk, sv, R.T, R.npre, attn);
                const float* pp = R.st_pool ? R.st_pool + (size_t)li * NB_S * 15 * D_POOL : nullptr;
                k_pooled<<<M, 256, 0, stream>>>(proj, pp, R.T, R.pos0, pooled);
                k_newpool<<<R.B * 15, 256, 0, stream>>>(proj, pp, R.T, R.npool + li * R.npool_l);
                for (int gi = 0; gi < 4; ++gi)
                    k_gemm<<<dim3(PG / 64, M / 64), 256, 0, stream>>>(pooled + gi * PG, D_POOL, pool_w + ((size_t)li * 4 + gi) * PG * PG, PG, mixed + gi * PG, D_POOL, PG);
                k_merge<<<M, 256, 0, stream>>>(proj, attn, mixed, pool_scale + li * D_POOL, merged);
                k_gemm<<<dim3(DM / 64, M / 64), 256, 0, stream>>>(merged, DM, w_out_even + (size_t)li * DM * DM, DM, mix, DM, DM);
            } else {
                k_gemm<<<dim3(N_ODD_IN / 64, M / 64), 256, 0, stream>>>(hb, DM, w_in_odd + (size_t)li * DM * N_ODD_IN, N_ODD_IN, proj, N_ODD_IN, DM);
                const float* cp = R.st_conv ? R.st_conv + (size_t)li * NB_S * 2 * D_CONV : nullptr;
                k_convgate<<<M, 256, 0, stream>>>(proj, cp, conv_w + (size_t)li * 3 * D_CONV, R.T, merged, R.nconv + li * R.nconv_l);
                k_gemm<<<dim3(DM / 64, M / 64), 256, 0, stream>>>(merged, DM, w_out_odd + (size_t)li * DM * DM, DM, mix, DM, DM);
            }
            k_resid<<<M, 256, 0, stream>>>(xb, mix, modp, R.T);
        }
        k_norm<<<M, 256, 0, stream>>>(xb, final_g, nullptr, R.T, R.y);
    }
}
```

```cpp
#include <hip/hip_runtime.h>
#include <hip/hip_bf16.h>
#include <cstdio>
#include <cstdint>
#include <cmath>

constexpr int DM = 2048, NB_P = 2, T_P = 4096, NB_S = 8, T_S = 8, DEPTH = 4;
constexpr int D_ATTN = 1024, HD = 128, NH = 8, D_POOL = 1024, PG = 256, D_CONV = 2048;
constexpr int N_EVEN_IN = 6144, N_ODD_IN = 8192, WBUF = 2048, PAST = 16384;
constexpr int MP = NB_P * T_P;
constexpr int MS = NB_S * T_S;
constexpr float EPS = 1e-6f;
constexpr int NSEQ = NB_P + NB_S;
constexpr int MODW = 3 * DM;
constexpr int SHW_LD = 8192;
constexpr int ROPE_ROWS = T_P + T_S;
constexpr int NPART = 8;

constexpr size_t O_YP = 0;
constexpr size_t O_YS = O_YP + (size_t)MP * DM;
constexpr size_t O_NKP = O_YS + (size_t)MS * DM;
constexpr size_t O_NVP = O_NKP + (size_t)2 * NB_P * 2048 * D_ATTN;
constexpr size_t O_NPOOLP = O_NVP + (size_t)2 * NB_P * 2048 * D_ATTN;
constexpr size_t O_NCONVP = O_NPOOLP + (size_t)2 * NB_P * 15 * D_POOL;
constexpr size_t O_NKS = O_NCONVP + (size_t)2 * NB_P * 2 * D_CONV;
constexpr size_t O_NVS = O_NKS + (size_t)2 * NB_S * T_S * D_ATTN;
constexpr size_t O_NPOOLS = O_NVS + (size_t)2 * NB_S * T_S * D_ATTN;
constexpr size_t O_NCONVS = O_NPOOLS + (size_t)2 * NB_S * 15 * D_POOL;
constexpr size_t O_END = O_NCONVS + (size_t)2 * NB_S * 2 * D_CONV;

constexpr size_t MiB = 1u << 20;
constexpr size_t WS_CTL = 0, CTL_ZERO_BYTES = 1 * MiB;
constexpr size_t WS_MOD = 1 * MiB;
constexpr size_t WS_SHW = 2 * MiB;
constexpr size_t WS_ROPE = 4 * MiB;
constexpr size_t WS_PARTSS = 7 * MiB;
constexpr size_t WS_WIE = 16 * MiB;
constexpr size_t WS_WOE = 64 * MiB;
constexpr size_t WS_WIO = 80 * MiB;
constexpr size_t WS_WOO = 144 * MiB;
constexpr size_t WS_WPW = 160 * MiB;
constexpr size_t WS_A = 162 * MiB;
constexpr size_t WS_AS = WS_A + (size_t)MP * DM * 2;
constexpr size_t WS_QR = 196 * MiB, WS_KR = 212 * MiB, WS_VB = 228 * MiB, WS_GA = 244 * MiB, WS_UB = 260 * MiB, WS_GP = 276 * MiB;
constexpr size_t WS_OPART = 292 * MiB;
constexpr size_t WS_ML = 340 * MiB;
constexpr size_t WS_MERGED = 342 * MiB;
constexpr size_t WS_UO = WS_QR, WS_ZO = WS_QR + 32 * MiB;
constexpr size_t WS_END = 374 * MiB;
constexpr size_t WS_NAIVE = 376 * MiB;

constexpr size_t WS_SRAW = 8 * MiB;
constexpr size_t WS_SMG = 10 * MiB;
constexpr size_t WS_PSS_S = 10 * MiB + 512 * 1024;
constexpr size_t WS_SOP = 11 * MiB;
constexpr size_t WS_SML = 12 * MiB;

typedef unsigned short bf16_t;
typedef float f32x4 __attribute__((ext_vector_type(4)));
typedef unsigned u32x4 __attribute__((ext_vector_type(4)));
typedef unsigned u32x2 __attribute__((ext_vector_type(2)));
typedef short bf16x8 __attribute__((ext_vector_type(8)));

__host__ __device__ __forceinline__ float bf2f(bf16_t v) { union { unsigned u; float f; } x; x.u = (unsigned)v << 16; return x.f; }
__device__ __forceinline__ float silu_f(float x) { return x / (1.f + expf(-x)); }
__device__ __forceinline__ float silu_fast(float x) { return x * __builtin_amdgcn_rcpf(1.f + __expf(-x)); }

__host__ __device__ __forceinline__ int nat8_phys(int j) { const int bj = j >> 7, wc = (j >> 5) & 3, fq = (j >> 3) & 3, n = (j >> 2) & 1, e = j & 3; return 128 * bj + 32 * wc + 16 * n + 4 * fq + e; }
__host__ __device__ __forceinline__ int phys_ie(int c) {
    const int grp = c >> 10, cc = c & 1023;
    if (grp < 2) {
        const int h = cc >> 7, d = cc & 127, bj = d >> 6, dd = d & 63, pn = 4 * grp + (h >> 1), hl = h & 1;
        const int wc = 2 * hl + (dd >> 5), fq = (dd >> 3) & 3, n = (dd >> 2) & 1, e = dd & 3;
        return 256 * pn + 128 * bj + 32 * wc + 16 * n + 4 * fq + e;
    }
    return 256 * (4 * grp + (cc >> 8)) + nat8_phys(cc & 255);
}
__host__ __device__ __forceinline__ int phys_io(int c) {
    const int grp = c >> 11, ch = c & 2047, pn = ch >> 6, r = ch & 63, wc = r >> 4, fq = (r >> 2) & 3, e = r & 3, bj = grp >> 1, n = grp & 1;
    return 256 * pn + 128 * bj + 32 * wc + 16 * n + 4 * fq + e;
}
__host__ __device__ __forceinline__ int phys_out(int c) { return (c & ~255) + nat8_phys(c & 255); }
namespace pg8 {
#define PG8_LAS __attribute__((address_space(3)))
typedef unsigned short bf16_t;
typedef short bf16x8 __attribute__((ext_vector_type(8)));
typedef float f32x4 __attribute__((ext_vector_type(4)));
typedef unsigned u32x4 __attribute__((ext_vector_type(4)));
constexpr int BM = 256, BK = 64, HALF = 128, HTB = HALF * BK * 2  , STAGE_BYTES = 8 * HTB, NXCD = 8, WGM = 8;

__host__ __device__ __forceinline__ int lds_byte(int r, int c) { const int st = (r >> 4) * 2 + (c >> 5), rr = r & 15, cc = c & 31, ob = rr * 64 + cc * 2; return st * 1024 + (ob ^ (((ob >> 9) & 1) << 5)); }
__host__ __device__ __forceinline__ void stage_rc(int b, int& R, int& C) { const int st = b / 1024, sb = b % 1024, swz = sb ^ (((sb >> 9) & 1) << 5); R = (st >> 1) * 16 + swz / 64; C = (st & 1) * 32 + (swz % 64) / 2; }
__host__ __device__ __forceinline__ int perm32(int rho) { const int n = rho >> 4, i = rho & 15; return 8 * (i >> 2) + 4 * n + (i & 3); }

struct Unit { int pm, pn; };
struct Gemm { const bf16_t* A; const bf16_t* Bt; int M, N, K; };

struct StaticOrder {
    int nM, nN, nwg, G, c;
    __host__ __device__ void init(int M, int N, int G_, int c_) { nM = M / BM; nN = N / BM; nwg = nM * nN; G = G_; c = c_; }
    __host__ __device__ bool next(int i, Unit& u) const {
        const long L = (long)i * G + c; if (L >= nwg) return false;
        int wgid = (int)L; { const int q = nwg / NXCD, r = nwg % NXCD, xcd = wgid % NXCD, off = wgid / NXCD; wgid = (xcd < r ? xcd * (q + 1) : r * (q + 1) + (xcd - r) * q) + off; }
        const int nig = WGM * nN, gid = wgid / nig, fm = gid * WGM, gsz = (nM - fm) < WGM ? (nM - fm) : WGM;
        u.pm = fm + ((wgid % nig) % gsz); u.pn = (wgid % nig) / gsz; return true;
    }
    __device__ __forceinline__ void a_ready(const Unit&) const {}
    __device__ __forceinline__ void done(const Unit&) const {}
};

__device__ __forceinline__ unsigned cvt_pk_bf16(float lo, float hi) { unsigned r; asm volatile("v_cvt_pk_bf16_f32 %0, %1, %2" : "=v"(r) : "v"(lo), "v"(hi)); return r; }
typedef float f32x2 __attribute__((ext_vector_type(2)));
__device__ __forceinline__ u32x4 pack8v(const f32x4 a, const f32x4 b) { u32x4 w; w.x = cvt_pk_bf16(a[0], a[1]); w.y = cvt_pk_bf16(a[2], a[3]); w.z = cvt_pk_bf16(b[0], b[1]); w.w = cvt_pk_bf16(b[2], b[3]); return w; }
__device__ __forceinline__ f32x4 silu4(const f32x4 v) { f32x4 r; r[0] = silu_fast(v[0]); r[1] = silu_fast(v[1]); r[2] = silu_fast(v[2]); r[3] = silu_fast(v[3]); return r; }
__device__ __forceinline__ float row_rstd(const float* partss, int row) {
    const f32x4* pp = (const f32x4*)(partss + (size_t)row * NPART); float s = 0.f;
#pragma unroll
    for (int i = 0; i < NPART / 4; ++i) { const f32x4 v = pp[i]; s += (v[0] + v[1]) + (v[2] + v[3]); }
    return rsqrtf(s * (1.0f / DM) + EPS);
}

constexpr size_t GSTRIDE = (size_t)8 * 1024 * 1024;
struct EpiG1E {
    static constexpr bool PERM = false, AFTER_DRAIN = false;
    const float* partss; const float* shw;
    const float* rope_c; const float* rope_s;
    bf16_t* base6;
    float *nk, *nv, *npool;
    __device__ __forceinline__ void operator()(const f32x4 (&acc)[2][2][4][2], const Unit& u, int wr, int wc, int fr, int fq) const {
        asm volatile("" : "+v"(fr), "+v"(fq));
        const int grp = u.pn >> 2, pq = u.pn & 3, b = u.pm >> 4;
        f32x4 sh[2][2];
#pragma unroll
        for (int bj = 0; bj < 2; ++bj)
#pragma unroll
            for (int n = 0; n < 2; ++n) sh[bj][n] = *(const f32x4*)(shw + (size_t)b * SHW_LD + u.pn * BM + bj * HALF + wc * 32 + n * 16 + fq * 4);
        if (grp < 2) {
            const int head = 2 * pq + (wc >> 1), dd0 = 32 * (wc & 1) + 8 * fq;
            bf16_t* dstb = base6 + (size_t)grp * GSTRIDE + head * HD + dd0;
#pragma unroll
            for (int ai = 0; ai < 2; ++ai)
#pragma unroll
                for (int m = 0; m < 4; ++m) {
                    const int row = u.pm * BM + ai * HALF + wr * 64 + m * 16 + fr, t = row & (T_P - 1);
                    const float rs = row_rstd(partss, row);
                    const f32x4 c0 = *(const f32x4*)(rope_c + (size_t)t * 64 + dd0), c1 = *(const f32x4*)(rope_c + (size_t)t * 64 + dd0 + 4);
                    const f32x4 s0 = *(const f32x4*)(rope_s + (size_t)t * 64 + dd0), s1 = *(const f32x4*)(rope_s + (size_t)t * 64 + dd0 + 4);
                    const f32x4 x10 = acc[ai][0][m][0] * rs + sh[0][0], x11 = acc[ai][0][m][1] * rs + sh[0][1];
                    const f32x4 x20 = acc[ai][1][m][0] * rs + sh[1][0], x21 = acc[ai][1][m][1] * rs + sh[1][1];
                    const f32x4 o10 = x10 * c0 - x20 * s0, o11 = x11 * c1 - x21 * s1, o20 = x20 * c0 + x10 * s0, o21 = x21 * c1 + x11 * s1;
                    bf16_t* d = dstb + (size_t)row * D_ATTN;
                    *(u32x4*)d = pack8v(o10, o11); *(u32x4*)(d + 64) = pack8v(o20, o21);
                    if (grp == 1 && t >= T_P - 2048) {
                        float* o = nk + ((size_t)b * 2048 + (t - (T_P - 2048))) * D_ATTN + head * HD + dd0;
                        *(f32x4*)o = o10; *(f32x4*)(o + 4) = o11; *(f32x4*)(o + 64) = o20; *(f32x4*)(o + 68) = o21;
                    }
                    asm volatile("" ::: "memory");
                }
        } else {
            bf16_t* dstb = base6 + (size_t)grp * GSTRIDE + pq * 256 + wc * 32 + 8 * fq;
            const bool gate = (grp == 3) || (grp == 5);
#pragma unroll
            for (int ai = 0; ai < 2; ++ai)
#pragma unroll
                for (int m = 0; m < 4; ++m) {
                    const int row = u.pm * BM + ai * HALF + wr * 64 + m * 16 + fr, t = row & (T_P - 1);
                    const float rs = row_rstd(partss, row);
#pragma unroll
                    for (int bj = 0; bj < 2; ++bj) {
                        f32x4 v0 = acc[ai][bj][m][0] * rs + sh[bj][0], v1 = acc[ai][bj][m][1] * rs + sh[bj][1];
                        if (gate) { v0 = silu4(v0); v1 = silu4(v1); }
                        *(u32x4*)(dstb + (size_t)row * D_ATTN + bj * HALF) = pack8v(v0, v1);
                        const int col = pq * 256 + bj * HALF + wc * 32 + 8 * fq;
                        if (grp == 2 && t >= T_P - 2048) { float* o = nv + ((size_t)b * 2048 + (t - (T_P - 2048))) * D_ATTN + col; *(f32x4*)o = v0; *(f32x4*)(o + 4) = v1; }
                        if (grp == 4 && t >= T_P - 15) { float* o = npool + ((size_t)b * 15 + (t - (T_P - 15))) * D_POOL + col; *(f32x4*)o = v0; *(f32x4*)(o + 4) = v1; }
                    }
                    asm volatile("" ::: "memory");
                }
        }
    }
};

struct EpiG1O {
    static constexpr bool PERM = false, AFTER_DRAIN = false;
    const float* partss; const float* shw;
    bf16_t *UO, *ZO; float* nconv;
    __device__ __forceinline__ void operator()(const f32x4 (&acc)[2][2][4][2], const Unit& u, int wr, int wc, int fr, int fq) const {
        asm volatile("" : "+v"(fr), "+v"(fq));
        const int b = u.pm >> 4, ch0 = 64 * u.pn + 16 * wc + 4 * fq;
        f32x4 sh[2][2];
#pragma unroll
        for (int bj = 0; bj < 2; ++bj)
#pragma unroll
            for (int n = 0; n < 2; ++n) sh[bj][n] = *(const f32x4*)(shw + (size_t)b * SHW_LD + u.pn * BM + bj * HALF + wc * 32 + n * 16 + fq * 4);
#pragma unroll
        for (int ai = 0; ai < 2; ++ai)
#pragma unroll
            for (int m = 0; m < 4; ++m) {
                const int row = u.pm * BM + ai * HALF + wr * 64 + m * 16 + fr, t = row & (T_P - 1);
                const float rs = row_rstd(partss, row);
                const f32x4 bg = acc[ai][0][m][0] * rs + sh[0][0], cg = acc[ai][0][m][1] * rs + sh[0][1], hh = acc[ai][1][m][0] * rs + sh[1][0], g = acc[ai][1][m][1] * rs + sh[1][1];
                const f32x4 uu = bg * silu4(g), zz = cg * hh;
                u32x2 wu, wz; wu.x = cvt_pk_bf16(uu[0], uu[1]); wu.y = cvt_pk_bf16(uu[2], uu[3]); wz.x = cvt_pk_bf16(zz[0], zz[1]); wz.y = cvt_pk_bf16(zz[2], zz[3]);
                *(u32x2*)(UO + (size_t)row * D_CONV + ch0) = wu; *(u32x2*)(ZO + (size_t)row * D_CONV + ch0) = wz;
                if (t >= T_P - 2) *(f32x4*)(nconv + ((size_t)b * 2 + (t - (T_P - 2))) * D_CONV + ch0) = zz;
                asm volatile("" ::: "memory");
            }
    }
};

struct EpiG2 {
    static constexpr bool PERM = false, AFTER_DRAIN = true;
    const float* xin; float* xout; bf16_t* anext;
    const float* modl;
    const float* modn; const float* gn;
    float* partss;
    __device__ __forceinline__ void operator()(const f32x4 (&acc)[2][2][4][2], const Unit& u, int wr, int wc, int fr, int fq) const {}
    __device__ __forceinline__ void fused(f32x4 (&acc)[2][2][4][2], const Unit& u, int wr, int wc, int fr, int fq, PG8_LAS unsigned char* lds, int wid, int lane) const {
        asm volatile("" : "+v"(fr), "+v"(fq), "+v"(lane));
        const int b = u.pm >> 4;
        PG8_LAS float* P = (PG8_LAS float*)lds;
        f32x4 gt[2][2], gs[2][2];
#pragma unroll
        for (int bj = 0; bj < 2; ++bj) { const int col0 = u.pn * BM + bj * HALF + wc * 32 + 8 * fq;
#pragma unroll
            for (int n = 0; n < 2; ++n) { gt[bj][n] = *(const f32x4*)(modl + (size_t)b * MODW + 2 * DM + col0 + 4 * n);
                if (anext) { const f32x4 sc = *(const f32x4*)(modn + (size_t)b * MODW + DM + col0 + 4 * n), g = *(const f32x4*)(gn + col0 + 4 * n); gs[bj][n] = g * (sc + 1.0f); }
                else gs[bj][n] = (f32x4){0.f, 0.f, 0.f, 0.f}; } }
#pragma unroll
        for (int ai = 0; ai < 2; ++ai)
#pragma unroll
            for (int m = 0; m < 4; ++m) {
                const int rl = ai * HALF + wr * 64 + m * 16 + fr, row = u.pm * BM + rl; float ss = 0.f;
#pragma unroll
                for (int bj = 0; bj < 2; ++bj) { const size_t off = (size_t)row * DM + u.pn * BM + bj * HALF + wc * 32 + 8 * fq;
                    const f32x4 x0 = *(const f32x4*)(xin + off), x1 = *(const f32x4*)(xin + off + 4);
                    const f32x4 y0 = x0 + gt[bj][0] * acc[ai][bj][m][0], y1 = x1 + gt[bj][1] * acc[ai][bj][m][1];
                    *(f32x4*)(xout + off) = y0; *(f32x4*)(xout + off + 4) = y1;
                    ss += (y0[0] * y0[0] + y0[1] * y0[1]) + (y0[2] * y0[2] + y0[3] * y0[3]) + (y1[0] * y1[0] + y1[1] * y1[1]) + (y1[2] * y1[2] + y1[3] * y1[3]);
                    if (anext) *(u32x4*)(anext + off) = pack8v(y0 * gs[bj][0], y1 * gs[bj][1]); }
                ss += __shfl_xor(ss, 16); ss += __shfl_xor(ss, 32);
                if (fq == 0) P[rl * 4 + wc] = ss;
                asm volatile("" ::: "memory");
            }
        asm volatile("s_waitcnt lgkmcnt(0)" ::: "memory"); __builtin_amdgcn_s_barrier(); asm volatile("" ::: "memory");
        const int tid = wid * 64 + lane;
        if (tid < BM) { const f32x4 v = *(const PG8_LAS f32x4*)(P + tid * 4); partss[(size_t)(u.pm * BM + tid) * NPART + u.pn] = (v[0] + v[1]) + (v[2] + v[3]); }
    }
};
template <class Epi, class Sched, bool ALIGN_EPI = false, bool SP2 = false>
__device__ __forceinline__ void gemm_phase(PG8_LAS unsigned char* lds, const Gemm g, const Sched& S, const Epi& E, int tid_in) {
    int tid_ = tid_in; asm volatile("" : "+v"(tid_));
    const int tid = tid_, wid = __builtin_amdgcn_readfirstlane(tid >> 6), lane = tid & 63, wr = wid >> 2, wc = wid & 3, fr = lane & 15, fq = lane >> 4;
    const int K = g.K, nt = K / BK;
    unsigned voffA[2], voffB[2];
#pragma unroll
    for (int i = 0; i < 2; ++i) { int R, C; stage_rc(tid * 16 + i * 8192, R, C); const int Rb = Epi::PERM ? ((R & ~31) + perm32(R & 31)) : R;
        voffA[i] = (unsigned)(R * K + C) * 2u; voffB[i] = (unsigned)(Rb * K + C) * 2u; }
    const size_t kstep = (size_t)(BK * 2);
    const size_t hstep = (size_t)HALF * K * 2;
    const size_t tstep = 2 * hstep;
    const unsigned ldsw = (unsigned)wid * 1024u;
    const int aoff = lds_byte(wr * 64 + fr, fq * 8), boff = lds_byte(wc * 32 + fr, fq * 8);
#define PG8_SA(b, h) (((b) * 2 + (h)) * HTB)
#define PG8_SB(b, h) ((4 + (b) * 2 + (h)) * HTB)
#define PG8_STAGE(bufoff, gbase, voff) do { _Pragma("unroll") for (int _i = 0; _i < 2; ++_i) \
        __builtin_amdgcn_global_load_lds((const unsigned*)((const char*)(gbase) + (voff)[_i]), (PG8_LAS unsigned*)(lds + (bufoff) + ldsw + _i * 8192), 16, 0, 0); } while (0)
#define PG8_LDA(dst, b, h) do { _Pragma("unroll") for (int m = 0; m < 4; ++m) _Pragma("unroll") for (int k = 0; k < 2; ++k) dst[m][k] = *(const PG8_LAS bf16x8*)(lds + PG8_SA(b, h) + aoff + m * 2048 + k * 1024); } while (0)
#define PG8_LDB(dst, b, h) do { _Pragma("unroll") for (int n = 0; n < 2; ++n) _Pragma("unroll") for (int k = 0; k < 2; ++k) dst[n][k] = *(const PG8_LAS bf16x8*)(lds + PG8_SB(b, h) + boff + n * 2048 + k * 1024); } while (0)
#define PG8_MMA(ai, bj, At, Bt) do { __builtin_amdgcn_s_setprio(1); _Pragma("unroll") for (int m = 0; m < 4; ++m) _Pragma("unroll") for (int n = 0; n < 2; ++n) _Pragma("unroll") for (int k = 0; k < 2; ++k) \
        acc[ai][bj][m][n] = __builtin_amdgcn_mfma_f32_16x16x32_bf16(Bt[n][k], At[m][k], acc[ai][bj][m][n], 0, 0, 0); __builtin_amdgcn_s_setprio(0); } while (0)
#define PG8_WAIT_V(n) asm volatile("s_waitcnt vmcnt(" #n ")" ::: "memory")
#define PG8_WAIT_L(n) asm volatile("s_waitcnt lgkmcnt(" #n ")" ::: "memory")
#define PG8_BAR __builtin_amdgcn_s_barrier()
#define PG8_SCHED __builtin_amdgcn_sched_barrier(0)
    Unit cur, nxt; int ui = 0;
    if (!S.next(0, cur)) return;
    f32x4 acc[2][2][4][2];
#pragma unroll
    for (int a = 0; a < 2; ++a)
#pragma unroll
        for (int b = 0; b < 2; ++b)
#pragma unroll
            for (int m = 0; m < 4; ++m)
#pragma unroll
                for (int n = 0; n < 2; ++n) acc[a][b][m][n] = (f32x4){0.f, 0.f, 0.f, 0.f};
    bf16x8 At[4][2], B0[2][2], B1[2][2];
    const char* cA = (const char*)g.A + (size_t)cur.pm * tstep; const char* cB = (const char*)g.Bt + (size_t)cur.pn * tstep;
    S.a_ready(cur);
    if constexpr (SP2) {
        PG8_STAGE(PG8_SB(0, 0), cB, voffB); PG8_STAGE(PG8_SB(0, 1), cB + hstep, voffB); PG8_STAGE(PG8_SA(0, 0), cA, voffA); PG8_STAGE(PG8_SA(0, 1), cA + hstep, voffA);
        if (wr == 1) PG8_BAR;
        PG8_WAIT_V(2); PG8_BAR;
        PG8_STAGE(PG8_SB(1, 0), cB + kstep, voffB); PG8_STAGE(PG8_SA(1, 0), cA + kstep, voffA); PG8_STAGE(PG8_SB(1, 1), cB + hstep + kstep, voffB);
        PG8_WAIT_V(6); PG8_BAR;
    } else {
        PG8_STAGE(PG8_SB(0, 0), cB, voffB); PG8_STAGE(PG8_SA(0, 0), cA, voffA); PG8_STAGE(PG8_SB(0, 1), cB + hstep, voffB); PG8_STAGE(PG8_SA(0, 1), cA + hstep, voffA);
        if (wr == 1) PG8_BAR;
        PG8_WAIT_V(4); PG8_BAR;
        PG8_STAGE(PG8_SB(1, 0), cB + kstep, voffB); PG8_STAGE(PG8_SA(1, 0), cA + kstep, voffA); PG8_STAGE(PG8_SB(1, 1), cB + hstep + kstep, voffB);
        PG8_WAIT_V(6); PG8_BAR;
    }
    for (;;) {
        const bool has_next = S.next(ui + 1, nxt);
        const char* nA = has_next ? (const char*)g.A + (size_t)nxt.pm * tstep : cA; const char* nB = has_next ? (const char*)g.Bt + (size_t)nxt.pn * tstep : cB;
        for (int t = 0; t < nt; t += 2) {
            const bool last = (t == nt - 2);
            const char* a1 = cA + (size_t)(t + 1) * kstep;
            const char* a2 = last ? nA : cA + (size_t)(t + 2) * kstep; const char* b2 = last ? nB : cB + (size_t)(t + 2) * kstep;
            const char* a3 = a2 + kstep; const char* b3 = b2 + kstep;
            if (last && has_next) S.a_ready(nxt);
            if constexpr (SP2) {
            PG8_LDB(B0, 0, 0); PG8_LDB(B1, 0, 1); PG8_SCHED; PG8_LDA(At, 0, 0); PG8_STAGE(PG8_SA(1, 1), a1 + hstep, voffA);
            PG8_WAIT_V(8); PG8_WAIT_L(0); PG8_BAR; PG8_MMA(0, 0, At, B0); PG8_MMA(0, 1, At, B1); PG8_BAR; PG8_SCHED;
            PG8_LDA(At, 0, 1); PG8_STAGE(PG8_SB(0, 0), b2, voffB); PG8_STAGE(PG8_SB(0, 1), b2 + hstep, voffB); PG8_STAGE(PG8_SA(0, 0), a2, voffA);
            PG8_WAIT_V(8); PG8_WAIT_L(0); PG8_BAR; PG8_MMA(1, 0, At, B0); PG8_MMA(1, 1, At, B1); PG8_BAR; PG8_SCHED;
            PG8_LDB(B0, 1, 0); PG8_LDB(B1, 1, 1); PG8_SCHED; PG8_LDA(At, 1, 0); PG8_STAGE(PG8_SA(0, 1), a2 + hstep, voffA);
            PG8_WAIT_V(8); PG8_WAIT_L(0); PG8_BAR; PG8_MMA(0, 0, At, B0); PG8_MMA(0, 1, At, B1); PG8_BAR; PG8_SCHED;
            PG8_LDA(At, 1, 1); PG8_STAGE(PG8_SB(1, 0), b3, voffB); PG8_STAGE(PG8_SB(1, 1), b3 + hstep, voffB); PG8_STAGE(PG8_SA(1, 0), a3, voffA);
            PG8_WAIT_V(8); PG8_WAIT_L(0); PG8_BAR; PG8_MMA(1, 0, At, B0); PG8_MMA(1, 1, At, B1); PG8_BAR; PG8_SCHED;
            } else {
            PG8_LDB(B0, 0, 0); PG8_SCHED; PG8_LDA(At, 0, 0); PG8_STAGE(PG8_SA(1, 1), a1 + hstep, voffA);
            PG8_WAIT_L(8); PG8_BAR; PG8_WAIT_L(0); PG8_MMA(0, 0, At, B0); PG8_BAR; PG8_SCHED;
            PG8_LDB(B1, 0, 1); PG8_STAGE(PG8_SB(0, 0), b2, voffB);
            PG8_BAR; PG8_WAIT_L(0); PG8_MMA(0, 1, At, B1); PG8_BAR;
            PG8_LDA(At, 0, 1); PG8_STAGE(PG8_SA(0, 0), a2, voffA);
            PG8_BAR; PG8_WAIT_L(0); PG8_MMA(1, 0, At, B0); PG8_BAR; PG8_SCHED;
            PG8_STAGE(PG8_SB(0, 1), b2 + hstep, voffB);
            PG8_WAIT_V(6); PG8_BAR; PG8_MMA(1, 1, At, B1); PG8_BAR;
            PG8_LDB(B0, 1, 0); PG8_SCHED; PG8_LDA(At, 1, 0); PG8_STAGE(PG8_SA(0, 1), a2 + hstep, voffA);
            PG8_WAIT_L(8); PG8_BAR; PG8_WAIT_L(0); PG8_MMA(0, 0, At, B0); PG8_BAR; PG8_SCHED;
            PG8_LDB(B1, 1, 1); PG8_STAGE(PG8_SB(1, 0), b3, voffB);
            PG8_BAR; PG8_WAIT_L(0); PG8_MMA(0, 1, At, B1); PG8_BAR;
            PG8_LDA(At, 1, 1); PG8_STAGE(PG8_SA(1, 0), a3, voffA);
            PG8_BAR; PG8_WAIT_L(0); PG8_MMA(1, 0, At, B0); PG8_BAR; PG8_SCHED;
            PG8_STAGE(PG8_SB(1, 1), b3 + hstep, voffB);
            PG8_WAIT_V(6); PG8_BAR; PG8_MMA(1, 1, At, B1); PG8_BAR;
            }
        }
        if constexpr (ALIGN_EPI) { if (wr == 0) PG8_BAR; }
        if constexpr (!Epi::AFTER_DRAIN) { E(acc, cur, wr, wc, fr, fq); S.done(cur); }
        if (!has_next) break;
#pragma unroll
        for (int a = 0; a < 2; ++a)
#pragma unroll
            for (int b = 0; b < 2; ++b)
#pragma unroll
                for (int m = 0; m < 4; ++m)
#pragma unroll
                    for (int n = 0; n < 2; ++n) acc[a][b][m][n] = (f32x4){0.f, 0.f, 0.f, 0.f};
        cur = nxt; cA = nA; cB = nB; ++ui;
        if constexpr (ALIGN_EPI) { if (wr == 1) PG8_BAR; }
    }
    PG8_WAIT_V(0);
    if constexpr (!ALIGN_EPI) { if (wr == 0) PG8_BAR; }
    PG8_BAR;
    if constexpr (Epi::AFTER_DRAIN) { E.fused(acc, cur, wr, wc, fr, fq, lds, wid, lane); S.done(cur); }
#undef PG8_SA
#undef PG8_SB
#undef PG8_STAGE
#undef PG8_LDA
#undef PG8_LDB
#undef PG8_MMA
#undef PG8_WAIT_V
#undef PG8_WAIT_L
#undef PG8_BAR
#undef PG8_SCHED
}
}
namespace at {
using bf16 = __hip_bfloat16;
typedef short s16x4 __attribute__((ext_vector_type(4)));
typedef float f32x16 __attribute__((ext_vector_type(16)));
template <class A, class Bt> struct same_t { static constexpr bool v = false; };
template <class A> struct same_t<A, A> { static constexpr bool v = true; };
constexpr int D = 128;
constexpr int WINDOW = 129;
constexpr float THR = 8.f;
constexpr bool WSKIP = true;
constexpr float SCALE = 0.08838834764831845f;
constexpr int NW = 8, QBLK = 32, KVBLK = 64, QB = NW * QBLK;
constexpr int SHM_V = KVBLK * D * 2, SHM_K = KVBLK * D * 2;
constexpr int LDS_BYTES = 2 * SHM_V + 2 * SHM_K + NW * 64 * 4;
#define KSWZ(row, colB) ((row) * 256 + ((colB) ^ (((row) & 7) << 4)))
#define SBAR() __builtin_amdgcn_sched_barrier(0)
__device__ __forceinline__ int v_st(int k, int c) { const int kk = (k & ~0xC) | ((k & 4) << 1) | ((k & 8) >> 1); return ((kk >> 3) * 4 + (c >> 5)) * 512 + ((kk & 7) * 32 + (c & 31)) * 2; }
__device__ __forceinline__ int v_rd_base(int lane) { return ((lane & 3) << 3) | (((lane >> 2) & 3) << 6) | (((lane >> 4) & 1) << 5) | (((lane >> 5) & 1) << 8); }
constexpr int v_rd_off(int d0, int ks, int half) { return d0 * 512 + ks * 4096 + half * 2048; }
__device__ __forceinline__ int crow(int r, int hi) { return (r & 3) + 8 * (r >> 2) + 4 * hi; }
__device__ __forceinline__ unsigned cvtpk(float lo, float hi) {
    unsigned r; asm volatile("v_cvt_pk_bf16_f32 %0, %1, %2" : "=v"(r) : "v"(lo), "v"(hi)); return r;
}
__device__ __forceinline__ bf16x8 pack8(f32x4 a, f32x4 b) {
    u32x4 w = {cvtpk(a[0], a[1]), cvtpk(a[2], a[3]), cvtpk(b[0], b[1]), cvtpk(b[2], b[3])};
    return *reinterpret_cast<bf16x8*>(&w);
}
template <class T> __device__ __forceinline__ bf16x8 load8(const T* p) {
    if constexpr (same_t<T, float>::v) { return pack8(*(const f32x4*)p, *(const f32x4*)(p + 4)); }
    else { return *reinterpret_cast<const bf16x8*>(p); }
}
__device__ __forceinline__ void mask_tile(f32x16& p0, f32x16& p1, int dq, unsigned W) {
    const float NEG = -__builtin_inff();
#pragma unroll
    for (int r = 0; r < 16; ++r) {
        const int c = (r & 3) + 8 * (r >> 2);
        if ((unsigned)(dq - c) >= W) p0[r] = NEG;
        if ((unsigned)(dq - c - 32) >= W) p1[r] = NEG;
    }
}
__device__ __forceinline__ void partialSM(f32x16& p0, f32x16& p1, float& m_reg, float& mn, float& alpha) {
    float pmax = p0[0]; for (int r = 1; r < 16; ++r) pmax = fmaxf(pmax, p0[r]); for (int r = 0; r < 16; ++r) pmax = fmaxf(pmax, p1[r]);
    { auto rr = __builtin_amdgcn_permlane32_swap(__float_as_uint(pmax), __float_as_uint(pmax), false, false);
      pmax = fmaxf(__uint_as_float(rr[0]), __uint_as_float(rr[1])); }
    constexpr float C2 = 1.4426950408889634f * SCALE;
    if (__builtin_expect(__all((pmax - m_reg) * SCALE <= THR), 1)) { mn = m_reg; alpha = 1.f; }
    else { mn = fmaxf(m_reg, pmax); alpha = __builtin_amdgcn_exp2f((m_reg - mn) * C2); m_reg = mn; }
    const float mnL = -mn * C2;
    for (int r = 0; r < 16; ++r) p0[r] = fmaf(p0[r], C2, mnL); for (int r = 0; r < 16; ++r) p1[r] = fmaf(p1[r], C2, mnL);
    for (int r = 0; r < 16; ++r) p0[r] = __builtin_amdgcn_exp2f(p0[r]);
}
__device__ __forceinline__ void finishSM(f32x16& p0, f32x16& p1, float alpha, float& l_reg, bf16x8& pa0, bf16x8& pa1, bf16x8& pa2, bf16x8& pa3) {
    for (int r = 0; r < 16; ++r) p1[r] = __builtin_amdgcn_exp2f(p1[r]);
    float ps = 0; for (int r = 0; r < 16; ++r) ps += p0[r]; for (int r = 0; r < 16; ++r) ps += p1[r];
    { auto rr = __builtin_amdgcn_permlane32_swap(__float_as_uint(ps), __float_as_uint(ps), false, false);
      ps = __uint_as_float(rr[0]) + __uint_as_float(rr[1]); }
    l_reg = l_reg * alpha + ps;
#define PK4(P, B_, OUT) do { unsigned a0 = cvtpk(P[B_+0], P[B_+1]), a1 = cvtpk(P[B_+2], P[B_+3]);                          \
        unsigned b0 = cvtpk(P[B_+4], P[B_+5]), b1 = cvtpk(P[B_+6], P[B_+7]);                                             \
        auto r0 = __builtin_amdgcn_permlane32_swap(a0, b0, false, false); auto r1 = __builtin_amdgcn_permlane32_swap(a1, b1, false, false); \
        u32x4 w = {r0[0], r1[0], r0[1], r1[1]}; OUT = *reinterpret_cast<bf16x8*>(&w); } while (0)
    PK4(p0, 0, pa0); PK4(p0, 8, pa1); PK4(p1, 0, pa2); PK4(p1, 8, pa3);
#undef PK4
}
template <int KB, bool SK>
__device__ __forceinline__ void qkt(f32x16& p0, f32x16& p1, const char* K_lds, int r32, int hi, const bf16x8* qr, bool act) {
    if (SK && !act) { const float NEG = -__builtin_inff();
#pragma unroll
        for (int r = 0; r < 16; ++r) { p0[r] = NEG; p1[r] = NEG; } return; }
    p0 = f32x16{}; p1 = f32x16{};
    const char* kb[4];
#pragma unroll
    for (int dd = 0; dd < 4; ++dd) kb[dd] = K_lds + KB * SHM_K + KSWZ(r32, (dd * 16 + hi * 8) * 2);
#pragma unroll
    for (int d0 = 0; d0 < 8; ++d0) { const char* a = kb[d0 & 3] + (d0 >> 2) * 128;
        bf16x8 b0 = *reinterpret_cast<const bf16x8*>(a);
        bf16x8 b1 = *reinterpret_cast<const bf16x8*>(a + 32 * 256);
        p0 = __builtin_amdgcn_mfma_f32_32x32x16_bf16(b0, qr[d0], p0, 0, 0, 0);
        p1 = __builtin_amdgcn_mfma_f32_32x32x16_bf16(b1, qr[d0], p1, 0, 0, 0); }
}
template <int VB, bool SK>
__device__ __forceinline__ void pv_tile(f32x16* o, int vb0, bf16x8 pa0, bf16x8 pa1, bf16x8 pa2, bf16x8 pa3, bool act) {
    if (SK && !act) return;
#define TRRD(dst, off) asm volatile("ds_read_b64_tr_b16 %0, %1 offset:%2" : "=&v"(dst) : "v"(vb0), "i"(off) : "memory")
#define PV_D0(d0) do { s16x4 l0, l1, l2, l3, h0, h1, h2, h3; constexpr int b_ = VB * SHM_V + v_rd_off(d0, 0, 0);     \
        TRRD(l0, b_); TRRD(h0, b_ + 2048); TRRD(l1, b_ + 4096); TRRD(h1, b_ + 6144); TRRD(l2, b_ + 8192); TRRD(h2, b_ + 10240); TRRD(l3, b_ + 12288); TRRD(h3, b_ + 14336); \
        asm volatile("s_waitcnt lgkmcnt(0)" ::: "memory"); SBAR();                 \
        o[d0] = __builtin_amdgcn_mfma_f32_32x32x16_bf16(pa0, (bf16x8){l0[0], l0[1], l0[2], l0[3], h0[0], h0[1], h0[2], h0[3]}, o[d0], 0, 0, 0);   \
        o[d0] = __builtin_amdgcn_mfma_f32_32x32x16_bf16(pa1, (bf16x8){l1[0], l1[1], l1[2], l1[3], h1[0], h1[1], h1[2], h1[3]}, o[d0], 0, 0, 0);   \
        o[d0] = __builtin_amdgcn_mfma_f32_32x32x16_bf16(pa2, (bf16x8){l2[0], l2[1], l2[2], l2[3], h2[0], h2[1], h2[2], h2[3]}, o[d0], 0, 0, 0);   \
        o[d0] = __builtin_amdgcn_mfma_f32_32x32x16_bf16(pa3, (bf16x8){l3[0], l3[1], l3[2], l3[3], h3[0], h3[1], h3[2], h3[3]}, o[d0], 0, 0, 0); } while (0)
    PV_D0(0); PV_D0(1); PV_D0(2); PV_D0(3);
#undef PV_D0
#undef TRRD
}

template <class TIn, class TOut> struct BlockRef { const TIn* Q; const TIn* K; const TIn* V; TOut* O; float* ML; int P0; };
template <class TIn> struct Seam {
    bf16x8 qr[8];
    bf16x8 st_v0, st_v1, st_k0, st_k1; f32x4 sf0, sf1, sf2, sf3;
    f32x4 tq[16];
};
__device__ __forceinline__ int swa_jlo(int P0, int W) { const int lowk = P0 - W + 1; return lowk > 0 ? lowk / KVBLK : 0; }
#define TROW(p, k0) ((p) + (size_t)(k0) * ld)
#define VMW() asm volatile("s_waitcnt vmcnt(0)" ::: "memory")
#define VMWN(n) asm volatile("s_waitcnt vmcnt(%0)" :: "i"(n) : "memory")
#define SLOAD_H(Kp, Vp, k0) do { const TIn* vt_ = TROW(Vp, k0); const TIn* kt_ = TROW(Kp, k0); S.st_v0 = load8<TIn>(vt_ + ro0); S.st_v1 = load8<TIn>(vt_ + ro1);              \
                         S.st_k0 = load8<TIn>(kt_ + ro0); S.st_k1 = load8<TIn>(kt_ + ro1); } while (0)
#define SWRITE_HK(bf) do { *(bf16x8*)(K_lds + (bf) * SHM_K + kws) = S.st_k0; *(bf16x8*)(K_lds + (bf) * SHM_K + kws + 32 * 256) = S.st_k1; } while (0)
#define SWRITE_HV(bf) do { *(bf16x8*)(V_lds + (bf) * SHM_V + vst0) = S.st_v0; *(bf16x8*)(V_lds + (bf) * SHM_V + vst1) = S.st_v1; } while (0)
#define SWRITE_H(bf) do { SWRITE_HV(bf); SWRITE_HK(bf); } while (0)
#define SLOAD_F(p, k0) do { const float* pt_ = TROW(p, k0); S.sf0 = *(const f32x4*)(pt_ + ro0); S.sf1 = *(const f32x4*)(pt_ + ro0 + 4);                \
                            S.sf2 = *(const f32x4*)(pt_ + ro1); S.sf3 = *(const f32x4*)(pt_ + ro1 + 4); } while (0)
#define SWRITE_KF(bf) do { *(bf16x8*)(K_lds + (bf) * SHM_K + kws) = pack8(S.sf0, S.sf1); *(bf16x8*)(K_lds + (bf) * SHM_K + kws + 32 * 256) = pack8(S.sf2, S.sf3); } while (0)
#define SWRITE_VF(bf) do { *(bf16x8*)(V_lds + (bf) * SHM_V + vst0) = pack8(S.sf0, S.sf1); *(bf16x8*)(V_lds + (bf) * SHM_V + vst1) = pack8(S.sf2, S.sf3); } while (0)
template <class TIn, class TOut>
__device__ __forceinline__ void causal_swa_prime(const BlockRef<TIn, TOut>& cur, int W, char* lds, Seam<TIn>& S, int ld, int tid_in) {
    constexpr bool F32 = same_t<TIn, float>::v;
    int tid_ = tid_in; asm volatile("" : "+v"(tid_));
    const int tid = tid_, wid = __builtin_amdgcn_readfirstlane(tid >> 6), lane = tid & 63, r32 = lane & 31, hi = lane >> 5;
    const int sr = tid >> 4, sc = (tid & 15) * 8, kws = KSWZ(sr, sc * 2); char* K_lds = lds + 2 * SHM_V;
    const unsigned ro0 = (unsigned)(sr * ld + sc), ro1 = (unsigned)((32 + sr) * ld + sc);
    const int kb0 = swa_jlo(cur.P0, W) * KVBLK;
    for (int d0 = 0; d0 < 8; ++d0) S.qr[d0] = load8<TIn>(cur.Q + (unsigned)((wid * QBLK + r32) * ld + d0 * 16 + hi * 8));
    if constexpr (F32) { SLOAD_F((const float*)cur.K, kb0); VMW(); SWRITE_KF(0); SBAR(); SLOAD_F((const float*)cur.V, kb0); }
    else { SLOAD_H(cur.K, cur.V, kb0); VMW(); SWRITE_HK(0); }
    __syncthreads();
}
template <class TIn, class TOut>
__device__ __forceinline__ void causal_swa_block(const BlockRef<TIn, TOut>& cur, const BlockRef<TIn, TOut>& nxt, int skv, int W, char* lds, Seam<TIn>& S, int ld, int mlstride, int tid_in) {
    constexpr bool F32 = same_t<TIn, float>::v;
    int tid_ = tid_in; asm volatile("" : "+v"(tid_));
    const int tid = tid_, wid = __builtin_amdgcn_readfirstlane(tid >> 6), lane = tid & 63, r32 = lane & 31, hi = lane >> 5;
    const int j_lo = swa_jlo(cur.P0, W);
    int j_hi = (cur.P0 + QB - 1) / KVBLK + 1; if (j_hi > skv / KVBLK) j_hi = skv / KVBLK;
    const int NT = j_hi - j_lo;
    const int kbn = swa_jlo(nxt.P0, W) * KVBLK;
    const int qlo = cur.P0 + wid * QBLK, qm = qlo + r32 - 4 * hi;
    char* V_lds = lds; char* K_lds = lds + 2 * SHM_V;
    float* ws = (float*)(lds + 2 * SHM_V + 2 * SHM_K) + wid * 64; float* li_l = ws, * al_l = ws + 32;
    float m_reg = -1e30f, l_reg = 0; f32x16 o[4] = {};
    const unsigned ro0 = (unsigned)((tid >> 4) * ld + (tid & 15) * 8), ro1 = (unsigned)((32 + (tid >> 4)) * ld + (tid & 15) * 8);
    const int sr = tid >> 4, sc = (tid & 15) * 8, vst0 = v_st(sr, sc), vst1 = v_st(32 + sr, sc), kws = KSWZ(sr, sc * 2);
    const int vb0 = (int)(uintptr_t)V_lds + v_rd_base(lane);
    const TIn* Kh = cur.K; const TIn* Vh = cur.V;
#define RESC(a) do { if (__any((a) < 1.f)) { if (hi == 0) al_l[r32] = (a); asm volatile("s_waitcnt lgkmcnt(0)" ::: "memory");              \
                     for (int d_ = 0; d_ < 4; ++d_) for (int r = 0; r < 16; ++r) o[d_][r] *= al_l[crow(r, hi)]; } } while (0)
#define KBASE(t) ((j_lo + (t)) * KVBLK)
#define ACT(t) (KBASE(t) <= qlo + QBLK - 1 && KBASE(t) + KVBLK - 1 >= qlo - W + 1)
#define MASKT(P0_, P1_, t) do { const int kb_ = KBASE(t); if ((!SK || ACT(t)) && (kb_ + KVBLK - 1 > qlo || kb_ <= qlo + QBLK - 1 - W)) mask_tile(P0_, P1_, qm - kb_, (unsigned)W); } while (0)
    constexpr int NQL = F32 ? 16 : 8;
    constexpr bool SK = WSKIP && !F32;
#define SEAM_K0() do { VMWN(NQL); if constexpr (F32) { SWRITE_KF(0); SBAR(); SLOAD_F((const float*)nxt.V, kbn); } else { SWRITE_HK(0); } SBAR(); } while (0)
    f32x16 pA0, pA1, pB0, pB1; float mnA, mnB, alA, alB; bf16x8 pa0, pa1, pa2, pa3;
    if constexpr (F32) { VMW(); SWRITE_VF(0); SBAR(); } else { SWRITE_HV(0); SBAR(); }
    if (NT > 1) { if constexpr (F32) SLOAD_F((const float*)Kh, KBASE(1)); else SLOAD_H(Kh, Vh, KBASE(1)); }
    SBAR(); qkt<0, SK>(pA0, pA1, K_lds, r32, hi, S.qr, ACT(0));
    if constexpr (F32) { if (NT > 1) { VMW(); SWRITE_KF(1); SBAR(); SLOAD_F((const float*)Vh, KBASE(1)); } }
    MASKT(pA0, pA1, 0); partialSM(pA0, pA1, m_reg, mnA, alA);
    if (NT > 1) { VMW(); if constexpr (F32) { SWRITE_VF(1); SBAR(); if (NT > 2) SLOAD_F((const float*)Kh, KBASE(2)); } else SWRITE_H(1); }
    __syncthreads();
#define HALF_STEP(PX0, PX1, mnX, alX, PY0, PY1, alY, t, KB, VB, SB) do {                                                      \
        SBAR(); qkt<KB, SK>(PX0, PX1, K_lds, r32, hi, S.qr, ACT(t));                                             \
        finishSM(PY0, PY1, alY, l_reg, pa0, pa1, pa2, pa3); SBAR();                                                           \
        if ((t) + 1 < NT) { if constexpr (F32) { VMW(); SWRITE_KF(SB); SBAR(); SLOAD_F((const float*)Vh, KBASE((t) + 1)); }  \
                            else { SLOAD_H(Kh, Vh, KBASE((t) + 1)); } SBAR(); }                                               \
        pv_tile<VB, SK>(o, vb0, pa0, pa1, pa2, pa3, ACT((t) - 1)); MASKT(PX0, PX1, (t)); partialSM(PX0, PX1, m_reg, mnX, alX);                                        \
        __syncthreads();                                                                                                      \
        if ((t) + 1 < NT) { VMW(); if constexpr (F32) { SWRITE_VF(SB); SBAR(); if ((t) + 2 < NT) SLOAD_F((const float*)Kh, KBASE((t) + 2)); } \
                            else { SWRITE_H(SB); } }                                                                          \
        RESC(alX); __syncthreads(); } while (0)
    for (int t = 1; t + 1 < NT; t += 2) {
        HALF_STEP(pB0, pB1, mnB, alB, pA0, pA1, alA, t, 1, 0, 0);
        HALF_STEP(pA0, pA1, mnA, alA, pB0, pB1, alB, t + 1, 0, 1, 1);
    }
    const bool even = (NT & 1) == 0;
    if (even) { SBAR(); qkt<1, SK>(pB0, pB1, K_lds, r32, hi, S.qr, ACT(NT - 1)); SBAR(); }
#define QROW(e) (nxt.Q + (unsigned)((wid * QBLK + r32) * ld + ((e) >> 1) * 16 + hi * 8 + ((e) & 1) * 4))
    if constexpr (F32) { SLOAD_F((const float*)nxt.K, kbn); SBAR();
#pragma unroll
        for (int e = 0; e < 8; ++e) S.tq[e] = *(const f32x4*)QROW(e); }
    else { SLOAD_H(nxt.K, nxt.V, kbn); SBAR();
#pragma unroll
        for (int d0 = 0; d0 < 8; ++d0) S.qr[d0] = load8<TIn>(nxt.Q + (unsigned)((wid * QBLK + r32) * ld + d0 * 16 + hi * 8)); }
    SBAR();
    finishSM(pA0, pA1, alA, l_reg, pa0, pa1, pa2, pa3); SBAR();
    if constexpr (F32) {
#pragma unroll
        for (int e = 8; e < 16; ++e) S.tq[e] = *(const f32x4*)QROW(e); SBAR(); }
#undef QROW
    pv_tile<0, SK>(o, vb0, pa0, pa1, pa2, pa3, ACT(even ? NT - 2 : NT - 1));
    if (even) { MASKT(pB0, pB1, NT - 1); partialSM(pB0, pB1, m_reg, mnB, alB); __syncthreads(); RESC(alB);
        finishSM(pB0, pB1, alB, l_reg, pa0, pa1, pa2, pa3); SBAR(); pv_tile<1, SK>(o, vb0, pa0, pa1, pa2, pa3, ACT(NT - 1)); }
    SBAR(); SEAM_K0();
    int r32e = r32, hie = hi; asm volatile("" : "+v"(r32e), "+v"(hie));
    if (hi == 0) li_l[r32] = l_reg; asm volatile("s_waitcnt lgkmcnt(0)" ::: "memory");
    float rli[16];
#pragma unroll
    for (int r = 0; r < 16; ++r) rli[r] = __builtin_amdgcn_rcpf(li_l[crow(r, hie)]);
    if (hie == 0) { float* mlp = cur.ML + (unsigned)((wid * QBLK + r32e) * mlstride * 2); mlp[0] = m_reg; mlp[1] = l_reg; }
    TOut* Ow = cur.O + (unsigned)(wid * QBLK * ld);
#pragma unroll
    for (int r = 0; r < 16; ++r) { const int orow = crow(r, hie);
#pragma unroll
        for (int d0 = 0; d0 < 4; ++d0) { const float v = o[d0][r] * rli[r];
            if constexpr (same_t<TOut, float>::v) { Ow[(unsigned)(orow * ld + d0 * 32 + r32e)] = v; }
            else { const float vn = __shfl_xor(v, 1);
                   if ((r32e & 1) == 0) *(unsigned*)(Ow + (unsigned)(orow * ld + d0 * 32 + r32e)) = cvtpk(v, vn); } } }
    if constexpr (F32) {
#pragma unroll
        for (int d0 = 0; d0 < 8; ++d0) S.qr[d0] = pack8(S.tq[2 * d0], S.tq[2 * d0 + 1]); }
    __syncthreads();
#undef RESC
#undef KBASE
#undef ACT
#undef MASKT
#undef SEAM_K0
#undef HALF_STEP
}
#undef TROW
#undef VMW
#undef VMWN
#undef SLOAD_H
#undef SWRITE_HK
#undef SWRITE_HV
#undef SWRITE_H
#undef SLOAD_F
#undef SWRITE_KF
#undef SWRITE_VF

}
constexpr int NWAVES = 8;
constexpr int RING_BYTES = 131072;
constexpr int LDSCTL_OFF = RING_BYTES, MISC_OFF = LDSCTL_OFF + 320;
constexpr int LDS_BYTES = 147456;
constexpr int CW_BAR = 4096;

#define GAS __attribute__((address_space(1)))
#define LAS __attribute__((address_space(3)))
typedef GAS unsigned gu32;
#define RLX_AGENT __ATOMIC_RELAXED, __HIP_MEMORY_SCOPE_AGENT
#define LDS_WAIT() asm volatile("s_waitcnt lgkmcnt(0)" ::: "memory")
#define VM_WAIT() asm volatile("s_waitcnt vmcnt(0)" ::: "memory")

#define XB_TMO      128
#define XB_XCNT(j)  (256  + 64 * (j))
#define XB_XSUB(j)  (1280 + 64 * (j))
#define XB_XGEN(j)  (2304 + 64 * (j))
#define XB_TOP      3328
#define XB_TOPGEN   3392
#define XCD_BAR_WORDS 3456
#define XB_SPIN_CAP (1u << 18)
__device__ __forceinline__ unsigned xb_ld(unsigned* p)              { return __hip_atomic_load(p, __ATOMIC_RELAXED, __HIP_MEMORY_SCOPE_AGENT); }
__device__ __forceinline__ unsigned xb_add(unsigned* p, unsigned v) { return __hip_atomic_fetch_add(p, v, __ATOMIC_RELAXED, __HIP_MEMORY_SCOPE_AGENT); }
__device__ __forceinline__ unsigned xb_xcc_id() { return (unsigned)__builtin_amdgcn_s_getreg((3 << 11) | 20) & 0xFu; }
#define XB_SPIN(cond, bar) do { unsigned _sp = 0; while (cond) { __builtin_amdgcn_s_sleep(1); \
    if ((++_sp & 255u) == 0u) { if (xb_ld(&(bar)[XB_TMO])) break; if (_sp > XB_SPIN_CAP) { atomicAdd(&(bar)[XB_TMO], 1u); break; } } } } while (0)
__device__ __forceinline__ int lane_id() { int l; asm volatile("v_mbcnt_lo_u32_b32 %0, -1, 0\n\tv_mbcnt_hi_u32_b32 %0, -1, %0" : "=v"(l)); return l; }
struct XcdBarrier { unsigned* bar; unsigned x; volatile LAS unsigned* st; int wave; };
__device__ __forceinline__ XcdBarrier xcd_barrier_post(unsigned* bar, volatile LAS unsigned* st, int wave) {
    XcdBarrier b; b.bar = bar; b.x = xb_xcc_id(); b.st = st; b.wave = wave;
    if (wave == 0 && lane_id() == 0) (void)xb_add(&bar[XB_XCNT(b.x)], 1u);
    return b;
}
__device__ __forceinline__ void xcd_barrier_complete(unsigned* bar, unsigned x, unsigned& nloc, unsigned& nx) {
    const unsigned G = gridDim.x * gridDim.y * gridDim.z;
    unsigned sum, cnt, mine, sp = 0u;
    for (;;) {
        sum = 0u; cnt = 0u; mine = 0u;
#pragma unroll
        for (unsigned j = 0; j < 16; ++j) { const unsigned c = xb_ld(&bar[XB_XCNT(j)]); sum += c; cnt += (c > 0u) ? 1u : 0u; mine = (j == x) ? c : mine; }
        if (sum == G) break;
        __builtin_amdgcn_s_sleep(1);
        if ((++sp & 255u) == 0u) { if (xb_ld(&bar[XB_TMO])) break; if (sp > XB_SPIN_CAP) { atomicAdd(&bar[XB_TMO], 1u); break; } }
    }
    nloc = mine > 0u ? mine : 1u; nx = cnt > 0u ? cnt : 1u;
}
__device__ __forceinline__ void xcd_barrier(const XcdBarrier& b) {
    asm volatile("s_waitcnt vmcnt(0)" ::: "memory");
    __syncthreads();
    if (b.wave == 0 && lane_id() == 0) {
        unsigned* bar = b.bar;
        __builtin_amdgcn_s_waitcnt(0);
        unsigned nloc = b.st[0], nx = b.st[1];
        if (nloc == 0u) { xcd_barrier_complete(bar, b.x, nloc, nx); b.st[0] = nloc; b.st[1] = nx; }
        const unsigned old = xb_add(&bar[XB_XSUB(b.x)], 1u);
        const unsigned gen = old / nloc;
        if (old + 1u == (gen + 1u) * nloc) {
            __builtin_amdgcn_fence(__ATOMIC_RELEASE, "agent");
            asm volatile("s_waitcnt vmcnt(0)" ::: "memory");
            const unsigned og = xb_add(&bar[XB_TOP], 1u);
            const unsigned tg = og / nx;
            if (og + 1u == (tg + 1u) * nx) xb_add(&bar[XB_TOPGEN], 1u);
            else XB_SPIN(xb_ld(&bar[XB_TOPGEN]) == tg, bar);
            __builtin_amdgcn_fence(__ATOMIC_ACQUIRE, "agent");
            xb_add(&bar[XB_XGEN(b.x)], 1u);
            asm volatile("s_waitcnt vmcnt(0)" ::: "memory");
        } else {
            XB_SPIN(xb_ld(&bar[XB_XGEN(b.x)]) == gen, bar);
            __builtin_amdgcn_fence(__ATOMIC_ACQUIRE, "agent");
            asm volatile("s_waitcnt vmcnt(0)" ::: "memory");
        }
    }
    __syncthreads();
}

struct Args { const float* in[19]; float* out; unsigned char* ws; int ph_lo, ph_hi, li, pad; };
#define OPQ_S(x) asm volatile("" : "+s"(x))
#define OPQ_V(x) asm volatile("" : "+v"(x))
struct Frame {
    LAS unsigned char* lds; char* ldsg;
    int tid, lane, wave, vcu, G;
    float* out; unsigned char* ws;
};
__device__ __forceinline__ Frame fresh(const Frame& F0) { Frame F = F0; OPQ_S(F.ws); OPQ_S(F.out); int ln = lane_id(); OPQ_V(ln); F.lane = ln; F.tid = F.wave * 64 + ln; F.ldsg = (char*)(__attribute__((address_space(3))) char*)F.lds; return F; }
__device__ __forceinline__ float wave_sum(float v) {
#pragma unroll
    for (int o = 1; o < 64; o <<= 1) v += __shfl_xor(v, o);
    return v;
}
__device__ __forceinline__ unsigned f2bf(float f) { unsigned u = __builtin_bit_cast(unsigned, f); return (u + 0x7fffu + ((u >> 16) & 1u)) >> 16; }
__device__ __forceinline__ unsigned pk2(float lo, float hi) { return f2bf(lo) | (f2bf(hi) << 16); }

enum WKind { WK_IE = 0, WK_OE = 1, WK_IO = 2, WK_OO = 3, WK_PW = 4 };
template <int KIND>
__device__ __forceinline__ void p0_transpose_item(const float* W, int K, int N, bf16_t* WT, LAS float* scr, int item, int lane) {
    const int nblk = N / 32, kb = item / nblk, nb = item % nblk, k0 = 64 * kb, n0 = 32 * nb;
#pragma unroll 8
    for (int i = 0; i < 32; ++i) { const int kk = 2 * i + (lane >> 5); scr[kk * 33 + (lane & 31)] = W[(size_t)(k0 + kk) * N + n0 + (lane & 31)]; }
    LDS_WAIT(); asm volatile("" ::: "memory");
    const int c = lane & 7;
#pragma unroll
    for (int j = 0; j < 4; ++j) { const int n = (lane >> 3) + 8 * j; const LAS float* s = scr + (8 * c) * 33 + n;
        u32x4 o; o.x = pk2(s[0 * 33], s[1 * 33]); o.y = pk2(s[2 * 33], s[3 * 33]); o.z = pk2(s[4 * 33], s[5 * 33]); o.w = pk2(s[6 * 33], s[7 * 33]);
        const int nn = n0 + n;
        const int prow = KIND == WK_IE ? phys_ie(nn) : KIND == WK_IO ? phys_io(nn) : KIND == WK_PW ? nn : phys_out(nn);
        *(GAS u32x4*)(WT + (size_t)prow * K + k0 + 8 * c) = o; }
    LDS_WAIT(); asm volatile("" ::: "memory");
}
__device__ __forceinline__ void p0_phase(Frame& F, const Args& args) {
    const float* cp = args.in[2]; const float* cs = args.in[3]; const float* ada_w = args.in[8]; const float* ada_b = args.in[9];
    float* mod = (float*)(F.ws + WS_MOD);
    LAS float* sc = (LAS float*)F.lds;
    LAS float* red = (LAS float*)(F.lds + 81920);
    for (int i = F.tid; i < NSEQ * DM; i += NWAVES * 64) { const int b = i / DM, k = i % DM; const float c = b < NB_P ? cp[b * DM + k] : cs[(b - NB_P) * DM + k]; sc[i] = c / (1.f + expf(-c)); }
    __syncthreads();
    for (int u = F.vcu; u < DEPTH * (MODW / 32); u += F.G) {
        const int l = u / (MODW / 32), j0 = (u % (MODW / 32)) * 32, kr = F.tid >> 3, cj = F.tid & 7;
        float acc[NSEQ][4];
#pragma unroll
        for (int b = 0; b < NSEQ; ++b) { acc[b][0] = 0.f; acc[b][1] = 0.f; acc[b][2] = 0.f; acc[b][3] = 0.f; }
        const float* wp = ada_w + ((size_t)l * DM + kr) * MODW + j0 + 4 * cj;
#pragma unroll 8
        for (int it = 0; it < DM / 64; ++it) {
            const f32x4 w = *(const f32x4*)(wp + (size_t)it * 64 * MODW); const int k = kr + 64 * it;
#pragma unroll
            for (int b = 0; b < NSEQ; ++b) { const float s = sc[b * DM + k]; acc[b][0] += s * w[0]; acc[b][1] += s * w[1]; acc[b][2] += s * w[2]; acc[b][3] += s * w[3]; }
        }
#pragma unroll
        for (int b = 0; b < NSEQ; ++b)
#pragma unroll
            for (int e = 0; e < 4; ++e) { float v = acc[b][e]; v += __shfl_xor(v, 8); v += __shfl_xor(v, 16); v += __shfl_xor(v, 32); if (F.lane < 8) red[(F.wave * 8 + F.lane) * 40 + b * 4 + e] = v; }
        __syncthreads();
        if (F.tid < 320) { const int cj2 = F.tid / 40, be = F.tid % 40, b = be >> 2, e = be & 3; float s = 0.f;
#pragma unroll
            for (int w = 0; w < NWAVES; ++w) s += red[(w * 8 + cj2) * 40 + be];
            const int j = j0 + 4 * cj2 + e; mod[((size_t)l * NSEQ + b) * MODW + j] = s + ada_b[l * MODW + j]; }
        __syncthreads();
    }
    __syncthreads();
    LAS float* scr = (LAS float*)(F.lds + F.wave * 16384);
    const int gw = F.vcu * NWAVES + F.wave, NGW = F.G * NWAVES;
    constexpr int I_IE = (DM / 64) * (N_EVEN_IN / 32), I_OE = (DM / 64) * (DM / 32), I_IO = (DM / 64) * (N_ODD_IN / 32), I_PW = (PG / 64) * (PG / 32);
    constexpr int NITEMS = 2 * (I_IE + I_OE + I_IO + I_OE) + 8 * I_PW;
    for (int it = gw; it < NITEMS; it += NGW) {
        int r = it;
        if (r < 2 * I_IE) { const int li = r / I_IE; p0_transpose_item<WK_IE>(args.in[11] + (size_t)li * DM * N_EVEN_IN, DM, N_EVEN_IN, (bf16_t*)(F.ws + WS_WIE) + (size_t)li * N_EVEN_IN * DM, scr, r % I_IE, F.lane); continue; } r -= 2 * I_IE;
        if (r < 2 * I_OE) { const int li = r / I_OE; p0_transpose_item<WK_OE>(args.in[12] + (size_t)li * DM * DM, DM, DM, (bf16_t*)(F.ws + WS_WOE) + (size_t)li * DM * DM, scr, r % I_OE, F.lane); continue; } r -= 2 * I_OE;
        if (r < 2 * I_IO) { const int li = r / I_IO; p0_transpose_item<WK_IO>(args.in[15] + (size_t)li * DM * N_ODD_IN, DM, N_ODD_IN, (bf16_t*)(F.ws + WS_WIO) + (size_t)li * N_ODD_IN * DM, scr, r % I_IO, F.lane); continue; } r -= 2 * I_IO;
        if (r < 2 * I_OE) { const int li = r / I_OE; p0_transpose_item<WK_OO>(args.in[17] + (size_t)li * DM * DM, DM, DM, (bf16_t*)(F.ws + WS_WOO) + (size_t)li * DM * DM, scr, r % I_OE, F.lane); continue; } r -= 2 * I_OE;
        { const int g = r / I_PW; p0_transpose_item<WK_PW>(args.in[13] + (size_t)g * PG * PG, PG, PG, (bf16_t*)(F.ws + WS_WPW) + (size_t)g * PG * PG, scr, r % I_PW, F.lane); }
    }
    float* rc = (float*)(F.ws + WS_ROPE); float* rsn = rc + (size_t)ROPE_ROWS * 64;
    for (int i = gw * 64 + F.lane; i < ROPE_ROWS * 64; i += NGW * 64) {
        const int row = i >> 6, dd = i & 63; const double pos = row < T_P ? (double)row : (double)(PAST + row - T_P);
        const double inv = pow(10000.0, -(double)dd / 64.0), ang = pos * inv;
        rc[i] = (float)cos(ang); rsn[i] = (float)sin(ang);
    }
}

__device__ __forceinline__ void p1_phase(Frame& F, const Args& args) {
    const float* mod = (const float*)(F.ws + WS_MOD); float* shw = (float*)(F.ws + WS_SHW);
    const int gw = F.vcu * NWAVES + F.wave, NGW = F.G * NWAVES;
    constexpr int NROWS = 2 * N_EVEN_IN + 2 * N_ODD_IN;
    for (int rr = gw; rr < NROWS; rr += NGW) {
        int l, prow; const bf16_t* wt;
        if (rr < 2 * N_EVEN_IN) { const int li = rr / N_EVEN_IN; prow = rr % N_EVEN_IN; l = 2 * li; wt = (const bf16_t*)(F.ws + WS_WIE) + ((size_t)li * N_EVEN_IN + prow) * DM; }
        else { const int r2 = rr - 2 * N_EVEN_IN, li = r2 / N_ODD_IN; prow = r2 % N_ODD_IN; l = 2 * li + 1; wt = (const bf16_t*)(F.ws + WS_WIO) + ((size_t)li * N_ODD_IN + prow) * DM; }
        float w[4][8];
#pragma unroll
        for (int i = 0; i < 4; ++i) { const u32x4 v = *(const GAS u32x4*)(wt + 8 * (F.lane + 64 * i));
            w[i][0] = __uint_as_float(v.x << 16); w[i][1] = __uint_as_float(v.x & 0xffff0000u); w[i][2] = __uint_as_float(v.y << 16); w[i][3] = __uint_as_float(v.y & 0xffff0000u);
            w[i][4] = __uint_as_float(v.z << 16); w[i][5] = __uint_as_float(v.z & 0xffff0000u); w[i][6] = __uint_as_float(v.w << 16); w[i][7] = __uint_as_float(v.w & 0xffff0000u); }
        for (int b = 0; b < NSEQ; ++b) {
            const float* sp = mod + ((size_t)l * NSEQ + b) * MODW; float s = 0.f;
#pragma unroll
            for (int i = 0; i < 4; ++i) { const f32x4 s0 = *(const f32x4*)(sp + 8 * (F.lane + 64 * i)), s1 = *(const f32x4*)(sp + 8 * (F.lane + 64 * i) + 4);
                s += w[i][0] * s0[0] + w[i][1] * s0[1] + w[i][2] * s0[2] + w[i][3] * s0[3] + w[i][4] * s1[0] + w[i][5] * s1[1] + w[i][6] * s1[2] + w[i][7] * s1[3]; }
            s = wave_sum(s);
            if (F.lane == 0) shw[((size_t)l * NSEQ + b) * SHW_LD + prow] = s;
        }
    }
    const float* g0 = args.in[10]; float* partss = (float*)(F.ws + WS_PARTSS); bf16_t* A = (bf16_t*)(F.ws + WS_A);
    for (int row = gw; row < MP + MS; row += NGW) {
        const float* xr = row < MP ? args.in[0] + (size_t)row * DM : args.in[1] + (size_t)(row - MP) * DM;
        const int b = row < MP ? row / T_P : NB_P + (row - MP) / T_S;
        const float* scl = mod + ((size_t)0 * NSEQ + b) * MODW + DM; float ss = 0.f;
#pragma unroll
        for (int i = 0; i < 8; ++i) { const int c = 4 * (F.lane + 64 * i);
            const f32x4 x = *(const f32x4*)(xr + c), g = *(const f32x4*)(g0 + c), s = *(const f32x4*)(scl + c);
            ss += (x[0] * x[0] + x[1] * x[1]) + (x[2] * x[2] + x[3] * x[3]);
            const f32x4 a = x * (g * (s + 1.0f)); u32x2 o; o.x = pk2(a[0], a[1]); o.y = pk2(a[2], a[3]);
            *(GAS u32x2*)(A + (size_t)row * DM + c) = o; }
        ss = wave_sum(ss);
        if (row < MP) { if (F.lane < NPART) partss[(size_t)row * NPART + F.lane] = F.lane == 0 ? ss : 0.f; }
        else ((float*)(F.ws + WS_PSS_S))[(size_t)(row - MP) * 64 + F.lane] = F.lane == 0 ? ss : 0.f;
    }
}

__device__ __forceinline__ void att_phase(Frame& F) {
    using bf = at::bf16;
    const bf* QR = (const bf*)(F.ws + WS_QR); const bf* KR = (const bf*)(F.ws + WS_KR); const bf* VB = (const bf*)(F.ws + WS_VB);
    bf* OP = (bf*)(F.ws + WS_OPART); float* ML = (float*)(F.ws + WS_ML);
    const int cls = (int)blockIdx.x & 7, idx = (int)blockIdx.x >> 3, per = F.G >> 3;
    for (int q = idx; q < 96; q += per) {
        const int bh = 2 * cls + q / 48, w = q % 48, pat = w >> 4, z = w & 15;
        const int b = bh >> 3, h = bh & 7;
        const int dil = pat == 0 ? 1 : pat == 1 ? 4 : 16;
        const int nblk = 16 / dil;
        const int res = z / nblk, blk = z % nblk;
        const int ld = dil * D_ATTN, skv = T_P / dil, P0 = blk * at::QB;
        const size_t base = ((size_t)b * T_P + res) * D_ATTN + h * HD;
        at::BlockRef<bf, bf> cur;
        cur.Q = QR + base + (size_t)P0 * ld; cur.K = KR + base; cur.V = VB + base;
        cur.O = OP + (size_t)pat * MP * D_ATTN + base + (size_t)P0 * ld;
        cur.ML = ML + (((size_t)pat * MP + (size_t)b * T_P + res + (size_t)P0 * dil) * NH + h) * 2;
        cur.P0 = P0;
        at::Seam<bf> S;
        at::causal_swa_prime<bf, bf>(cur, at::WINDOW, F.ldsg, S, ld, F.tid);
        at::causal_swa_block<bf, bf>(cur, cur, skv, at::WINDOW, F.ldsg, S, ld, dil * NH, F.tid);
    }
}

__device__ __forceinline__ void cmb_phase(Frame& F, const Args& args, int li) {
    const int gw = F.vcu * NWAVES + F.wave, NGW = F.G * NWAVES;
    const bf16_t* OP = (const bf16_t*)(F.ws + WS_OPART); const float* ML = (const float*)(F.ws + WS_ML);
    const bf16_t* GA = (const bf16_t*)(F.ws + WS_GA); bf16_t* MG = (bf16_t*)(F.ws + WS_MERGED);
    constexpr float C2 = 1.4426950408889634f * 0.08838834764831845f;
    for (int row = gw; row < MP; row += NGW) {
        const int h = F.lane >> 3;
        float m[3], l[3];
#pragma unroll
        for (int p = 0; p < 3; ++p) { const float* q = ML + (((size_t)p * MP + row) * NH + h) * 2; m[p] = q[0]; l[p] = q[1]; }
        const float mm = fmaxf(m[0], fmaxf(m[1], m[2]));
        float w[3]; float ws = 0.f;
#pragma unroll
        for (int p = 0; p < 3; ++p) { w[p] = __builtin_amdgcn_exp2f((m[p] - mm) * C2) * l[p]; ws += w[p]; }
        const float inv = 1.f / ws;
        float o[16];
#pragma unroll
        for (int e = 0; e < 16; ++e) o[e] = 0.f;
#pragma unroll
        for (int p = 0; p < 3; ++p) { const float wp = w[p] * inv; const bf16_t* src = OP + ((size_t)p * MP + row) * D_ATTN + 16 * F.lane;
#pragma unroll
            for (int hh = 0; hh < 2; ++hh) { const u32x4 v = *(const GAS u32x4*)(src + 8 * hh);
                o[8 * hh + 0] += wp * __uint_as_float(v.x << 16); o[8 * hh + 1] += wp * __uint_as_float(v.x & 0xffff0000u);
                o[8 * hh + 2] += wp * __uint_as_float(v.y << 16); o[8 * hh + 3] += wp * __uint_as_float(v.y & 0xffff0000u);
                o[8 * hh + 4] += wp * __uint_as_float(v.z << 16); o[8 * hh + 5] += wp * __uint_as_float(v.z & 0xffff0000u);
                o[8 * hh + 6] += wp * __uint_as_float(v.w << 16); o[8 * hh + 7] += wp * __uint_as_float(v.w & 0xffff0000u); } }
#pragma unroll
        for (int hh = 0; hh < 2; ++hh) { const u32x4 g = *(const GAS u32x4*)(GA + (size_t)row * D_ATTN + 16 * F.lane + 8 * hh); u32x4 r;
            r.x = pk2(o[8 * hh + 0] * __uint_as_float(g.x << 16), o[8 * hh + 1] * __uint_as_float(g.x & 0xffff0000u));
            r.y = pk2(o[8 * hh + 2] * __uint_as_float(g.y << 16), o[8 * hh + 3] * __uint_as_float(g.y & 0xffff0000u));
            r.z = pk2(o[8 * hh + 4] * __uint_as_float(g.z << 16), o[8 * hh + 5] * __uint_as_float(g.z & 0xffff0000u));
            r.w = pk2(o[8 * hh + 6] * __uint_as_float(g.w << 16), o[8 * hh + 7] * __uint_as_float(g.w & 0xffff0000u));
            *(GAS u32x4*)(MG + (size_t)row * DM + 16 * F.lane + 8 * hh) = r; }
    }
    const bf16_t* UB = (const bf16_t*)(F.ws + WS_UB); const bf16_t* GP = (const bf16_t*)(F.ws + WS_GP);
    const bf16_t* PW = (const bf16_t*)(F.ws + WS_WPW) + (size_t)li * 4 * PG * PG;
    const float* pscale = args.in[14] + (size_t)li * D_POOL;
    constexpr int LDA = 264;
    LAS bf16_t* Us = (LAS bf16_t*)F.lds;
    LAS bf16_t* As = (LAS bf16_t*)(F.lds + 40960);
    for (int u = F.vcu; u < (MP / 64) * 4; u += F.G) {
        const int rt = u >> 2, g = u & 3, R0 = rt * 64, t0 = R0 & (T_P - 1), wlen = 2 << g;
        __syncthreads();
        for (int i = F.tid; i < 79 * 32; i += NWAVES * 64) { const int rr = i >> 5, ck = i & 31, t = t0 - 15 + rr; u32x4 v = {0u, 0u, 0u, 0u};
            if (t >= 0) v = *(const GAS u32x4*)(UB + (size_t)(R0 - 15 + rr) * D_POOL + 256 * g + 8 * ck);
            *(LAS u32x4*)(Us + rr * 256 + 8 * ck) = v; }
        __syncthreads();
        for (int i = F.tid; i < 64 * 128; i += NWAVES * 64) { const int row = i >> 7, cp = i & 127; float s0 = 0.f, s1 = 0.f;
            for (int j = 0; j < wlen; ++j) { const unsigned v = *(const LAS unsigned*)(Us + (row + 15 - j) * 256 + 2 * cp); s0 += __uint_as_float(v << 16); s1 += __uint_as_float(v & 0xffff0000u); }
            const unsigned vc = *(const LAS unsigned*)(Us + (row + 15) * 256 + 2 * cp); const int t = t0 + row; const float ic = 1.f / (float)((t + 1) < wlen ? (t + 1) : wlen);
            *(LAS unsigned*)(As + row * LDA + 2 * cp) = pk2(s0 * ic - __uint_as_float(vc << 16), s1 * ic - __uint_as_float(vc & 0xffff0000u)); }
        __syncthreads();
        f32x4 acc[4][2];
#pragma unroll
        for (int mt = 0; mt < 4; ++mt) { acc[mt][0] = (f32x4){0.f, 0.f, 0.f, 0.f}; acc[mt][1] = (f32x4){0.f, 0.f, 0.f, 0.f}; }
        const int fr = F.lane & 15, fq = F.lane >> 4;
#pragma unroll 2
        for (int ks = 0; ks < 8; ++ks) {
            bf16x8 a[4], bb[2];
#pragma unroll
            for (int mt = 0; mt < 4; ++mt) a[mt] = *(const LAS bf16x8*)(As + (16 * mt + fr) * LDA + 32 * ks + 8 * fq);
#pragma unroll
            for (int nt = 0; nt < 2; ++nt) bb[nt] = *(const GAS bf16x8*)(PW + ((size_t)g * PG + 32 * F.wave + 16 * nt + fr) * PG + 32 * ks + 8 * fq);
#pragma unroll
            for (int mt = 0; mt < 4; ++mt)
#pragma unroll
                for (int nt = 0; nt < 2; ++nt) acc[mt][nt] = __builtin_amdgcn_mfma_f32_16x16x32_bf16(bb[nt], a[mt], acc[mt][nt], 0, 0, 0);
        }
#pragma unroll
        for (int nt = 0; nt < 2; ++nt) { const int col = 256 * g + 32 * F.wave + 16 * nt + 4 * fq; const f32x4 ps = *(const f32x4*)(pscale + col);
#pragma unroll
            for (int mt = 0; mt < 4; ++mt) { const int row = R0 + 16 * mt + fr; const u32x2 gv = *(const GAS u32x2*)(GP + (size_t)row * D_POOL + col); const f32x4 v = acc[mt][nt] * ps; u32x2 o;
                o.x = pk2(v[0] * __uint_as_float(gv.x << 16), v[1] * __uint_as_float(gv.x & 0xffff0000u)); o.y = pk2(v[2] * __uint_as_float(gv.y << 16), v[3] * __uint_as_float(gv.y & 0xffff0000u));
                *(GAS u32x2*)(MG + (size_t)row * DM + D_ATTN + col) = o; } }
    }
    __syncthreads();
}

__device__ __forceinline__ void cnv_phase(Frame& F, const Args& args, int li) {
    const bf16_t* UO = (const bf16_t*)(F.ws + WS_UO); const bf16_t* ZO = (const bf16_t*)(F.ws + WS_ZO); bf16_t* MG = (bf16_t*)(F.ws + WS_MERGED);
    const float* cw = args.in[16] + (size_t)li * 3 * D_CONV;
    for (int u = F.vcu; u < MP / 32; u += F.G) {
        const int cgp = F.tid & 255, rh = F.tid >> 8, r0 = u * 32 + rh * 16, c = 8 * cgp;
        float w0[8], w1[8], w2[8];
#pragma unroll
        for (int e = 0; e < 8; ++e) { w0[e] = cw[c + e]; w1[e] = cw[D_CONV + c + e]; w2[e] = cw[2 * D_CONV + c + e]; }
        float zm2[8], zm1[8];
        { const int t = r0 & (T_P - 1); u32x4 a = {0u, 0u, 0u, 0u}, b = {0u, 0u, 0u, 0u};
          if (t >= 2) a = *(const GAS u32x4*)(ZO + (size_t)(r0 - 2) * D_CONV + c);
          if (t >= 1) b = *(const GAS u32x4*)(ZO + (size_t)(r0 - 1) * D_CONV + c);
          zm2[0] = __uint_as_float(a.x << 16); zm2[1] = __uint_as_float(a.x & 0xffff0000u); zm2[2] = __uint_as_float(a.y << 16); zm2[3] = __uint_as_float(a.y & 0xffff0000u);
          zm2[4] = __uint_as_float(a.z << 16); zm2[5] = __uint_as_float(a.z & 0xffff0000u); zm2[6] = __uint_as_float(a.w << 16); zm2[7] = __uint_as_float(a.w & 0xffff0000u);
          zm1[0] = __uint_as_float(b.x << 16); zm1[1] = __uint_as_float(b.x & 0xffff0000u); zm1[2] = __uint_as_float(b.y << 16); zm1[3] = __uint_as_float(b.y & 0xffff0000u);
          zm1[4] = __uint_as_float(b.z << 16); zm1[5] = __uint_as_float(b.z & 0xffff0000u); zm1[6] = __uint_as_float(b.w << 16); zm1[7] = __uint_as_float(b.w & 0xffff0000u); }
#pragma unroll 4
        for (int i = 0; i < 16; ++i) { const size_t off = (size_t)(r0 + i) * D_CONV + c;
            const u32x4 zv = *(const GAS u32x4*)(ZO + off), uv = *(const GAS u32x4*)(UO + off);
            float z[8], uu[8];
            z[0] = __uint_as_float(zv.x << 16); z[1] = __uint_as_float(zv.x & 0xffff0000u); z[2] = __uint_as_float(zv.y << 16); z[3] = __uint_as_float(zv.y & 0xffff0000u);
            z[4] = __uint_as_float(zv.z << 16); z[5] = __uint_as_float(zv.z & 0xffff0000u); z[6] = __uint_as_float(zv.w << 16); z[7] = __uint_as_float(zv.w & 0xffff0000u);
            uu[0] = __uint_as_float(uv.x << 16); uu[1] = __uint_as_float(uv.x & 0xffff0000u); uu[2] = __uint_as_float(uv.y << 16); uu[3] = __uint_as_float(uv.y & 0xffff0000u);
            uu[4] = __uint_as_float(uv.z << 16); uu[5] = __uint_as_float(uv.z & 0xffff0000u); uu[6] = __uint_as_float(uv.w << 16); uu[7] = __uint_as_float(uv.w & 0xffff0000u);
            float y[8];
#pragma unroll
            for (int e = 0; e < 8; ++e) { y[e] = uu[e] * (w0[e] * zm2[e] + w1[e] * zm1[e] + w2[e] * z[e]); zm2[e] = zm1[e]; zm1[e] = z[e]; }
            u32x4 o; o.x = pk2(y[0], y[1]); o.y = pk2(y[2], y[3]); o.z = pk2(y[4], y[5]); o.w = pk2(y[6], y[7]);
            *(GAS u32x4*)(MG + off) = o; }
    }
}

__device__ __forceinline__ void fin_phase(Frame& F, const Args& args) {
    const int gw = F.vcu * NWAVES + F.wave, NGW = F.G * NWAVES;
    const float* partss = (const float*)(F.ws + WS_PARTSS); const float* fg = args.in[18]; float* y = F.out + O_YP;
    for (int row = gw; row < MP; row += NGW) {
        float s = F.lane < NPART ? partss[(size_t)row * NPART + F.lane] : 0.f; s = wave_sum(s);
        const float rstd = rsqrtf(s * (1.0f / DM) + EPS);
#pragma unroll
        for (int i = 0; i < 8; ++i) { const int c = 4 * (F.lane + 64 * i); f32x4 x = *(const f32x4*)(y + (size_t)row * DM + c); const f32x4 g = *(const f32x4*)(fg + c);
            x = x * rstd * g; *(f32x4*)(y + (size_t)row * DM + c) = x; }
    }
}

constexpr int SRAW_LD = 8192, NPS = 64;
constexpr float ATT_SCALE = 0.08838834764831845f;

template <int KIND, class Epi>
__device__ __forceinline__ void skinny_gemm(Frame& F, const bf16_t* As, const bf16_t* Bt, int N, const Epi& E) {
    LAS f32x4* red = (LAS f32x4*)F.lds;
    const int fr = F.lane & 15, fq = F.lane >> 4;
    for (int grp = F.vcu; grp < N / 32; grp += F.G) {
        const int c0 = grp * 32;
        f32x4 acc[4][2];
#pragma unroll
        for (int mt = 0; mt < 4; ++mt) { acc[mt][0] = (f32x4){0.f, 0.f, 0.f, 0.f}; acc[mt][1] = (f32x4){0.f, 0.f, 0.f, 0.f}; }
        const bf16_t* bp[2];
#pragma unroll
        for (int nt = 0; nt < 2; ++nt) { const int c = c0 + 16 * nt + fr; const int prow = KIND == WK_IE ? phys_ie(c) : KIND == WK_IO ? phys_io(c) : phys_out(c); bp[nt] = Bt + (size_t)prow * DM + 256 * F.wave + 8 * fq; }
        const bf16_t* ap = As + (size_t)fr * DM + 256 * F.wave + 8 * fq;
#pragma unroll 4
        for (int ks = 0; ks < 8; ++ks) {
            bf16x8 a[4], b[2];
#pragma unroll
            for (int nt = 0; nt < 2; ++nt) b[nt] = *(const GAS bf16x8*)(bp[nt] + 32 * ks);
#pragma unroll
            for (int mt = 0; mt < 4; ++mt) a[mt] = *(const GAS bf16x8*)(ap + (size_t)mt * 16 * DM + 32 * ks);
#pragma unroll
            for (int mt = 0; mt < 4; ++mt)
#pragma unroll
                for (int nt = 0; nt < 2; ++nt) acc[mt][nt] = __builtin_amdgcn_mfma_f32_16x16x32_bf16(b[nt], a[mt], acc[mt][nt], 0, 0, 0);
        }
        __syncthreads();
#pragma unroll
        for (int mt = 0; mt < 4; ++mt)
#pragma unroll
            for (int nt = 0; nt < 2; ++nt) red[(F.wave * 8 + mt * 2 + nt) * 64 + F.lane] = acc[mt][nt];
        __syncthreads();
        { const int s = F.tid >> 6, l2 = F.tid & 63; f32x4 sum = red[s * 64 + l2];
#pragma unroll
          for (int w = 1; w < NWAVES; ++w) sum += red[(w * 8 + s) * 64 + l2];
          const int m = 16 * (s >> 1) + (l2 & 15), c = c0 + 16 * (s & 1) + 4 * (l2 >> 4);
          E(m, c, sum, grp, F); }
    }
    __syncthreads();
}
__device__ __forceinline__ LAS float* sample_rstd_table(Frame& F) {
    LAS float* rs = (LAS float*)(F.lds + 65536 + 4096);
    const float* pss = (const float*)(F.ws + WS_PSS_S);
    { const int row = F.tid >> 3, j = F.tid & 7; const f32x4 a = *(const f32x4*)(pss + row * NPS + 8 * j), b = *(const f32x4*)(pss + row * NPS + 8 * j + 4);
      float s = (a[0] + a[1]) + (a[2] + a[3]) + (b[0] + b[1]) + (b[2] + b[3]); s += __shfl_xor(s, 1); s += __shfl_xor(s, 2); s += __shfl_xor(s, 4);
      if (j == 0) rs[row] = rsqrtf(s * (1.0f / DM) + EPS); }
    __syncthreads();
    return rs;
}
template <int KIND> struct EpiSRaw {
    const float* shw; LAS float* rs; float* sraw;
    __device__ __forceinline__ void operator()(int m, int c, f32x4 sum, int grp, Frame& F) const {
        const int seq = NB_P + (m >> 3); const int prow = KIND == WK_IE ? phys_ie(c) : phys_io(c);
        const f32x4 sh = *(const f32x4*)(shw + (size_t)seq * SHW_LD + prow);
        *(f32x4*)(sraw + (size_t)m * SRAW_LD + c) = sum * rs[m] + sh;
    }
};
struct EpiSG2 {
    const float* xin; float* xout; bf16_t* anext; const float* modl; const float* modn; const float* gn; float* pss;
    __device__ __forceinline__ void operator()(int m, int c, f32x4 sum, int grp, Frame& F) const {
        LAS float* sq = (LAS float*)(F.lds + 65536);
        const int seq = NB_P + (m >> 3);
        const f32x4 gt = *(const f32x4*)(modl + (size_t)seq * MODW + 2 * DM + c), x0 = *(const f32x4*)(xin + (size_t)m * DM + c);
        const f32x4 y = x0 + gt * sum;
        *(f32x4*)(xout + (size_t)m * DM + c) = y;
        if (anext) { const f32x4 sc = *(const f32x4*)(modn + (size_t)seq * MODW + DM + c), g = *(const f32x4*)(gn + c); const f32x4 a = y * (g * (sc + 1.0f));
            u32x2 o; o.x = pk2(a[0], a[1]); o.y = pk2(a[2], a[3]); *(GAS u32x2*)(anext + (size_t)m * DM + c) = o; }
        sq[m * 8 + ((c >> 2) & 7)] = (y[0] * y[0] + y[1] * y[1]) + (y[2] * y[2] + y[3] * y[3]);
        __syncthreads();
        if (F.tid < 64) { const f32x4 a = *(const LAS f32x4*)(sq + F.tid * 8), b = *(const LAS f32x4*)(sq + F.tid * 8 + 4); pss[F.tid * NPS + grp] = (a[0] + a[1]) + (a[2] + a[3]) + (b[0] + b[1]) + (b[2] + b[3]); }
    }
};

__device__ __forceinline__ void satt_phase(Frame& F, const Args& args, int li) {
    const float* sraw = (const float*)(F.ws + WS_SRAW);
    const float* rope_c = (const float*)(F.ws + WS_ROPE) + (size_t)T_P * 64; const float* rope_s = rope_c + (size_t)ROPE_ROWS * 64;
    const float* stk = args.in[4] + (size_t)li * NB_S * WBUF * D_ATTN; const float* stv = args.in[5] + (size_t)li * NB_S * WBUF * D_ATTN;
    float* sop = (float*)(F.ws + WS_SOP); float* sml = (float*)(F.ws + WS_SML);
    LAS float* qs = (LAS float*)F.lds; LAS float* ks = qs + 8 * 128; LAS float* vs = ks + 8 * 128; LAS float* scw = vs + 8 * 128 + F.wave * 136;
    for (int u = F.vcu; u < NB_S * NH * 3; u += F.G) {
        const int p = u % 3, bh = u / 3, b = bh >> 3, h = bh & 7, dil = p == 0 ? 1 : p == 1 ? 4 : 16;
        __syncthreads();
        { const int row = F.tid >> 6, d2 = F.tid & 63, m = b * T_S + row; const float c = rope_c[row * 64 + d2], s = rope_s[row * 64 + d2];
          const float* src = sraw + (size_t)m * SRAW_LD + h * HD + d2;
          const float q1 = src[0], q2 = src[64], k1 = src[D_ATTN], k2 = src[D_ATTN + 64], v1 = src[2 * D_ATTN], v2 = src[2 * D_ATTN + 64];
          const float kr1 = k1 * c - k2 * s, kr2 = k2 * c + k1 * s;
          qs[row * 128 + d2] = (q1 * c - q2 * s) * ATT_SCALE; qs[row * 128 + 64 + d2] = (q2 * c + q1 * s) * ATT_SCALE;
          ks[row * 128 + d2] = kr1; ks[row * 128 + 64 + d2] = kr2; vs[row * 128 + d2] = v1; vs[row * 128 + 64 + d2] = v2;
          if (p == 0) { const size_t o = (((size_t)li * NB_S + b) * T_S + row) * D_ATTN + h * HD + d2;
              F.out[O_NKS + o] = kr1; F.out[O_NKS + o + 64] = kr2; F.out[O_NVS + o] = v1; F.out[O_NVS + o + 64] = v2; } }
        __syncthreads();
        const int t = F.wave, jn = t / dil + 1, m = b * T_S + t;
        const float q0 = qs[t * 128 + 2 * F.lane], q1 = qs[t * 128 + 2 * F.lane + 1];
        const float* kb = stk + (((size_t)b * WBUF) * NH + h) * HD + 2 * F.lane;
        const float* vb = stv + (((size_t)b * WBUF) * NH + h) * HD + 2 * F.lane;
        for (int j = 0; j < jn; ++j) { const int r = t - j * dil; float s = q0 * ks[r * 128 + 2 * F.lane] + q1 * ks[r * 128 + 2 * F.lane + 1]; s = wave_sum(s); if (F.lane == 0) scw[j] = s; }
        for (int j0 = jn; j0 < 129; j0 += 16) {
            float kx[16], ky[16];
#pragma unroll
            for (int i = 0; i < 16; ++i) { const int j = j0 + i; kx[i] = 0.f; ky[i] = 0.f;
                if (j < 129) { const int idx = WBUF + t - j * dil; const float* kp = kb + (size_t)idx * D_ATTN; kx[i] = kp[0]; ky[i] = kp[1]; } }
#pragma unroll
            for (int i = 0; i < 16; ++i) { const int j = j0 + i; float s = q0 * kx[i] + q1 * ky[i]; s = wave_sum(s); if (j < 129 && F.lane == 0) scw[j] = s; }
        }
        LDS_WAIT();
        float mx = -1e30f;
        for (int j = F.lane; j < 129; j += 64) mx = fmaxf(mx, scw[j]);
#pragma unroll
        for (int o = 1; o < 64; o <<= 1) mx = fmaxf(mx, __shfl_xor(mx, o));
        float ls = 0.f;
        for (int j = F.lane; j < 129; j += 64) { const float pv = __expf(scw[j] - mx); scw[j] = pv; ls += pv; }
        ls = wave_sum(ls);
        LDS_WAIT();
        float o0 = 0.f, o1 = 0.f;
        for (int j = 0; j < jn; ++j) { const int r = t - j * dil; const float pv = scw[j]; o0 += pv * vs[r * 128 + 2 * F.lane]; o1 += pv * vs[r * 128 + 2 * F.lane + 1]; }
        for (int j0 = jn; j0 < 129; j0 += 16) {
            float vx[16], vy[16];
#pragma unroll
            for (int i = 0; i < 16; ++i) { const int j = j0 + i; vx[i] = 0.f; vy[i] = 0.f;
                if (j < 129) { const int idx = WBUF + t - j * dil; const float* vp = vb + (size_t)idx * D_ATTN; vx[i] = vp[0]; vy[i] = vp[1]; } }
#pragma unroll
            for (int i = 0; i < 16; ++i) { const int j = j0 + i; const float pv = j < 129 ? scw[j] : 0.f; o0 += pv * vx[i]; o1 += pv * vy[i]; }
        }
        float* op = sop + (((size_t)m * NH + h) * 3 + p) * HD + 2 * F.lane; op[0] = o0; op[1] = o1;
        if (F.lane == 0) { float* mp = sml + (((size_t)m * NH + h) * 3 + p) * 2; mp[0] = mx; mp[1] = ls; }
    }
    __syncthreads();
}
__device__ __forceinline__ void scmb_phase(Frame& F, const Args& args, int li) {
    const float* sraw = (const float*)(F.ws + WS_SRAW); bf16_t* smg = (bf16_t*)(F.ws + WS_SMG);
    const float* sop = (const float*)(F.ws + WS_SOP); const float* sml = (const float*)(F.ws + WS_SML);
    const int gw = F.vcu * NWAVES + F.wave;
    if (gw < MS * NH) { const int m = gw >> 3, h = gw & 7; float mm[3], ll[3];
#pragma unroll
        for (int p = 0; p < 3; ++p) { const float* q = sml + (((size_t)m * NH + h) * 3 + p) * 2; mm[p] = q[0]; ll[p] = q[1]; }
        const float M = fmaxf(mm[0], fmaxf(mm[1], mm[2])); float o0 = 0.f, o1 = 0.f, den = 0.f;
#pragma unroll
        for (int p = 0; p < 3; ++p) { const float w = __expf(mm[p] - M); den += w * ll[p]; const float* op = sop + (((size_t)m * NH + h) * 3 + p) * HD + 2 * F.lane; o0 += w * op[0]; o1 += w * op[1]; }
        const float inv = 1.f / den; const float* ga = sraw + (size_t)m * SRAW_LD + 3 * D_ATTN + h * HD + 2 * F.lane;
        *(GAS unsigned*)(smg + (size_t)m * DM + h * HD + 2 * F.lane) = pk2(o0 * inv * silu_f(ga[0]), o1 * inv * silu_f(ga[1])); }
    const float* stp = args.in[6] + (size_t)li * NB_S * 15 * D_POOL; const float* pw = args.in[13] + (size_t)li * 4 * PG * PG; const float* psc = args.in[14] + (size_t)li * D_POOL;
    LAS float* pooled = (LAS float*)F.lds;
    for (int m = F.vcu; m < MS; m += F.G) {
        const int b = m >> 3, t = m & 7;
        __syncthreads();
#pragma unroll
        for (int i = 0; i < 2; ++i) { const int c = F.tid + 512 * i, w = 2 << (c >> 8); float s = 0.f;
            for (int j = 0; j < w; ++j) { const int tt = t - j; s += tt >= 0 ? sraw[(size_t)(b * T_S + tt) * SRAW_LD + 4 * D_ATTN + c] : stp[((size_t)b * 15 + 15 + tt) * D_POOL + c]; }
            pooled[c] = s / (float)w - sraw[(size_t)m * SRAW_LD + 4 * D_ATTN + c]; }
        __syncthreads();
#pragma unroll
        for (int i = 0; i < 2; ++i) { const int d = F.tid + 512 * i, gi = d >> 8, dc = d & 255; const float* wp = pw + (size_t)gi * PG * PG + dc; float s = 0.f;
#pragma unroll 8
            for (int c = 0; c < PG; ++c) s += pooled[gi * PG + c] * wp[(size_t)c * PG];
            const float gp = sraw[(size_t)m * SRAW_LD + 4 * D_ATTN + D_POOL + d];
            smg[(size_t)m * DM + D_ATTN + d] = (bf16_t)f2bf(s * psc[d] * silu_f(gp)); }
        if (t == 0) { float* np = F.out + O_NPOOLS + ((size_t)li * NB_S + b) * 15 * D_POOL;
            for (int i = F.tid; i < 15 * D_POOL; i += NWAVES * 64) { const int r = i >> 10, c = i & 1023;
                np[i] = r < 7 ? stp[((size_t)b * 15 + 8 + r) * D_POOL + c] : sraw[(size_t)(b * T_S + r - 7) * SRAW_LD + 4 * D_ATTN + c]; } }
    }
    __syncthreads();
}
__device__ __forceinline__ void scnv_phase(Frame& F, const Args& args, int li) {
    const float* sraw = (const float*)(F.ws + WS_SRAW); bf16_t* smg = (bf16_t*)(F.ws + WS_SMG);
    const float* stc = args.in[7] + (size_t)li * NB_S * 2 * D_CONV; const float* cw = args.in[16] + (size_t)li * 3 * D_CONV;
    for (int m = F.vcu; m < MS; m += F.G) {
        const int b = m >> 3, t = m & 7, c = 4 * F.tid;
        f32x4 y = {0.f, 0.f, 0.f, 0.f}, zt = {0.f, 0.f, 0.f, 0.f};
#pragma unroll
        for (int kk = 0; kk < 3; ++kk) { const int tt = t - 2 + kk; f32x4 z;
            if (tt >= 0) { const float* p = sraw + (size_t)(b * T_S + tt) * SRAW_LD; z = *(const f32x4*)(p + D_CONV + c) * *(const f32x4*)(p + 2 * D_CONV + c); }
            else z = *(const f32x4*)(stc + ((size_t)b * 2 + 2 + tt) * D_CONV + c);
            y += z * *(const f32x4*)(cw + kk * D_CONV + c); zt = z; }
        const float* p = sraw + (size_t)m * SRAW_LD; const f32x4 bg = *(const f32x4*)(p + c), g = *(const f32x4*)(p + 3 * D_CONV + c);
        u32x2 o; o.x = pk2(bg[0] * y[0] * silu_f(g[0]), bg[1] * y[1] * silu_f(g[1])); o.y = pk2(bg[2] * y[2] * silu_f(g[2]), bg[3] * y[3] * silu_f(g[3]));
        *(GAS u32x2*)(smg + (size_t)m * DM + c) = o;
        if (t >= T_S - 2) *(f32x4*)(F.out + O_NCONVS + (((size_t)li * NB_S + b) * 2 + (t - (T_S - 2))) * D_CONV + c) = zt;
    }
}
__device__ __forceinline__ void sfin_phase(Frame& F, const Args& args) {
    const int gw = F.vcu * NWAVES + F.wave;
    if (gw < MS) { const float* pss = (const float*)(F.ws + WS_PSS_S); float s = pss[gw * NPS + F.lane]; s = wave_sum(s);
        const float rstd = rsqrtf(s * (1.0f / DM) + EPS); float* y = F.out + O_YS + (size_t)gw * DM; const float* fg = args.in[18];
#pragma unroll
        for (int i = 0; i < 8; ++i) { const int c = 4 * (F.lane + 64 * i); f32x4 x = *(const f32x4*)(y + c); x = x * rstd * *(const f32x4*)(fg + c); *(f32x4*)(y + c) = x; } }
}
constexpr int PH_FIN = 2 + 4 * DEPTH, PH_END = PH_FIN + 1;
__global__ void __launch_bounds__(NWAVES * 64, 2) mk_fwd(Args args) {
    extern __shared__ __attribute__((aligned(16))) unsigned char lds[];
    Frame F0;
    F0.lds = (LAS unsigned char*)lds; F0.ldsg = nullptr;
    F0.wave = __builtin_amdgcn_readfirstlane((int)threadIdx.x >> 6); F0.lane = lane_id(); F0.tid = F0.wave * 64 + F0.lane;
    F0.G = gridDim.x; { const int bx = blockIdx.x; F0.vcu = (F0.G % 8 == 0) ? (bx % 8) * (F0.G / 8) + bx / 8 : bx; }
    F0.out = args.out; F0.ws = args.ws;
    volatile LAS unsigned* MISC = (volatile LAS unsigned*)(F0.lds + MISC_OFF);
    for (int u = F0.tid; u < (LDS_BYTES - LDSCTL_OFF) / 4; u += NWAVES * 64) ((LAS unsigned*)(F0.lds + LDSCTL_OFF))[u] = 0u;
    __syncthreads();
    unsigned* ctl = (unsigned*)(F0.ws + WS_CTL);
    XcdBarrier bar = xcd_barrier_post(ctl + CW_BAR + args.li * XCD_BAR_WORDS, MISC + 8, F0.wave);
    const int lo = args.ph_lo, hi = args.ph_hi;
#define IN(k) (lo <= (k) && (k) < hi)
#define SEAM(k) do { if (IN(k) && (k) + 1 < hi) xcd_barrier(bar); } while (0)
    if (IN(0)) { Frame F = fresh(F0); p0_phase(F, args); } SEAM(0);
    if (IN(1)) { Frame F = fresh(F0); p1_phase(F, args); } SEAM(1);
#pragma unroll 1
    for (int l = 0; l < DEPTH; ++l) {
        const int pb = 2 + 4 * l, li = l >> 1;
        if ((l & 1) == 0) {
            if (IN(pb)) { Frame F = fresh(F0);
                pg8::Gemm g{(const bf16_t*)(F.ws + WS_A), (const bf16_t*)(F.ws + WS_WIE) + (size_t)li * N_EVEN_IN * DM, MP, N_EVEN_IN, DM};
                pg8::StaticOrder S; S.init(MP, N_EVEN_IN, F.G, (int)blockIdx.x);
                const float* rope_c = (const float*)(F.ws + WS_ROPE);
                pg8::EpiG1E E{(const float*)(F.ws + WS_PARTSS), (const float*)(F.ws + WS_SHW) + (size_t)l * NSEQ * SHW_LD, rope_c, rope_c + (size_t)ROPE_ROWS * 64, (bf16_t*)(F.ws + WS_QR),
                              F.out + O_NKP + (size_t)li * NB_P * 2048 * D_ATTN, F.out + O_NVP + (size_t)li * NB_P * 2048 * D_ATTN, F.out + O_NPOOLP + (size_t)li * NB_P * 15 * D_POOL};
                pg8::gemm_phase<pg8::EpiG1E, pg8::StaticOrder, true, true>(F.lds, g, S, E, F.tid);
                { LAS float* rs = sample_rstd_table(F); EpiSRaw<WK_IE> ES{(const float*)(F.ws + WS_SHW) + (size_t)l * NSEQ * SHW_LD, rs, (float*)(F.ws + WS_SRAW)};
                  skinny_gemm<WK_IE>(F, (const bf16_t*)(F.ws + WS_AS), g.Bt, N_EVEN_IN, ES); }
            } SEAM(pb);
            if (IN(pb + 1)) { Frame F = fresh(F0); att_phase(F); } if (IN(pb + 1)) { Frame F = fresh(F0); satt_phase(F, args, li); } SEAM(pb + 1);
            if (IN(pb + 2)) { Frame F = fresh(F0); cmb_phase(F, args, li); } if (IN(pb + 2)) { Frame F = fresh(F0); scmb_phase(F, args, li); } SEAM(pb + 2);
        } else {
            if (IN(pb)) { Frame F = fresh(F0);
                pg8::Gemm g{(const bf16_t*)(F.ws + WS_A), (const bf16_t*)(F.ws + WS_WIO) + (size_t)li * N_ODD_IN * DM, MP, N_ODD_IN, DM};
                pg8::StaticOrder S; S.init(MP, N_ODD_IN, F.G, (int)blockIdx.x);
                pg8::EpiG1O E{(const float*)(F.ws + WS_PARTSS), (const float*)(F.ws + WS_SHW) + (size_t)l * NSEQ * SHW_LD, (bf16_t*)(F.ws + WS_UO), (bf16_t*)(F.ws + WS_ZO), F.out + O_NCONVP + (size_t)li * NB_P * 2 * D_CONV};
                pg8::gemm_phase<pg8::EpiG1O, pg8::StaticOrder, true, true>(F.lds, g, S, E, F.tid);
                { LAS float* rs = sample_rstd_table(F); EpiSRaw<WK_IO> ES{(const float*)(F.ws + WS_SHW) + (size_t)l * NSEQ * SHW_LD, rs, (float*)(F.ws + WS_SRAW)};
                  skinny_gemm<WK_IO>(F, (const bf16_t*)(F.ws + WS_AS), g.Bt, N_ODD_IN, ES); }
            } SEAM(pb);
            if (IN(pb + 1)) { Frame F = fresh(F0); cnv_phase(F, args, li); } if (IN(pb + 1)) { Frame F = fresh(F0); scnv_phase(F, args, li); } SEAM(pb + 1);
        }
        if (IN(pb + 3)) { Frame F = fresh(F0);
            const bf16_t* wt = (const bf16_t*)(F.ws + ((l & 1) ? WS_WOO : WS_WOE)) + (size_t)li * DM * DM;
            pg8::Gemm g{(const bf16_t*)(F.ws + WS_MERGED), wt, MP, DM, DM};
            pg8::StaticOrder S; S.init(MP, DM, F.G, (int)blockIdx.x);
            const bool last = (l == DEPTH - 1); const float* mod = (const float*)(F.ws + WS_MOD);
            pg8::EpiG2 E{l == 0 ? args.in[0] : F.out + O_YP, F.out + O_YP, last ? nullptr : (bf16_t*)(F.ws + WS_A), mod + (size_t)l * NSEQ * MODW,
                         mod + (size_t)(last ? l : l + 1) * NSEQ * MODW, args.in[10] + (size_t)(last ? l : l + 1) * DM, (float*)(F.ws + WS_PARTSS)};
            pg8::gemm_phase<pg8::EpiG2, pg8::StaticOrder, false, true>(F.lds, g, S, E, F.tid);
            { EpiSG2 ES{l == 0 ? args.in[1] : F.out + O_YS, F.out + O_YS, last ? nullptr : (bf16_t*)(F.ws + WS_AS), E.modl, E.modn, E.gn, (float*)(F.ws + WS_PSS_S)};
              __syncthreads(); skinny_gemm<WK_OE>(F, (const bf16_t*)(F.ws + WS_SMG), wt, DM, ES); }
        } SEAM(pb + 3);
    }
    if (IN(PH_FIN)) { Frame F = fresh(F0); fin_phase(F, args); sfin_phase(F, args); }
#undef IN
#undef SEAM
}
__global__ void k_siluc(const float* __restrict__ cp, const float* __restrict__ cs, float* __restrict__ sc) {
    const int i = blockIdx.x * blockDim.x + threadIdx.x;
    if (i < 10 * DM) { const int b = i / DM, k = i % DM; const float c = b < 2 ? cp[b * DM + k] : cs[(b - 2) * DM + k]; sc[i] = silu_f(c); }
}
__global__ void k_ada(const float* __restrict__ sc, const float* __restrict__ aw, const float* __restrict__ ab, float* __restrict__ mod) {
    const int j = blockIdx.x * blockDim.x + threadIdx.x;
    const int l = blockIdx.y;
    if (j >= 3 * DM) return;
    float acc[10];
#pragma unroll
    for (int b = 0; b < 10; ++b) acc[b] = 0.f;
    const float* w = aw + (size_t)l * DM * 3 * DM + j;
    for (int k = 0; k < DM; ++k) {
        const float wv = w[(size_t)k * 3 * DM];
#pragma unroll
        for (int b = 0; b < 10; ++b) {
            acc[b] += sc[b * DM + k] * wv;
        }
    }
#pragma unroll
    for (int b = 0; b < 10; ++b) mod[((size_t)l * 10 + b) * 3 * DM + j] = acc[b] + ab[l * 3 * DM + j];
}

__global__ void k_norm(const float* __restrict__ x, const float* __restrict__ g, const float* __restrict__ modp  , int T, float* __restrict__ h) {
    const int row = blockIdx.x, b = row / T;
    __shared__ float red[256];
    float s = 0.f;
    for (int c = threadIdx.x; c < DM; c += 256) { const float v = x[(size_t)row * DM + c]; s += v * v; }
    red[threadIdx.x] = s; __syncthreads();
    for (int o = 128; o > 0; o >>= 1) { if (threadIdx.x < o) red[threadIdx.x] += red[threadIdx.x + o]; __syncthreads(); }
    const float rstd = rsqrtf(red[0] / DM + EPS);
    for (int c = threadIdx.x; c < DM; c += 256) {
        float v = x[(size_t)row * DM + c] * rstd * g[c];
        if (modp) { const float sh = modp[(size_t)b * 3 * DM + c], sc = modp[(size_t)b * 3 * DM + DM + c]; v = v * (1.f + sc) + sh; }
        h[(size_t)row * DM + c] = v;
    }
}

__global__ void __launch_bounds__(256) k_gemm(const float* __restrict__ A, int lda, const float* __restrict__ W, int ldw, float* __restrict__ C, int ldc, int K) {
    __shared__ float As[16][64 + 4], Ws[16][64 + 4];
    const int tx = threadIdx.x & 15, ty = threadIdx.x >> 4;
    const int m0 = blockIdx.y * 64, n0 = blockIdx.x * 64;
    float acc[4][4] = {};
    for (int k0 = 0; k0 < K; k0 += 16) {
        for (int i = threadIdx.x; i < 64 * 16; i += 256) { const int r = i >> 4, kk = i & 15; As[kk][r] = A[(size_t)(m0 + r) * lda + k0 + kk]; }
        for (int i = threadIdx.x; i < 16 * 64; i += 256) { const int kk = i >> 6, c = i & 63; Ws[kk][c] = W[(size_t)(k0 + kk) * ldw + n0 + c]; }
        __syncthreads();
#pragma unroll
        for (int kk = 0; kk < 16; ++kk) {
            float a[4], w[4];
#pragma unroll
            for (int i = 0; i < 4; ++i) { a[i] = As[kk][ty * 4 + i]; w[i] = Ws[kk][tx * 4 + i]; }
#pragma unroll
            for (int i = 0; i < 4; ++i)
#pragma unroll
                for (int j = 0; j < 4; ++j) acc[i][j] += a[i] * w[j];
        }
        __syncthreads();
    }
#pragma unroll
    for (int i = 0; i < 4; ++i)
#pragma unroll
        for (int j = 0; j < 4; ++j) C[(size_t)(m0 + ty * 4 + i) * ldc + n0 + tx * 4 + j] = acc[i][j];
}

__global__ void k_rotary(float* __restrict__ proj, int T, int pos0) {
    const int row = blockIdx.x, t = row % T;
    const float pos = (float)(pos0 + t);
    for (int i = threadIdx.x; i < 2 * NH * 64; i += blockDim.x) {
        const int which = i / (NH * 64), r = i % (NH * 64), hh = r / 64, dd = r % 64;
        const float inv = powf(10000.f, -(float)dd / 64.f);
        const float ang = pos * inv, c = cosf(ang), s = sinf(ang);
        float* p = proj + (size_t)row * N_EVEN_IN + which * D_ATTN + hh * HD;
        const float x1 = p[dd], x2 = p[dd + 64];
        p[dd] = x1 * c - x2 * s; p[dd + 64] = x2 * c + x1 * s;
    }
}

__global__ void __launch_bounds__(64) k_attn(const float* __restrict__ proj, const float* __restrict__ stk, const float* __restrict__ stv, int T, int npre, float* __restrict__ attn) {
    const int row = blockIdx.x, h = blockIdx.y, b = row / T, t = row % T, lane = threadIdx.x;
    __shared__ float qs[HD];
    __shared__ float ps[3 * 129];
    __shared__ int pidx[3 * 129];
    const float scale = 0.08838834764831845f;
    for (int d = lane; d < HD; d += 64) qs[d] = proj[(size_t)row * N_EVEN_IN + h * HD + d] * scale;
    __syncthreads();
    const int e = npre + t;
    const int dil[3] = {1, 4, 16};
    float mymax = -1e30f;
    for (int i = lane; i < 3 * 129; i += 64) {
        const int p = i / 129, j = i % 129;
        const int idx = e - j * dil[p];
        float s = -1e30f;
        if (idx >= 0) {
            const float* kr = idx < npre ? stk + (((size_t)b * npre + idx) * NH + h) * HD : proj + (size_t)(b * T + idx - npre) * N_EVEN_IN + D_ATTN + h * HD;
            float a = 0.f;
            for (int d = 0; d < HD; ++d) a += qs[d] * kr[d];
            s = a;
        }
        ps[i] = s; pidx[i] = idx;
        mymax = fmaxf(mymax, s);
    }
    for (int o = 32; o > 0; o >>= 1) mymax = fmaxf(mymax, __shfl_xor(mymax, o));
    __syncthreads();
    float mysum = 0.f;
    for (int i = lane; i < 3 * 129; i += 64) { const float pv = pidx[i] >= 0 ? expf(ps[i] - mymax) : 0.f; ps[i] = pv; mysum += pv; }
    for (int o = 32; o > 0; o >>= 1) mysum += __shfl_xor(mysum, o);
    __syncthreads();
    float o0 = 0.f, o1 = 0.f;
    for (int i = 0; i < 3 * 129; ++i) {
        const int idx = pidx[i];
        if (idx < 0) continue;
        const float* vr = idx < npre ? stv + (((size_t)b * npre + idx) * NH + h) * HD : proj + (size_t)(b * T + idx - npre) * N_EVEN_IN + 2 * D_ATTN + h * HD;
        const float pv = ps[i];
        o0 += pv * vr[lane]; o1 += pv * vr[lane + 64];
    }
    attn[(size_t)row * D_ATTN + h * HD + lane] = o0 / mysum;
    attn[(size_t)row * D_ATTN + h * HD + lane + 64] = o1 / mysum;
}

__global__ void k_pooled(const float* __restrict__ proj, const float* __restrict__ prefix, int T, int pos0, float* __restrict__ pooled) {
    const int row = blockIdx.x, b = row / T, t = row % T;
    for (int c = threadIdx.x; c < D_POOL; c += blockDim.x) {
        const int gi = c / PG, w = 2 << gi;
        float s = 0.f;
        for (int j = 0; j < w; ++j) {
            const int tt = t - j;
            float v;
            if (tt >= 0) v = proj[(size_t)(b * T + tt) * N_EVEN_IN + 4 * D_ATTN + c];
            else v = prefix ? prefix[((size_t)b * 15 + (15 + tt)) * D_POOL + c] : 0.f;
            s += v;
        }
        const int pos = pos0 + t;
        const float cnt = (float)(w < pos + 1 ? w : pos + 1);
        pooled[(size_t)row * D_POOL + c] = s / cnt - proj[(size_t)row * N_EVEN_IN + 4 * D_ATTN + c];
    }
}

__global__ void k_merge(const float* __restrict__ proj, const float* __restrict__ attn, const float* __restrict__ mixed, const float* __restrict__ pscale, float* __restrict__ merged, int presilu) {
    const int row = blockIdx.x;
    for (int c = threadIdx.x; c < D_ATTN; c += blockDim.x) {
        { const float ga = proj[(size_t)row * N_EVEN_IN + 3 * D_ATTN + c]; merged[(size_t)row * DM + c] = attn[(size_t)row * D_ATTN + c] * (presilu ? ga : silu_f(ga)); }
        { const float gp = proj[(size_t)row * N_EVEN_IN + 4 * D_ATTN + D_POOL + c]; merged[(size_t)row * DM + D_ATTN + c] = mixed[(size_t)row * D_POOL + c] * pscale[c] * (presilu ? gp : silu_f(gp)); }
    }
}

__global__ void k_resid(float* __restrict__ x, const float* __restrict__ mix, const float* __restrict__ modp, int T) {
    const int row = blockIdx.x, b = row / T;
    for (int c = threadIdx.x; c < DM; c += blockDim.x) x[(size_t)row * DM + c] += modp[(size_t)b * 3 * DM + 2 * DM + c] * mix[(size_t)row * DM + c];
}

__global__ void k_convgate(const float* __restrict__ proj, const float* __restrict__ prefix, const float* __restrict__ cw, int T, float* __restrict__ v, float* __restrict__ newconv) {
    const int row = blockIdx.x, b = row / T, t = row % T;
    for (int c = threadIdx.x; c < D_CONV; c += blockDim.x) {
        float y = 0.f;
        for (int kk = 0; kk < 3; ++kk) {
            const int tt = t - 2 + kk;
            float z;
            if (tt >= 0) { const float* p = proj + (size_t)(b * T + tt) * N_ODD_IN; z = p[D_CONV + c] * p[2 * D_CONV + c]; }
            else z = prefix ? prefix[((size_t)b * 2 + (2 + tt)) * D_CONV + c] : 0.f;
            y += z * cw[kk * D_CONV + c];
        }
        const float* p = proj + (size_t)row * N_ODD_IN;
        v[(size_t)row * DM + c] = p[c] * y * silu_f(p[3 * D_CONV + c]);
        if (t >= T - 2) newconv[((size_t)b * 2 + (t - (T - 2))) * D_CONV + c] = p[D_CONV + c] * p[2 * D_CONV + c];
    }
}

__global__ void k_copykv(const float* __restrict__ proj, int T, int keep, float* __restrict__ ok, float* __restrict__ ov) {
    const int row = blockIdx.x, b = row / T, t = row % T;
    if (t < T - keep) return;
    for (int c = threadIdx.x; c < D_ATTN; c += blockDim.x) {
        ok[((size_t)b * keep + t - (T - keep)) * D_ATTN + c] = proj[(size_t)row * N_EVEN_IN + D_ATTN + c];
        ov[((size_t)b * keep + t - (T - keep)) * D_ATTN + c] = proj[(size_t)row * N_EVEN_IN + 2 * D_ATTN + c];
    }
}
__global__ void k_newpool(const float* __restrict__ proj, const float* __restrict__ prefix, int T, float* __restrict__ out) {
    const int b = blockIdx.x / 15, i = blockIdx.x % 15;
    const int e = T + i;
    for (int c = threadIdx.x; c < D_POOL; c += blockDim.x) {
        float v;
        if (e < 15) v = prefix ? prefix[((size_t)b * 15 + e) * D_POOL + c] : 0.f;
        else v = proj[(size_t)(b * T + e - 15) * N_EVEN_IN + 4 * D_ATTN + c];
        out[((size_t)b * 15 + i) * D_POOL + c] = v;
    }
}


__global__ void k_adapt_g1e(const bf16_t* __restrict__ QR, const bf16_t* __restrict__ KR, const bf16_t* __restrict__ VB, const bf16_t* __restrict__ GA, const bf16_t* __restrict__ UB, const bf16_t* __restrict__ GP, float* __restrict__ proj) {
    const int row = blockIdx.x;
    for (int c = threadIdx.x; c < D_ATTN; c += blockDim.x) {
        float* p = proj + (size_t)row * N_EVEN_IN; const size_t o = (size_t)row * D_ATTN + c;
        p[c] = bf2f(QR[o]); p[D_ATTN + c] = bf2f(KR[o]); p[2 * D_ATTN + c] = bf2f(VB[o]); p[3 * D_ATTN + c] = bf2f(GA[o]); p[4 * D_ATTN + c] = bf2f(UB[o]); p[5 * D_ATTN + c] = bf2f(GP[o]);
    }
}
__global__ void k_bf2f(const bf16_t* __restrict__ src, float* __restrict__ dst, size_t n) {
    for (size_t i = (size_t)blockIdx.x * blockDim.x + threadIdx.x; i < n; i += (size_t)gridDim.x * blockDim.x) dst[i] = bf2f(src[i]);
}
#ifndef MK_UPTO
#define MK_UPTO 19
#endif
struct NaiveBufs { float *xb, *hb, *proj, *attn, *pooled, *mixed, *merged, *mix, *scb, *mod; };
struct Trunk {
    int B, T, pos0, npre; const float* x_in; const float* st_k; const float* st_v; const float* st_pool; const float* st_conv; int bmod0;
    float *y, *nk, *nv, *npool, *nconv; size_t nk_l, npool_l, nconv_l; int keep;
};
static void naive_run(const Trunk& R, const NaiveBufs& N, void* const* d_in, int l0, int s0, bool final_norm, hipStream_t stream) {
    const float* norm_g = (const float*)d_in[10]; const float* w_in_even = (const float*)d_in[11]; const float* w_out_even = (const float*)d_in[12];
    const float* pool_w = (const float*)d_in[13]; const float* pool_scale = (const float*)d_in[14];
    const float* w_in_odd = (const float*)d_in[15]; const float* conv_w = (const float*)d_in[16]; const float* w_out_odd = (const float*)d_in[17]; const float* final_g = (const float*)d_in[18];
    const int M = R.B * R.T;
    for (int l = l0; l < DEPTH; ++l) {
        const int li = l / 2, s = (l == l0) ? s0 : 0;
        const float* modp = N.mod + ((size_t)l * 10 + R.bmod0) * 3 * DM;
        if (s == 0) k_norm<<<M, 256, 0, stream>>>(N.xb, norm_g + l * DM, modp, R.T, N.hb);
        if (l % 2 == 0) {
            if (s == 0) {
                k_gemm<<<dim3(N_EVEN_IN / 64, M / 64), 256, 0, stream>>>(N.hb, DM, w_in_even + (size_t)li * DM * N_EVEN_IN, N_EVEN_IN, N.proj, N_EVEN_IN, DM);
                k_rotary<<<M, 256, 0, stream>>>(N.proj, R.T, R.pos0);
                k_copykv<<<M, 256, 0, stream>>>(N.proj, R.T, R.keep, R.nk + li * R.nk_l, R.nv + li * R.nk_l);
            }
            if (s <= 1) {
                const float* sk = R.st_k ? R.st_k + (size_t)li * NB_S * WBUF * D_ATTN : nullptr;
                const float* sv = R.st_v ? R.st_v + (size_t)li * NB_S * WBUF * D_ATTN : nullptr;
                k_attn<<<dim3(M, NH), 64, 0, stream>>>(N.proj, sk, sv, R.T, R.npre, N.attn);
                const float* pp = R.st_pool ? R.st_pool + (size_t)li * NB_S * 15 * D_POOL : nullptr;
                k_pooled<<<M, 256, 0, stream>>>(N.proj, pp, R.T, R.pos0, N.pooled);
                if (s == 0) k_newpool<<<R.B * 15, 256, 0, stream>>>(N.proj, pp, R.T, R.npool + li * R.npool_l);
                for (int gi = 0; gi < 4; ++gi)
                    k_gemm<<<dim3(PG / 64, M / 64), 256, 0, stream>>>(N.pooled + gi * PG, D_POOL, pool_w + ((size_t)li * 4 + gi) * PG * PG, PG, N.mixed + gi * PG, D_POOL, PG);
                k_merge<<<M, 256, 0, stream>>>(N.proj, N.attn, N.mixed, pool_scale + li * D_POOL, N.merged, s == 1 ? 1 : 0);
            }
            k_gemm<<<dim3(DM / 64, M / 64), 256, 0, stream>>>(N.merged, DM, w_out_even + (size_t)li * DM * DM, DM, N.mix, DM, DM);
        } else {
            if (s == 0) {
                k_gemm<<<dim3(N_ODD_IN / 64, M / 64), 256, 0, stream>>>(N.hb, DM, w_in_odd + (size_t)li * DM * N_ODD_IN, N_ODD_IN, N.proj, N_ODD_IN, DM);
                const float* cp = R.st_conv ? R.st_conv + (size_t)li * NB_S * 2 * D_CONV : nullptr;
                k_convgate<<<M, 256, 0, stream>>>(N.proj, cp, conv_w + (size_t)li * 3 * D_CONV, R.T, N.merged, R.nconv + li * R.nconv_l);
            }
            k_gemm<<<dim3(DM / 64, M / 64), 256, 0, stream>>>(N.merged, DM, w_out_odd + (size_t)li * DM * DM, DM, N.mix, DM, DM);
        }
        k_resid<<<M, 256, 0, stream>>>(N.xb, N.mix, modp, R.T);
    }
    if (final_norm) k_norm<<<M, 256, 0, stream>>>(N.xb, final_g, nullptr, R.T, R.y);
}

extern "C" void kernel_launch(void* const* d_in, const int* in_sizes, int n_in, void* d_out, int out_size, void* d_ws, size_t ws_size, hipStream_t stream) {
    static int grid = 0;
    if (grid == 0) {
        int dev = 0, cus = 0, per_cu = 0;
        if (n_in != 19 || (size_t)out_size != O_END || ws_size < 700 * MiB) { fprintf(stderr, "kernel_launch: unexpected shapes (n_in %d out %d ws %zu)\n", n_in, out_size, ws_size); grid = -1; return; }
        if (hipGetDevice(&dev) != hipSuccess || hipDeviceGetAttribute(&cus, hipDeviceAttributeMultiprocessorCount, dev) != hipSuccess) { grid = -1; return; }
        if (hipFuncSetAttribute((const void*)mk_fwd, hipFuncAttributeMaxDynamicSharedMemorySize, LDS_BYTES) != hipSuccess) { fprintf(stderr, "kernel_launch: hipFuncSetAttribute failed\n"); grid = -1; return; }
        if (hipOccupancyMaxActiveBlocksPerMultiprocessor(&per_cu, (const void*)mk_fwd, NWAVES * 64, LDS_BYTES) != hipSuccess || per_cu < 1) { fprintf(stderr, "kernel_launch: occupancy query says %d blocks per CU\n", per_cu); }
        (void)hipGetLastError();
        grid = cus;
        if (grid != 256) fprintf(stderr, "kernel_launch: %d CUs (built for 256)\n", grid);
    }
    if (grid < 0) return;
    (void)hipMemsetAsync((char*)d_ws + WS_CTL, 0, CTL_ZERO_BYTES, stream);
    Args a{};
    for (int i = 0; i < 19; ++i) a.in[i] = (const float*)d_in[i];
    a.out = (float*)d_out; a.ws = (unsigned char*)d_ws;
    if (MK_UPTO == PH_END) { a.ph_lo = 0; a.ph_hi = PH_END; a.li = 0; hipLaunchKernelGGL(mk_fwd, dim3(grid), dim3(NWAVES * 64), LDS_BYTES, stream, a); }
    else { int li = 0;
      for (int ph = 0; ph < MK_UPTO; ++ph) {
          if (ph >= 2 && ph < PH_FIN) { const int l = (ph - 2) / 4, s = (ph - 2) % 4; if ((l & 1) && s == 2) continue; }
          a.ph_lo = ph; a.ph_hi = ph + 1; a.li = li++;
          hipLaunchKernelGGL(mk_fwd, dim3(grid), dim3(NWAVES * 64), LDS_BYTES, stream, a);
      } }
    float* out = (float*)d_out;
    float* nf = (float*)((char*)d_ws + WS_NAIVE); size_t w = 0;
    NaiveBufs N;
    const size_t MR = (size_t)T_P;
    N.xb = nf + w; w += MR * DM; N.hb = nf + w; N.mix = N.hb; w += MR * DM; N.proj = nf + w; w += MR * N_ODD_IN;
    N.attn = nf + w; w += MR * D_ATTN; N.pooled = nf + w; w += MR * D_POOL; N.mixed = nf + w; w += MR * D_POOL; N.merged = nf + w; w += MR * DM;
    N.scb = nf + w; w += (size_t)10 * DM;
    N.mod = (float*)((char*)d_ws + WS_MOD);
    if (MK_UPTO < 1) { k_siluc<<<10 * DM / 256, 256, 0, stream>>>((const float*)d_in[2], (const float*)d_in[3], N.scb); k_ada<<<dim3(3 * DM / 256, 4), 256, 0, stream>>>(N.scb, (const float*)d_in[8], (const float*)d_in[9], N.mod); }
    if (MK_UPTO < PH_END) {
        const int l0 = MK_UPTO < 2 ? 0 : (MK_UPTO - 2) / 4, s0 = MK_UPTO < 2 ? 0 : (MK_UPTO - 2) % 4;
        for (int b = 0; b < NB_P; ++b) {
            Trunk R{1, T_P, 0, 0, (const float*)d_in[0] + (size_t)b * T_P * DM, nullptr, nullptr, nullptr, nullptr, b,
                    out + O_YP + (size_t)b * T_P * DM, out + O_NKP + (size_t)b * 2048 * D_ATTN, out + O_NVP + (size_t)b * 2048 * D_ATTN, out + O_NPOOLP + (size_t)b * 15 * D_POOL, out + O_NCONVP + (size_t)b * 2 * D_CONV,
                    (size_t)NB_P * 2048 * D_ATTN, (size_t)NB_P * 15 * D_POOL, (size_t)NB_P * 2 * D_CONV, 2048};
            const float* xsrc = (l0 == 0) ? R.x_in : out + O_YP + (size_t)b * T_P * DM;
            (void)hipMemcpyAsync(N.xb, xsrc, (size_t)T_P * DM * sizeof(float), hipMemcpyDeviceToDevice, stream);
            const size_t ro = (size_t)b * T_P;
            if (l0 < DEPTH && (l0 % 2 == 0) && s0 == 1)
                k_adapt_g1e<<<T_P, 256, 0, stream>>>((const bf16_t*)((char*)d_ws + WS_QR) + ro * D_ATTN, (const bf16_t*)((char*)d_ws + WS_KR) + ro * D_ATTN, (const bf16_t*)((char*)d_ws + WS_VB) + ro * D_ATTN,
                                                      (const bf16_t*)((char*)d_ws + WS_GA) + ro * D_ATTN, (const bf16_t*)((char*)d_ws + WS_UB) + ro * D_ATTN, (const bf16_t*)((char*)d_ws + WS_GP) + ro * D_ATTN, N.proj);
            if (l0 < DEPTH && ((l0 % 2 == 0 && s0 == 3) || (l0 % 2 == 1 && s0 == 2)))
                k_bf2f<<<2048, 256, 0, stream>>>((const bf16_t*)((char*)d_ws + WS_MERGED) + ro * DM, N.merged, (size_t)T_P * DM);
            naive_run(R, N, d_in, l0, s0, true, stream);
        }
    }
    if (MK_UPTO < PH_END) {
        Trunk R{NB_S, T_S, PAST, WBUF, (const float*)d_in[1], (const float*)d_in[4], (const float*)d_in[5], (const float*)d_in[6], (const float*)d_in[7], 2,
                out + O_YS, out + O_NKS, out + O_NVS, out + O_NPOOLS, out + O_NCONVS, (size_t)NB_S * T_S * D_ATTN, (size_t)NB_S * 15 * D_POOL, (size_t)NB_S * 2 * D_CONV, T_S};
        (void)hipMemcpyAsync(N.xb, R.x_in, (size_t)MS * DM * sizeof(float), hipMemcpyDeviceToDevice, stream);
        naive_run(R, N, d_in, 0, 0, true, stream);
    }
}
```

```cpp
#include <hip/hip_runtime.h>
#include <hip/hip_bf16.h>
#include <cstdio>
#include <cstdint>
#include <cmath>

#ifndef EXP_PH
#define EXP_PH -1
#endif
constexpr int DM = 2048, NB_P = 2, T_P = 4096, NB_S = 8, T_S = 8, DEPTH = 4;
constexpr int D_ATTN = 1024, HD = 128, NH = 8, D_POOL = 1024, PG = 256, D_CONV = 2048;
constexpr int N_EVEN_IN = 6144, N_ODD_IN = 8192, WBUF = 2048, PAST = 16384;
constexpr int MP = NB_P * T_P;
constexpr int MS = NB_S * T_S;
constexpr float EPS = 1e-6f;
constexpr int NSEQ = NB_P + NB_S;
constexpr int MODW = 3 * DM;
constexpr int SHW_LD = 8192;
constexpr int ROPE_ROWS = T_P + T_S;
constexpr int NPART = 8;

constexpr size_t O_YP = 0;
constexpr size_t O_YS = O_YP + (size_t)MP * DM;
constexpr size_t O_NKP = O_YS + (size_t)MS * DM;
constexpr size_t O_NVP = O_NKP + (size_t)2 * NB_P * 2048 * D_ATTN;
constexpr size_t O_NPOOLP = O_NVP + (size_t)2 * NB_P * 2048 * D_ATTN;
constexpr size_t O_NCONVP = O_NPOOLP + (size_t)2 * NB_P * 15 * D_POOL;
constexpr size_t O_NKS = O_NCONVP + (size_t)2 * NB_P * 2 * D_CONV;
constexpr size_t O_NVS = O_NKS + (size_t)2 * NB_S * T_S * D_ATTN;
constexpr size_t O_NPOOLS = O_NVS + (size_t)2 * NB_S * T_S * D_ATTN;
constexpr size_t O_NCONVS = O_NPOOLS + (size_t)2 * NB_S * 15 * D_POOL;
constexpr size_t O_END = O_NCONVS + (size_t)2 * NB_S * 2 * D_CONV;

constexpr size_t MiB = 1u << 20;
constexpr size_t WS_CTL = 0, CTL_ZERO_BYTES = 1 * MiB;
constexpr size_t WS_MOD = 1 * MiB;
constexpr size_t WS_SHW = 2 * MiB;
constexpr size_t WS_ROPE = 4 * MiB;
constexpr size_t WS_PARTSS = 7 * MiB;
constexpr size_t WS_WIE = 16 * MiB;
constexpr size_t WS_WOE = 64 * MiB;
constexpr size_t WS_WIO = 80 * MiB;
constexpr size_t WS_WOO = 144 * MiB;
constexpr size_t WS_WPW = 160 * MiB;
constexpr size_t WS_A = 162 * MiB;
constexpr size_t WS_AS = WS_A + (size_t)MP * DM * 2;
constexpr size_t WS_QR = 196 * MiB, WS_KR = 212 * MiB, WS_VB = 228 * MiB, WS_GA = 244 * MiB, WS_UB = 260 * MiB, WS_GP = 276 * MiB;
constexpr size_t WS_OPART = 292 * MiB;
constexpr size_t WS_ML = 340 * MiB;
constexpr size_t WS_MERGED = 342 * MiB;
constexpr size_t WS_UO = WS_QR, WS_ZO = WS_QR + 32 * MiB;
constexpr size_t WS_END = 374 * MiB;
constexpr size_t WS_NAIVE = 376 * MiB;

constexpr size_t WS_SRAW = 8 * MiB;
constexpr size_t WS_SMG = 10 * MiB;
constexpr size_t WS_PSS_S = 10 * MiB + 512 * 1024;
constexpr size_t WS_SOP = 11 * MiB;
constexpr size_t WS_SML = 12 * MiB;

typedef unsigned short bf16_t;
typedef float f32x4 __attribute__((ext_vector_type(4)));
typedef unsigned u32x4 __attribute__((ext_vector_type(4)));
typedef unsigned u32x2 __attribute__((ext_vector_type(2)));
typedef short bf16x8 __attribute__((ext_vector_type(8)));

__host__ __device__ __forceinline__ float bf2f(bf16_t v) { union { unsigned u; float f; } x; x.u = (unsigned)v << 16; return x.f; }
__device__ __forceinline__ float silu_f(float x) { return x / (1.f + expf(-x)); }
__device__ __forceinline__ float silu_fast(float x) { return x * __builtin_amdgcn_rcpf(1.f + __expf(-x)); }

__host__ __device__ __forceinline__ int nat8_phys(int j) { const int bj = j >> 7, wc = (j >> 5) & 3, fq = (j >> 3) & 3, n = (j >> 2) & 1, e = j & 3; return 128 * bj + 32 * wc + 16 * n + 4 * fq + e; }
__host__ __device__ __forceinline__ int phys_ie(int c) {
    const int grp = c >> 10, cc = c & 1023;
    if (grp < 2) {
        const int h = cc >> 7, d = cc & 127, bj = d >> 6, dd = d & 63, pn = 4 * grp + (h >> 1), hl = h & 1;
        const int wc = 2 * hl + (dd >> 5), fq = (dd >> 3) & 3, n = (dd >> 2) & 1, e = dd & 3;
        return 256 * pn + 128 * bj + 32 * wc + 16 * n + 4 * fq + e;
    }
    return 256 * (4 * grp + (cc >> 8)) + nat8_phys(cc & 255);
}
__host__ __device__ __forceinline__ int phys_io(int c) {
    const int grp = c >> 11, ch = c & 2047, pn = ch >> 6, r = ch & 63, wc = r >> 4, fq = (r >> 2) & 3, e = r & 3, bj = grp >> 1, n = grp & 1;
    return 256 * pn + 128 * bj + 32 * wc + 16 * n + 4 * fq + e;
}
__host__ __device__ __forceinline__ int phys_out(int c) { return (c & ~255) + nat8_phys(c & 255); }
namespace pg8 {
#define PG8_LAS __attribute__((address_space(3)))
typedef unsigned short bf16_t;
typedef short bf16x8 __attribute__((ext_vector_type(8)));
typedef float f32x4 __attribute__((ext_vector_type(4)));
typedef unsigned u32x4 __attribute__((ext_vector_type(4)));
constexpr int BM = 256, BK = 64, HALF = 128, HTB = HALF * BK * 2  , STAGE_BYTES = 8 * HTB, NXCD = 8, WGM = 8;

__host__ __device__ __forceinline__ int lds_byte(int r, int c) { const int st = (r >> 4) * 2 + (c >> 5), rr = r & 15, cc = c & 31, ob = rr * 64 + cc * 2; return st * 1024 + (ob ^ (((ob >> 9) & 1) << 5)); }
__host__ __device__ __forceinline__ void stage_rc(int b, int& R, int& C) { const int st = b / 1024, sb = b % 1024, swz = sb ^ (((sb >> 9) & 1) << 5); R = (st >> 1) * 16 + swz / 64; C = (st & 1) * 32 + (swz % 64) / 2; }
__host__ __device__ __forceinline__ int perm32(int rho) { const int n = rho >> 4, i = rho & 15; return 8 * (i >> 2) + 4 * n + (i & 3); }

struct Unit { int pm, pn; };
struct Gemm { const bf16_t* A; const bf16_t* Bt; int M, N, K; };

struct StaticOrder {
    int nM, nN, nwg, G, c;
    __host__ __device__ void init(int M, int N, int G_, int c_) { nM = M / BM; nN = N / BM; nwg = nM * nN; G = G_; c = c_; }
    __host__ __device__ bool next(int i, Unit& u) const {
        const long L = (long)i * G + c; if (L >= nwg) return false;
        int wgid = (int)L; { const int q = nwg / NXCD, r = nwg % NXCD, xcd = wgid % NXCD, off = wgid / NXCD; wgid = (xcd < r ? xcd * (q + 1) : r * (q + 1) + (xcd - r) * q) + off; }
        const int nig = WGM * nN, gid = wgid / nig, fm = gid * WGM, gsz = (nM - fm) < WGM ? (nM - fm) : WGM;
        u.pm = fm + ((wgid % nig) % gsz); u.pn = (wgid % nig) / gsz; return true;
    }
    __device__ __forceinline__ void a_ready(const Unit&) const {}
    __device__ __forceinline__ void done(const Unit&) const {}
};

__device__ __forceinline__ unsigned cvt_pk_bf16(float lo, float hi) { unsigned r; asm volatile("v_cvt_pk_bf16_f32 %0, %1, %2" : "=v"(r) : "v"(lo), "v"(hi)); return r; }
typedef float f32x2 __attribute__((ext_vector_type(2)));
__device__ __forceinline__ u32x4 pack8v(const f32x4 a, const f32x4 b) { u32x4 w; w.x = cvt_pk_bf16(a[0], a[1]); w.y = cvt_pk_bf16(a[2], a[3]); w.z = cvt_pk_bf16(b[0], b[1]); w.w = cvt_pk_bf16(b[2], b[3]); return w; }
__device__ __forceinline__ f32x4 silu4(const f32x4 v) { f32x4 r; r[0] = silu_fast(v[0]); r[1] = silu_fast(v[1]); r[2] = silu_fast(v[2]); r[3] = silu_fast(v[3]); return r; }
__device__ __forceinline__ float row_rstd(const float* partss, int row) {
    const f32x4* pp = (const f32x4*)(partss + (size_t)row * NPART); float s = 0.f;
#pragma unroll
    for (int i = 0; i < NPART / 4; ++i) { const f32x4 v = pp[i]; s += (v[0] + v[1]) + (v[2] + v[3]); }
    return rsqrtf(s * (1.0f / DM) + EPS);
}

constexpr size_t GSTRIDE = (size_t)8 * 1024 * 1024;
struct EpiG1E {
    static constexpr bool PERM = false, AFTER_DRAIN = false;
    const float* partss; const float* shw;
    const float* rope_c; const float* rope_s;
    bf16_t* base6;
    float *nk, *nv, *npool;
    __device__ __forceinline__ void operator()(const f32x4 (&acc)[2][2][4][2], const Unit& u, int wr, int wc, int fr, int fq) const {
        asm volatile("" : "+v"(fr), "+v"(fq));
        const int grp = u.pn >> 2, pq = u.pn & 3, b = u.pm >> 4;
        f32x4 sh[2][2];
#pragma unroll
        for (int bj = 0; bj < 2; ++bj)
#pragma unroll
            for (int n = 0; n < 2; ++n) sh[bj][n] = *(const f32x4*)(shw + (size_t)b * SHW_LD + u.pn * BM + bj * HALF + wc * 32 + n * 16 + fq * 4);
        if (grp < 2) {
            const int head = 2 * pq + (wc >> 1), dd0 = 32 * (wc & 1) + 8 * fq;
            bf16_t* dstb = base6 + (size_t)grp * GSTRIDE + head * HD + dd0;
#pragma unroll
            for (int ai = 0; ai < 2; ++ai)
#pragma unroll
                for (int m = 0; m < 4; ++m) {
                    const int row = u.pm * BM + ai * HALF + wr * 64 + m * 16 + fr, t = row & (T_P - 1);
                    const float rs = row_rstd(partss, row);
                    const f32x4 c0 = *(const f32x4*)(rope_c + (size_t)t * 64 + dd0), c1 = *(const f32x4*)(rope_c + (size_t)t * 64 + dd0 + 4);
                    const f32x4 s0 = *(const f32x4*)(rope_s + (size_t)t * 64 + dd0), s1 = *(const f32x4*)(rope_s + (size_t)t * 64 + dd0 + 4);
                    const f32x4 x10 = acc[ai][0][m][0] * rs + sh[0][0], x11 = acc[ai][0][m][1] * rs + sh[0][1];
                    const f32x4 x20 = acc[ai][1][m][0] * rs + sh[1][0], x21 = acc[ai][1][m][1] * rs + sh[1][1];
                    const f32x4 o10 = x10 * c0 - x20 * s0, o11 = x11 * c1 - x21 * s1, o20 = x20 * c0 + x10 * s0, o21 = x21 * c1 + x11 * s1;
                    bf16_t* d = dstb + (size_t)row * D_ATTN;
                    *(u32x4*)d = pack8v(o10, o11); *(u32x4*)(d + 64) = pack8v(o20, o21);
                    if (grp == 1 && t >= T_P - 2048) {
                        float* o = nk + ((size_t)b * 2048 + (t - (T_P - 2048))) * D_ATTN + head * HD + dd0;
                        *(f32x4*)o = o10; *(f32x4*)(o + 4) = o11; *(f32x4*)(o + 64) = o20; *(f32x4*)(o + 68) = o21;
                    }
                    asm volatile("" ::: "memory");
                }
        } else {
            bf16_t* dstb = base6 + (size_t)grp * GSTRIDE + pq * 256 + wc * 32 + 8 * fq;
            const bool gate = (grp == 3) || (grp == 5);
#pragma unroll
            for (int ai = 0; ai < 2; ++ai)
#pragma unroll
                for (int m = 0; m < 4; ++m) {
                    const int row = u.pm * BM + ai * HALF + wr * 64 + m * 16 + fr, t = row & (T_P - 1);
                    const float rs = row_rstd(partss, row);
#pragma unroll
                    for (int bj = 0; bj < 2; ++bj) {
                        f32x4 v0 = acc[ai][bj][m][0] * rs + sh[bj][0], v1 = acc[ai][bj][m][1] * rs + sh[bj][1];
                        if (gate) { v0 = silu4(v0); v1 = silu4(v1); }
                        *(u32x4*)(dstb + (size_t)row * D_ATTN + bj * HALF) = pack8v(v0, v1);
                        const int col = pq * 256 + bj * HALF + wc * 32 + 8 * fq;
                        if (grp == 2 && t >= T_P - 2048) { float* o = nv + ((size_t)b * 2048 + (t - (T_P - 2048))) * D_ATTN + col; *(f32x4*)o = v0; *(f32x4*)(o + 4) = v1; }
                        if (grp == 4 && t >= T_P - 15) { float* o = npool + ((size_t)b * 15 + (t - (T_P - 15))) * D_POOL + col; *(f32x4*)o = v0; *(f32x4*)(o + 4) = v1; }
                    }
                    asm volatile("" ::: "memory");
                }
        }
    }
};

struct EpiG1O {
    static constexpr bool PERM = false, AFTER_DRAIN = false;
    const float* partss; const float* shw;
    bf16_t *UO, *ZO; float* nconv;
    __device__ __forceinline__ void operator()(const f32x4 (&acc)[2][2][4][2], const Unit& u, int wr, int wc, int fr, int fq) const {
        asm volatile("" : "+v"(fr), "+v"(fq));
        const int b = u.pm >> 4, ch0 = 64 * u.pn + 16 * wc + 4 * fq;
        f32x4 sh[2][2];
#pragma unroll
        for (int bj = 0; bj < 2; ++bj)
#pragma unroll
            for (int n = 0; n < 2; ++n) sh[bj][n] = *(const f32x4*)(shw + (size_t)b * SHW_LD + u.pn * BM + bj * HALF + wc * 32 + n * 16 + fq * 4);
#pragma unroll
        for (int ai = 0; ai < 2; ++ai)
#pragma unroll
            for (int m = 0; m < 4; ++m) {
                const int row = u.pm * BM + ai * HALF + wr * 64 + m * 16 + fr, t = row & (T_P - 1);
                const float rs = row_rstd(partss, row);
                const f32x4 bg = acc[ai][0][m][0] * rs + sh[0][0], cg = acc[ai][0][m][1] * rs + sh[0][1], hh = acc[ai][1][m][0] * rs + sh[1][0], g = acc[ai][1][m][1] * rs + sh[1][1];
                const f32x4 uu = bg * silu4(g), zz = cg * hh;
                u32x2 wu, wz; wu.x = cvt_pk_bf16(uu[0], uu[1]); wu.y = cvt_pk_bf16(uu[2], uu[3]); wz.x = cvt_pk_bf16(zz[0], zz[1]); wz.y = cvt_pk_bf16(zz[2], zz[3]);
                *(u32x2*)(UO + (size_t)row * D_CONV + ch0) = wu; *(u32x2*)(ZO + (size_t)row * D_CONV + ch0) = wz;
                if (t >= T_P - 2) *(f32x4*)(nconv + ((size_t)b * 2 + (t - (T_P - 2))) * D_CONV + ch0) = zz;
                asm volatile("" ::: "memory");
            }
    }
};

struct EpiG2 {
    static constexpr bool PERM = false, AFTER_DRAIN = true;
    const float* xin; float* xout; bf16_t* anext;
    const float* modl;
    const float* modn; const float* gn;
    float* partss;
    __device__ __forceinline__ void operator()(const f32x4 (&acc)[2][2][4][2], const Unit& u, int wr, int wc, int fr, int fq) const {}
    __device__ __forceinline__ void fused(f32x4 (&acc)[2][2][4][2], const Unit& u, int wr, int wc, int fr, int fq, PG8_LAS unsigned char* lds, int wid, int lane) const {
        asm volatile("" : "+v"(fr), "+v"(fq), "+v"(lane));
        const int b = u.pm >> 4;
        PG8_LAS float* P = (PG8_LAS float*)lds;
        f32x4 gt[2][2], gs[2][2];
#pragma unroll
        for (int bj = 0; bj < 2; ++bj) { const int col0 = u.pn * BM + bj * HALF + wc * 32 + 8 * fq;
#pragma unroll
            for (int n = 0; n < 2; ++n) { gt[bj][n] = *(const f32x4*)(modl + (size_t)b * MODW + 2 * DM + col0 + 4 * n);
                if (anext) { const f32x4 sc = *(const f32x4*)(modn + (size_t)b * MODW + DM + col0 + 4 * n), g = *(const f32x4*)(gn + col0 + 4 * n); gs[bj][n] = g * (sc + 1.0f); }
                else gs[bj][n] = (f32x4){0.f, 0.f, 0.f, 0.f}; } }
#pragma unroll
        for (int ai = 0; ai < 2; ++ai)
#pragma unroll
            for (int m = 0; m < 4; ++m) {
                const int rl = ai * HALF + wr * 64 + m * 16 + fr, row = u.pm * BM + rl; float ss = 0.f;
#pragma unroll
                for (int bj = 0; bj < 2; ++bj) { const size_t off = (size_t)row * DM + u.pn * BM + bj * HALF + wc * 32 + 8 * fq;
                    const f32x4 x0 = *(const f32x4*)(xin + off), x1 = *(const f32x4*)(xin + off + 4);
                    const f32x4 y0 = x0 + gt[bj][0] * acc[ai][bj][m][0], y1 = x1 + gt[bj][1] * acc[ai][bj][m][1];
                    *(f32x4*)(xout + off) = y0; *(f32x4*)(xout + off + 4) = y1;
                    ss += (y0[0] * y0[0] + y0[1] * y0[1]) + (y0[2] * y0[2] + y0[3] * y0[3]) + (y1[0] * y1[0] + y1[1] * y1[1]) + (y1[2] * y1[2] + y1[3] * y1[3]);
                    if (anext) *(u32x4*)(anext + off) = pack8v(y0 * gs[bj][0], y1 * gs[bj][1]); }
                ss += __shfl_xor(ss, 16); ss += __shfl_xor(ss, 32);
                if (fq == 0) P[rl * 4 + wc] = ss;
                asm volatile("" ::: "memory");
            }
        asm volatile("s_waitcnt lgkmcnt(0)" ::: "memory"); __builtin_amdgcn_s_barrier(); asm volatile("" ::: "memory");
        const int tid = wid * 64 + lane;
        if (tid < BM) { const f32x4 v = *(const PG8_LAS f32x4*)(P + tid * 4); partss[(size_t)(u.pm * BM + tid) * NPART + u.pn] = (v[0] + v[1]) + (v[2] + v[3]); }
    }
};
template <class Epi, class Sched, bool ALIGN_EPI = false, bool SP2 = false>
__device__ __forceinline__ void gemm_phase(PG8_LAS unsigned char* lds, const Gemm g, const Sched& S, const Epi& E, int tid_in) {
    int tid_ = tid_in; asm volatile("" : "+v"(tid_));
    const int tid = tid_, wid = __builtin_amdgcn_readfirstlane(tid >> 6), lane = tid & 63, wr = wid >> 2, wc = wid & 3, fr = lane & 15, fq = lane >> 4;
    const int K = g.K, nt = K / BK;
    unsigned voffA[2], voffB[2];
#pragma unroll
    for (int i = 0; i < 2; ++i) { int R, C; stage_rc(tid * 16 + i * 8192, R, C); const int Rb = Epi::PERM ? ((R & ~31) + perm32(R & 31)) : R;
        voffA[i] = (unsigned)(R * K + C) * 2u; voffB[i] = (unsigned)(Rb * K + C) * 2u; }
    const size_t kstep = (size_t)(BK * 2);
    const size_t hstep = (size_t)HALF * K * 2;
    const size_t tstep = 2 * hstep;
    const unsigned ldsw = (unsigned)wid * 1024u;
    const int aoff = lds_byte(wr * 64 + fr, fq * 8), boff = lds_byte(wc * 32 + fr, fq * 8);
#define PG8_SA(b, h) (((b) * 2 + (h)) * HTB)
#define PG8_SB(b, h) ((4 + (b) * 2 + (h)) * HTB)
#define PG8_STAGE(bufoff, gbase, voff) do { _Pragma("unroll") for (int _i = 0; _i < 2; ++_i) \
        __builtin_amdgcn_global_load_lds((const unsigned*)((const char*)(gbase) + (voff)[_i]), (PG8_LAS unsigned*)(lds + (bufoff) + ldsw + _i * 8192), 16, 0, 0); } while (0)
#define PG8_LDA(dst, b, h) do { _Pragma("unroll") for (int m = 0; m < 4; ++m) _Pragma("unroll") for (int k = 0; k < 2; ++k) dst[m][k] = *(const PG8_LAS bf16x8*)(lds + PG8_SA(b, h) + aoff + m * 2048 + k * 1024); } while (0)
#define PG8_LDB(dst, b, h) do { _Pragma("unroll") for (int n = 0; n < 2; ++n) _Pragma("unroll") for (int k = 0; k < 2; ++k) dst[n][k] = *(const PG8_LAS bf16x8*)(lds + PG8_SB(b, h) + boff + n * 2048 + k * 1024); } while (0)
#define PG8_MMA(ai, bj, At, Bt) do { __builtin_amdgcn_s_setprio(1); _Pragma("unroll") for (int m = 0; m < 4; ++m) _Pragma("unroll") for (int n = 0; n < 2; ++n) _Pragma("unroll") for (int k = 0; k < 2; ++k) \
        acc[ai][bj][m][n] = __builtin_amdgcn_mfma_f32_16x16x32_bf16(Bt[n][k], At[m][k], acc[ai][bj][m][n], 0, 0, 0); __builtin_amdgcn_s_setprio(0); } while (0)
#define PG8_WAIT_V(n) asm volatile("s_waitcnt vmcnt(" #n ")" ::: "memory")
#define PG8_WAIT_L(n) asm volatile("s_waitcnt lgkmcnt(" #n ")" ::: "memory")
#define PG8_BAR __builtin_amdgcn_s_barrier()
#define PG8_SCHED __builtin_amdgcn_sched_barrier(0)
    Unit cur, nxt; int ui = 0;
    if (!S.next(0, cur)) return;
    f32x4 acc[2][2][4][2];
#pragma unroll
    for (int a = 0; a < 2; ++a)
#pragma unroll
        for (int b = 0; b < 2; ++b)
#pragma unroll
            for (int m = 0; m < 4; ++m)
#pragma unroll
                for (int n = 0; n < 2; ++n) acc[a][b][m][n] = (f32x4){0.f, 0.f, 0.f, 0.f};
    bf16x8 At[4][2], B0[2][2], B1[2][2];
    const char* cA = (const char*)g.A + (size_t)cur.pm * tstep; const char* cB = (const char*)g.Bt + (size_t)cur.pn * tstep;
    S.a_ready(cur);
    if constexpr (SP2) {
        PG8_STAGE(PG8_SB(0, 0), cB, voffB); PG8_STAGE(PG8_SB(0, 1), cB + hstep, voffB); PG8_STAGE(PG8_SA(0, 0), cA, voffA); PG8_STAGE(PG8_SA(0, 1), cA + hstep, voffA);
        if (wr == 1) PG8_BAR;
        PG8_WAIT_V(2); PG8_BAR;
        PG8_STAGE(PG8_SB(1, 0), cB + kstep, voffB); PG8_STAGE(PG8_SA(1, 0), cA + kstep, voffA); PG8_STAGE(PG8_SB(1, 1), cB + hstep + kstep, voffB);
        PG8_WAIT_V(6); PG8_BAR;
    } else {
        PG8_STAGE(PG8_SB(0, 0), cB, voffB); PG8_STAGE(PG8_SA(0, 0), cA, voffA); PG8_STAGE(PG8_SB(0, 1), cB + hstep, voffB); PG8_STAGE(PG8_SA(0, 1), cA + hstep, voffA);
        if (wr == 1) PG8_BAR;
        PG8_WAIT_V(4); PG8_BAR;
        PG8_STAGE(PG8_SB(1, 0), cB + kstep, voffB); PG8_STAGE(PG8_SA(1, 0), cA + kstep, voffA); PG8_STAGE(PG8_SB(1, 1), cB + hstep + kstep, voffB);
        PG8_WAIT_V(6); PG8_BAR;
    }
    for (;;) {
        const bool has_next = S.next(ui + 1, nxt);
        const char* nA = has_next ? (const char*)g.A + (size_t)nxt.pm * tstep : cA; const char* nB = has_next ? (const char*)g.Bt + (size_t)nxt.pn * tstep : cB;
        for (int t = 0; t < nt; t += 2) {
            const bool last = (t == nt - 2);
            const char* a1 = cA + (size_t)(t + 1) * kstep;
            const char* a2 = last ? nA : cA + (size_t)(t + 2) * kstep; const char* b2 = last ? nB : cB + (size_t)(t + 2) * kstep;
            const char* a3 = a2 + kstep; const char* b3 = b2 + kstep;
            if (last && has_next) S.a_ready(nxt);
            if constexpr (SP2) {
            PG8_LDB(B0, 0, 0); PG8_LDB(B1, 0, 1); PG8_SCHED; PG8_LDA(At, 0, 0); PG8_STAGE(PG8_SA(1, 1), a1 + hstep, voffA);
            PG8_WAIT_V(8); PG8_WAIT_L(0); PG8_BAR; PG8_MMA(0, 0, At, B0); PG8_MMA(0, 1, At, B1); PG8_BAR; PG8_SCHED;
            PG8_LDA(At, 0, 1); PG8_STAGE(PG8_SB(0, 0), b2, voffB); PG8_STAGE(PG8_SB(0, 1), b2 + hstep, voffB); PG8_STAGE(PG8_SA(0, 0), a2, voffA);
            PG8_WAIT_V(8); PG8_WAIT_L(0); PG8_BAR; PG8_MMA(1, 0, At, B0); PG8_MMA(1, 1, At, B1); PG8_BAR; PG8_SCHED;
            PG8_LDB(B0, 1, 0); PG8_LDB(B1, 1, 1); PG8_SCHED; PG8_LDA(At, 1, 0); PG8_STAGE(PG8_SA(0, 1), a2 + hstep, voffA);
            PG8_WAIT_V(8); PG8_WAIT_L(0); PG8_BAR; PG8_MMA(0, 0, At, B0); PG8_MMA(0, 1, At, B1); PG8_BAR; PG8_SCHED;
            PG8_LDA(At, 1, 1); PG8_STAGE(PG8_SB(1, 0), b3, voffB); PG8_STAGE(PG8_SB(1, 1), b3 + hstep, voffB); PG8_STAGE(PG8_SA(1, 0), a3, voffA);
            PG8_WAIT_V(8); PG8_WAIT_L(0); PG8_BAR; PG8_MMA(1, 0, At, B0); PG8_MMA(1, 1, At, B1); PG8_BAR; PG8_SCHED;
            } else {
            PG8_LDB(B0, 0, 0); PG8_SCHED; PG8_LDA(At, 0, 0); PG8_STAGE(PG8_SA(1, 1), a1 + hstep, voffA);
            PG8_WAIT_L(8); PG8_BAR; PG8_WAIT_L(0); PG8_MMA(0, 0, At, B0); PG8_BAR; PG8_SCHED;
            PG8_LDB(B1, 0, 1); PG8_STAGE(PG8_SB(0, 0), b2, voffB);
            PG8_BAR; PG8_WAIT_L(0); PG8_MMA(0, 1, At, B1); PG8_BAR;
            PG8_LDA(At, 0, 1); PG8_STAGE(PG8_SA(0, 0), a2, voffA);
            PG8_BAR; PG8_WAIT_L(0); PG8_MMA(1, 0, At, B0); PG8_BAR; PG8_SCHED;
            PG8_STAGE(PG8_SB(0, 1), b2 + hstep, voffB);
            PG8_WAIT_V(6); PG8_BAR; PG8_MMA(1, 1, At, B1); PG8_BAR;
            PG8_LDB(B0, 1, 0); PG8_SCHED; PG8_LDA(At, 1, 0); PG8_STAGE(PG8_SA(0, 1), a2 + hstep, voffA);
            PG8_WAIT_L(8); PG8_BAR; PG8_WAIT_L(0); PG8_MMA(0, 0, At, B0); PG8_BAR; PG8_SCHED;
            PG8_LDB(B1, 1, 1); PG8_STAGE(PG8_SB(1, 0), b3, voffB);
            PG8_BAR; PG8_WAIT_L(0); PG8_MMA(0, 1, At, B1); PG8_BAR;
            PG8_LDA(At, 1, 1); PG8_STAGE(PG8_SA(1, 0), a3, voffA);
            PG8_BAR; PG8_WAIT_L(0); PG8_MMA(1, 0, At, B0); PG8_BAR; PG8_SCHED;
            PG8_STAGE(PG8_SB(1, 1), b3 + hstep, voffB);
            PG8_WAIT_V(6); PG8_BAR; PG8_MMA(1, 1, At, B1); PG8_BAR;
            }
        }
        if constexpr (ALIGN_EPI) { if (wr == 0) PG8_BAR; }
        if constexpr (!Epi::AFTER_DRAIN) { E(acc, cur, wr, wc, fr, fq); S.done(cur); }
        if (!has_next) break;
#pragma unroll
        for (int a = 0; a < 2; ++a)
#pragma unroll
            for (int b = 0; b < 2; ++b)
#pragma unroll
                for (int m = 0; m < 4; ++m)
#pragma unroll
                    for (int n = 0; n < 2; ++n) acc[a][b][m][n] = (f32x4){0.f, 0.f, 0.f, 0.f};
        cur = nxt; cA = nA; cB = nB; ++ui;
        if constexpr (ALIGN_EPI) { if (wr == 1) PG8_BAR; }
    }
    PG8_WAIT_V(0);
    if constexpr (!ALIGN_EPI) { if (wr == 0) PG8_BAR; }
    PG8_BAR;
    if constexpr (Epi::AFTER_DRAIN) { E.fused(acc, cur, wr, wc, fr, fq, lds, wid, lane); S.done(cur); }
#undef PG8_SA
#undef PG8_SB
#undef PG8_STAGE
#undef PG8_LDA
#undef PG8_LDB
#undef PG8_MMA
#undef PG8_WAIT_V
#undef PG8_WAIT_L
#undef PG8_BAR
#undef PG8_SCHED
}
}
namespace at {
using bf16 = __hip_bfloat16;
typedef short s16x4 __attribute__((ext_vector_type(4)));
typedef float f32x16 __attribute__((ext_vector_type(16)));
template <class A, class Bt> struct same_t { static constexpr bool v = false; };
template <class A> struct same_t<A, A> { static constexpr bool v = true; };
constexpr int D = 128;
constexpr int WINDOW = 129;
constexpr float THR = 8.f;
constexpr bool WSKIP = true;
constexpr float SCALE = 0.08838834764831845f;
constexpr int NW = 8, QBLK = 32, KVBLK = 64, QB = NW * QBLK;
constexpr int SHM_V = KVBLK * D * 2, SHM_K = KVBLK * D * 2;
constexpr int LDS_BYTES = 2 * SHM_V + 2 * SHM_K + NW * 64 * 4;
#define KSWZ(row, colB) ((row) * 256 + ((colB) ^ (((row) & 7) << 4)))
#define SBAR() __builtin_amdgcn_sched_barrier(0)
__device__ __forceinline__ int v_st(int k, int c) { const int kk = (k & ~0xC) | ((k & 4) << 1) | ((k & 8) >> 1); return ((kk >> 3) * 4 + (c >> 5)) * 512 + ((kk & 7) * 32 + (c & 31)) * 2; }
__device__ __forceinline__ int v_rd_base(int lane) { return ((lane & 3) << 3) | (((lane >> 2) & 3) << 6) | (((lane >> 4) & 1) << 5) | (((lane >> 5) & 1) << 8); }
constexpr int v_rd_off(int d0, int ks, int half) { return d0 * 512 + ks * 4096 + half * 2048; }
__device__ __forceinline__ int crow(int r, int hi) { return (r & 3) + 8 * (r >> 2) + 4 * hi; }
__device__ __forceinline__ unsigned cvtpk(float lo, float hi) {
    unsigned r; asm volatile("v_cvt_pk_bf16_f32 %0, %1, %2" : "=v"(r) : "v"(lo), "v"(hi)); return r;
}
__device__ __forceinline__ bf16x8 pack8(f32x4 a, f32x4 b) {
    u32x4 w = {cvtpk(a[0], a[1]), cvtpk(a[2], a[3]), cvtpk(b[0], b[1]), cvtpk(b[2], b[3])};
    return *reinterpret_cast<bf16x8*>(&w);
}
template <class T> __device__ __forceinline__ bf16x8 load8(const T* p) {
    if constexpr (same_t<T, float>::v) { return pack8(*(const f32x4*)p, *(const f32x4*)(p + 4)); }
    else { return *reinterpret_cast<const bf16x8*>(p); }
}
__device__ __forceinline__ void mask_tile(f32x16& p0, f32x16& p1, int dq, unsigned W) {
    const float NEG = -__builtin_inff();
#pragma unroll
    for (int r = 0; r < 16; ++r) {
        const int c = (r & 3) + 8 * (r >> 2);
        if ((unsigned)(dq - c) >= W) p0[r] = NEG;
        if ((unsigned)(dq - c - 32) >= W) p1[r] = NEG;
    }
}
__device__ __forceinline__ void partialSM(f32x16& p0, f32x16& p1, float& m_reg, float& mn, float& alpha) {
    float pmax = p0[0]; for (int r = 1; r < 16; ++r) pmax = fmaxf(pmax, p0[r]); for (int r = 0; r < 16; ++r) pmax = fmaxf(pmax, p1[r]);
    { auto rr = __builtin_amdgcn_permlane32_swap(__float_as_uint(pmax), __float_as_uint(pmax), false, false);
      pmax = fmaxf(__uint_as_float(rr[0]), __uint_as_float(rr[1])); }
    constexpr float C2 = 1.4426950408889634f * SCALE;
    if (__builtin_expect(__all((pmax - m_reg) * SCALE <= THR), 1)) { mn = m_reg; alpha = 1.f; }
    else { mn = fmaxf(m_reg, pmax); alpha = __builtin_amdgcn_exp2f((m_reg - mn) * C2); m_reg = mn; }
    const float mnL = -mn * C2;
    for (int r = 0; r < 16; ++r) p0[r] = fmaf(p0[r], C2, mnL); for (int r = 0; r < 16; ++r) p1[r] = fmaf(p1[r], C2, mnL);
    for (int r = 0; r < 16; ++r) p0[r] = __builtin_amdgcn_exp2f(p0[r]);
}
__device__ __forceinline__ void finishSM(f32x16& p0, f32x16& p1, float alpha, float& l_reg, bf16x8& pa0, bf16x8& pa1, bf16x8& pa2, bf16x8& pa3) {
    for (int r = 0; r < 16; ++r) p1[r] = __builtin_amdgcn_exp2f(p1[r]);
    float ps = 0; for (int r = 0; r < 16; ++r) ps += p0[r]; for (int r = 0; r < 16; ++r) ps += p1[r];
    { auto rr = __builtin_amdgcn_permlane32_swap(__float_as_uint(ps), __float_as_uint(ps), false, false);
      ps = __uint_as_float(rr[0]) + __uint_as_float(rr[1]); }
    l_reg = l_reg * alpha + ps;
#define PK4(P, B_, OUT) do { unsigned a0 = cvtpk(P[B_+0], P[B_+1]), a1 = cvtpk(P[B_+2], P[B_+3]);                          \
        unsigned b0 = cvtpk(P[B_+4], P[B_+5]), b1 = cvtpk(P[B_+6], P[B_+7]);                                             \
        auto r0 = __builtin_amdgcn_permlane32_swap(a0, b0, false, false); auto r1 = __builtin_amdgcn_permlane32_swap(a1, b1, false, false); \
        u32x4 w = {r0[0], r1[0], r0[1], r1[1]}; OUT = *reinterpret_cast<bf16x8*>(&w); } while (0)
    PK4(p0, 0, pa0); PK4(p0, 8, pa1); PK4(p1, 0, pa2); PK4(p1, 8, pa3);
#undef PK4
}
template <int KB, bool SK>
__device__ __forceinline__ void qkt(f32x16& p0, f32x16& p1, const char* K_lds, int r32, int hi, const bf16x8* qr, bool act) {
    if (SK && !act) { const float NEG = -__builtin_inff();
#pragma unroll
        for (int r = 0; r < 16; ++r) { p0[r] = NEG; p1[r] = NEG; } return; }
    p0 = f32x16{}; p1 = f32x16{};
    const char* kb[4];
#pragma unroll
    for (int dd = 0; dd < 4; ++dd) kb[dd] = K_lds + KB * SHM_K + KSWZ(r32, (dd * 16 + hi * 8) * 2);
#pragma unroll
    for (int d0 = 0; d0 < 8; ++d0) { const char* a = kb[d0 & 3] + (d0 >> 2) * 128;
        bf16x8 b0 = *reinterpret_cast<const bf16x8*>(a);
        bf16x8 b1 = *reinterpret_cast<const bf16x8*>(a + 32 * 256);
        p0 = __builtin_amdgcn_mfma_f32_32x32x16_bf16(b0, qr[d0], p0, 0, 0, 0);
        p1 = __builtin_amdgcn_mfma_f32_32x32x16_bf16(b1, qr[d0], p1, 0, 0, 0); }
}
template <int VB, bool SK>
__device__ __forceinline__ void pv_tile(f32x16* o, int vb0, bf16x8 pa0, bf16x8 pa1, bf16x8 pa2, bf16x8 pa3, bool act) {
    if (SK && !act) return;
#define TRRD(dst, off) asm volatile("ds_read_b64_tr_b16 %0, %1 offset:%2" : "=&v"(dst) : "v"(vb0), "i"(off) : "memory")
#define PV_D0(d0) do { s16x4 l0, l1, l2, l3, h0, h1, h2, h3; constexpr int b_ = VB * SHM_V + v_rd_off(d0, 0, 0);     \
        TRRD(l0, b_); TRRD(h0, b_ + 2048); TRRD(l1, b_ + 4096); TRRD(h1, b_ + 6144); TRRD(l2, b_ + 8192); TRRD(h2, b_ + 10240); TRRD(l3, b_ + 12288); TRRD(h3, b_ + 14336); \
        asm volatile("s_waitcnt lgkmcnt(0)" ::: "memory"); SBAR();                 \
        o[d0] = __builtin_amdgcn_mfma_f32_32x32x16_bf16(pa0, (bf16x8){l0[0], l0[1], l0[2], l0[3], h0[0], h0[1], h0[2], h0[3]}, o[d0], 0, 0, 0);   \
        o[d0] = __builtin_amdgcn_mfma_f32_32x32x16_bf16(pa1, (bf16x8){l1[0], l1[1], l1[2], l1[3], h1[0], h1[1], h1[2], h1[3]}, o[d0], 0, 0, 0);   \
        o[d0] = __builtin_amdgcn_mfma_f32_32x32x16_bf16(pa2, (bf16x8){l2[0], l2[1], l2[2], l2[3], h2[0], h2[1], h2[2], h2[3]}, o[d0], 0, 0, 0);   \
        o[d0] = __builtin_amdgcn_mfma_f32_32x32x16_bf16(pa3, (bf16x8){l3[0], l3[1], l3[2], l3[3], h3[0], h3[1], h3[2], h3[3]}, o[d0], 0, 0, 0); } while (0)
    PV_D0(0); PV_D0(1); PV_D0(2); PV_D0(3);
#undef PV_D0
#undef TRRD
}

template <class TIn, class TOut> struct BlockRef { const TIn* Q; const TIn* K; const TIn* V; TOut* O; float* ML; int P0; };
template <class TIn> struct Seam {
    bf16x8 qr[8];
    bf16x8 st_v0, st_v1, st_k0, st_k1; f32x4 sf0, sf1, sf2, sf3;
    f32x4 tq[16];
};
__device__ __forceinline__ int swa_jlo(int P0, int W) { const int lowk = P0 - W + 1; return lowk > 0 ? lowk / KVBLK : 0; }
#define TROW(p, k0) ((p) + (size_t)(k0) * ld)
#define VMW() asm volatile("s_waitcnt vmcnt(0)" ::: "memory")
#define VMWN(n) asm volatile("s_waitcnt vmcnt(%0)" :: "i"(n) : "memory")
#define SLOAD_H(Kp, Vp, k0) do { const TIn* vt_ = TROW(Vp, k0); const TIn* kt_ = TROW(Kp, k0); S.st_v0 = load8<TIn>(vt_ + ro0); S.st_v1 = load8<TIn>(vt_ + ro1);              \
                         S.st_k0 = load8<TIn>(kt_ + ro0); S.st_k1 = load8<TIn>(kt_ + ro1); } while (0)
#define SWRITE_HK(bf) do { *(bf16x8*)(K_lds + (bf) * SHM_K + kws) = S.st_k0; *(bf16x8*)(K_lds + (bf) * SHM_K + kws + 32 * 256) = S.st_k1; } while (0)
#define SWRITE_HV(bf) do { *(bf16x8*)(V_lds + (bf) * SHM_V + vst0) = S.st_v0; *(bf16x8*)(V_lds + (bf) * SHM_V + vst1) = S.st_v1; } while (0)
#define SWRITE_H(bf) do { SWRITE_HV(bf); SWRITE_HK(bf); } while (0)
#define SLOAD_F(p, k0) do { const float* pt_ = TROW(p, k0); S.sf0 = *(const f32x4*)(pt_ + ro0); S.sf1 = *(const f32x4*)(pt_ + ro0 + 4);                \
                            S.sf2 = *(const f32x4*)(pt_ + ro1); S.sf3 = *(const f32x4*)(pt_ + ro1 + 4); } while (0)
#define SWRITE_KF(bf) do { *(bf16x8*)(K_lds + (bf) * SHM_K + kws) = pack8(S.sf0, S.sf1); *(bf16x8*)(K_lds + (bf) * SHM_K + kws + 32 * 256) = pack8(S.sf2, S.sf3); } while (0)
#define SWRITE_VF(bf) do { *(bf16x8*)(V_lds + (bf) * SHM_V + vst0) = pack8(S.sf0, S.sf1); *(bf16x8*)(V_lds + (bf) * SHM_V + vst1) = pack8(S.sf2, S.sf3); } while (0)
template <class TIn, class TOut>
__device__ __forceinline__ void causal_swa_prime(const BlockRef<TIn, TOut>& cur, int W, char* lds, Seam<TIn>& S, int ld, int tid_in) {
    constexpr bool F32 = same_t<TIn, float>::v;
    int tid_ = tid_in; asm volatile("" : "+v"(tid_));
    const int tid = tid_, wid = __builtin_amdgcn_readfirstlane(tid >> 6), lane = tid & 63, r32 = lane & 31, hi = lane >> 5;
    const int sr = tid >> 4, sc = (tid & 15) * 8, kws = KSWZ(sr, sc * 2); char* K_lds = lds + 2 * SHM_V;
    const unsigned ro0 = (unsigned)(sr * ld + sc), ro1 = (unsigned)((32 + sr) * ld + sc);
    const int kb0 = swa_jlo(cur.P0, W) * KVBLK;
    for (int d0 = 0; d0 < 8; ++d0) S.qr[d0] = load8<TIn>(cur.Q + (unsigned)((wid * QBLK + r32) * ld + d0 * 16 + hi * 8));
    if constexpr (F32) { SLOAD_F((const float*)cur.K, kb0); VMW(); SWRITE_KF(0); SBAR(); SLOAD_F((const float*)cur.V, kb0); }
    else { SLOAD_H(cur.K, cur.V, kb0); VMW(); SWRITE_HK(0); }
    __syncthreads();
}
template <class TIn, class TOut>
__device__ __forceinline__ void causal_swa_block(const BlockRef<TIn, TOut>& cur, const BlockRef<TIn, TOut>& nxt, int skv, int W, char* lds, Seam<TIn>& S, int ld, int mlstride, int tid_in) {
    constexpr bool F32 = same_t<TIn, float>::v;
    int tid_ = tid_in; asm volatile("" : "+v"(tid_));
    const int tid = tid_, wid = __builtin_amdgcn_readfirstlane(tid >> 6), lane = tid & 63, r32 = lane & 31, hi = lane >> 5;
    const int j_lo = swa_jlo(cur.P0, W);
    int j_hi = (cur.P0 + QB - 1) / KVBLK + 1; if (j_hi > skv / KVBLK) j_hi = skv / KVBLK;
    const int NT = j_hi - j_lo;
    const int kbn = swa_jlo(nxt.P0, W) * KVBLK;
    const int qlo = cur.P0 + wid * QBLK, qm = qlo + r32 - 4 * hi;
    char* V_lds = lds; char* K_lds = lds + 2 * SHM_V;
    float* ws = (float*)(lds + 2 * SHM_V + 2 * SHM_K) + wid * 64; float* li_l = ws, * al_l = ws + 32;
    float m_reg = -1e30f, l_reg = 0; f32x16 o[4] = {};
    const unsigned ro0 = (unsigned)((tid >> 4) * ld + (tid & 15) * 8), ro1 = (unsigned)((32 + (tid >> 4)) * ld + (tid & 15) * 8);
    const int sr = tid >> 4, sc = (tid & 15) * 8, vst0 = v_st(sr, sc), vst1 = v_st(32 + sr, sc), kws = KSWZ(sr, sc * 2);
    const int vb0 = (int)(uintptr_t)V_lds + v_rd_base(lane);
    const TIn* Kh = cur.K; const TIn* Vh = cur.V;
#define RESC(a) do { if (__any((a) < 1.f)) { if (hi == 0) al_l[r32] = (a); asm volatile("s_waitcnt lgkmcnt(0)" ::: "memory");              \
                     for (int d_ = 0; d_ < 4; ++d_) for (int r = 0; r < 16; ++r) o[d_][r] *= al_l[crow(r, hi)]; } } while (0)
#define KBASE(t) ((j_lo + (t)) * KVBLK)
#define ACT(t) (KBASE(t) <= qlo + QBLK - 1 && KBASE(t) + KVBLK - 1 >= qlo - W + 1)
#define MASKT(P0_, P1_, t) do { const int kb_ = KBASE(t); if ((!SK || ACT(t)) && (kb_ + KVBLK - 1 > qlo || kb_ <= qlo + QBLK - 1 - W)) mask_tile(P0_, P1_, qm - kb_, (unsigned)W); } while (0)
    constexpr int NQL = F32 ? 16 : 8;
    constexpr bool SK = WSKIP && !F32;
#define SEAM_K0() do { VMWN(NQL); if constexpr (F32) { SWRITE_KF(0); SBAR(); SLOAD_F((const float*)nxt.V, kbn); } else { SWRITE_HK(0); } SBAR(); } while (0)
    f32x16 pA0, pA1, pB0, pB1; float mnA, mnB, alA, alB; bf16x8 pa0, pa1, pa2, pa3;
    if constexpr (F32) { VMW(); SWRITE_VF(0); SBAR(); } else { SWRITE_HV(0); SBAR(); }
    if (NT > 1) { if constexpr (F32) SLOAD_F((const float*)Kh, KBASE(1)); else SLOAD_H(Kh, Vh, KBASE(1)); }
    SBAR(); qkt<0, SK>(pA0, pA1, K_lds, r32, hi, S.qr, ACT(0));
    if constexpr (F32) { if (NT > 1) { VMW(); SWRITE_KF(1); SBAR(); SLOAD_F((const float*)Vh, KBASE(1)); } }
    MASKT(pA0, pA1, 0); partialSM(pA0, pA1, m_reg, mnA, alA);
    if (NT > 1) { VMW(); if constexpr (F32) { SWRITE_VF(1); SBAR(); if (NT > 2) SLOAD_F((const float*)Kh, KBASE(2)); } else SWRITE_H(1); }
    __syncthreads();
#define HALF_STEP(PX0, PX1, mnX, alX, PY0, PY1, alY, t, KB, VB, SB) do {                                                      \
        SBAR(); qkt<KB, SK>(PX0, PX1, K_lds, r32, hi, S.qr, ACT(t));                                             \
        finishSM(PY0, PY1, alY, l_reg, pa0, pa1, pa2, pa3); SBAR();                                                           \
        if ((t) + 1 < NT) { if constexpr (F32) { VMW(); SWRITE_KF(SB); SBAR(); SLOAD_F((const float*)Vh, KBASE((t) + 1)); }  \
                            else { SLOAD_H(Kh, Vh, KBASE((t) + 1)); } SBAR(); }                                               \
        pv_tile<VB, SK>(o, vb0, pa0, pa1, pa2, pa3, ACT((t) - 1)); MASKT(PX0, PX1, (t)); partialSM(PX0, PX1, m_reg, mnX, alX);                                        \
        __syncthreads();                                                                                                      \
        if ((t) + 1 < NT) { VMW(); if constexpr (F32) { SWRITE_VF(SB); SBAR(); if ((t) + 2 < NT) SLOAD_F((const float*)Kh, KBASE((t) + 2)); } \
                            else { SWRITE_H(SB); } }                                                                          \
        RESC(alX); __syncthreads(); } while (0)
    for (int t = 1; t + 1 < NT; t += 2) {
        HALF_STEP(pB0, pB1, mnB, alB, pA0, pA1, alA, t, 1, 0, 0);
        HALF_STEP(pA0, pA1, mnA, alA, pB0, pB1, alB, t + 1, 0, 1, 1);
    }
    const bool even = (NT & 1) == 0;
    if (even) { SBAR(); qkt<1, SK>(pB0, pB1, K_lds, r32, hi, S.qr, ACT(NT - 1)); SBAR(); }
#define QROW(e) (nxt.Q + (unsigned)((wid * QBLK + r32) * ld + ((e) >> 1) * 16 + hi * 8 + ((e) & 1) * 4))
    if constexpr (F32) { SLOAD_F((const float*)nxt.K, kbn); SBAR();
#pragma unroll
        for (int e = 0; e < 8; ++e) S.tq[e] = *(const f32x4*)QROW(e); }
    else { SLOAD_H(nxt.K, nxt.V, kbn); SBAR();
#pragma unroll
        for (int d0 = 0; d0 < 8; ++d0) S.qr[d0] = load8<TIn>(nxt.Q + (unsigned)((wid * QBLK + r32) * ld + d0 * 16 + hi * 8)); }
    SBAR();
    finishSM(pA0, pA1, alA, l_reg, pa0, pa1, pa2, pa3); SBAR();
    if constexpr (F32) {
#pragma unroll
        for (int e = 8; e < 16; ++e) S.tq[e] = *(const f32x4*)QROW(e); SBAR(); }
#undef QROW
    pv_tile<0, SK>(o, vb0, pa0, pa1, pa2, pa3, ACT(even ? NT - 2 : NT - 1));
    if (even) { MASKT(pB0, pB1, NT - 1); partialSM(pB0, pB1, m_reg, mnB, alB); __syncthreads(); RESC(alB);
        finishSM(pB0, pB1, alB, l_reg, pa0, pa1, pa2, pa3); SBAR(); pv_tile<1, SK>(o, vb0, pa0, pa1, pa2, pa3, ACT(NT - 1)); }
    SBAR(); SEAM_K0();
    int r32e = r32, hie = hi; asm volatile("" : "+v"(r32e), "+v"(hie));
    if (hi == 0) li_l[r32] = l_reg; asm volatile("s_waitcnt lgkmcnt(0)" ::: "memory");
    float rli[16];
#pragma unroll
    for (int r = 0; r < 16; ++r) rli[r] = __builtin_amdgcn_rcpf(li_l[crow(r, hie)]);
    if (hie == 0) { float* mlp = cur.ML + (unsigned)((wid * QBLK + r32e) * mlstride * 2); mlp[0] = m_reg; mlp[1] = l_reg; }
    TOut* Ow = cur.O + (unsigned)(wid * QBLK * ld);
#pragma unroll
    for (int r = 0; r < 16; ++r) { const int orow = crow(r, hie);
#pragma unroll
        for (int d0 = 0; d0 < 4; ++d0) { const float v = o[d0][r] * rli[r];
            if constexpr (same_t<TOut, float>::v) { Ow[(unsigned)(orow * ld + d0 * 32 + r32e)] = v; }
            else { const float vn = __shfl_xor(v, 1);
                   if ((r32e & 1) == 0) *(unsigned*)(Ow + (unsigned)(orow * ld + d0 * 32 + r32e)) = cvtpk(v, vn); } } }
    if constexpr (F32) {
#pragma unroll
        for (int d0 = 0; d0 < 8; ++d0) S.qr[d0] = pack8(S.tq[2 * d0], S.tq[2 * d0 + 1]); }
    __syncthreads();
#undef RESC
#undef KBASE
#undef ACT
#undef MASKT
#undef SEAM_K0
#undef HALF_STEP
}
#undef TROW
#undef VMW
#undef VMWN
#undef SLOAD_H
#undef SWRITE_HK
#undef SWRITE_HV
#undef SWRITE_H
#undef SLOAD_F
#undef SWRITE_KF
#undef SWRITE_VF

}
constexpr int NWAVES = 8;
constexpr int RING_BYTES = 131072;
constexpr int LDSCTL_OFF = RING_BYTES, MISC_OFF = LDSCTL_OFF + 320;
constexpr int LDS_BYTES = 147456;
constexpr int CW_BAR = 4096;

#define GAS __attribute__((address_space(1)))
#define LAS __attribute__((address_space(3)))
typedef GAS unsigned gu32;
#define RLX_AGENT __ATOMIC_RELAXED, __HIP_MEMORY_SCOPE_AGENT
#define LDS_WAIT() asm volatile("s_waitcnt lgkmcnt(0)" ::: "memory")
#define VM_WAIT() asm volatile("s_waitcnt vmcnt(0)" ::: "memory")

#define XB_TMO      128
#define XB_XCNT(j)  (256  + 64 * (j))
#define XB_XSUB(j)  (1280 + 64 * (j))
#define XB_XGEN(j)  (2304 + 64 * (j))
#define XB_TOP      3328
#define XB_TOPGEN   3392
#define XCD_BAR_WORDS 3456
#define XB_SPIN_CAP (1u << 18)
__device__ __forceinline__ unsigned xb_ld(unsigned* p)              { return __hip_atomic_load(p, __ATOMIC_RELAXED, __HIP_MEMORY_SCOPE_AGENT); }
__device__ __forceinline__ unsigned xb_add(unsigned* p, unsigned v) { return __hip_atomic_fetch_add(p, v, __ATOMIC_RELAXED, __HIP_MEMORY_SCOPE_AGENT); }
__device__ __forceinline__ unsigned xb_xcc_id() { return (unsigned)__builtin_amdgcn_s_getreg((3 << 11) | 20) & 0xFu; }
#define XB_SPIN(cond, bar) do { unsigned _sp = 0; while (cond) { __builtin_amdgcn_s_sleep(1); \
    if ((++_sp & 255u) == 0u) { if (xb_ld(&(bar)[XB_TMO])) break; if (_sp > XB_SPIN_CAP) { atomicAdd(&(bar)[XB_TMO], 1u); break; } } } } while (0)
__device__ __forceinline__ int lane_id() { int l; asm volatile("v_mbcnt_lo_u32_b32 %0, -1, 0\n\tv_mbcnt_hi_u32_b32 %0, -1, %0" : "=v"(l)); return l; }
struct XcdBarrier { unsigned* bar; unsigned x; volatile LAS unsigned* st; int wave; };
__device__ __forceinline__ XcdBarrier xcd_barrier_post(unsigned* bar, volatile LAS unsigned* st, int wave) {
    XcdBarrier b; b.bar = bar; b.x = xb_xcc_id(); b.st = st; b.wave = wave;
    if (wave == 0 && lane_id() == 0) (void)xb_add(&bar[XB_XCNT(b.x)], 1u);
    return b;
}
__device__ __forceinline__ void xcd_barrier_complete(unsigned* bar, unsigned x, unsigned& nloc, unsigned& nx) {
    const unsigned G = gridDim.x * gridDim.y * gridDim.z;
    unsigned sum, cnt, mine, sp = 0u;
    for (;;) {
        sum = 0u; cnt = 0u; mine = 0u;
#pragma unroll
        for (unsigned j = 0; j < 16; ++j) { const unsigned c = xb_ld(&bar[XB_XCNT(j)]); sum += c; cnt += (c > 0u) ? 1u : 0u; mine = (j == x) ? c : mine; }
        if (sum == G) break;
        __builtin_amdgcn_s_sleep(1);
        if ((++sp & 255u) == 0u) { if (xb_ld(&bar[XB_TMO])) break; if (sp > XB_SPIN_CAP) { atomicAdd(&bar[XB_TMO], 1u); break; } }
    }
    nloc = mine > 0u ? mine : 1u; nx = cnt > 0u ? cnt : 1u;
}
__device__ __forceinline__ void xcd_barrier(const XcdBarrier& b) {
    asm volatile("s_waitcnt vmcnt(0)" ::: "memory");
    __syncthreads();
    if (b.wave == 0 && lane_id() == 0) {
        unsigned* bar = b.bar;
        __builtin_amdgcn_s_waitcnt(0);
        unsigned nloc = b.st[0], nx = b.st[1];
        if (nloc == 0u) { xcd_barrier_complete(bar, b.x, nloc, nx); b.st[0] = nloc; b.st[1] = nx; }
        const unsigned old = xb_add(&bar[XB_XSUB(b.x)], 1u);
        const unsigned gen = old / nloc;
        if (old + 1u == (gen + 1u) * nloc) {
            __builtin_amdgcn_fence(__ATOMIC_RELEASE, "agent");
            asm volatile("s_waitcnt vmcnt(0)" ::: "memory");
            const unsigned og = xb_add(&bar[XB_TOP], 1u);
            const unsigned tg = og / nx;
            if (og + 1u == (tg + 1u) * nx) xb_add(&bar[XB_TOPGEN], 1u);
            else XB_SPIN(xb_ld(&bar[XB_TOPGEN]) == tg, bar);
            __builtin_amdgcn_fence(__ATOMIC_ACQUIRE, "agent");
            xb_add(&bar[XB_XGEN(b.x)], 1u);
            asm volatile("s_waitcnt vmcnt(0)" ::: "memory");
        } else {
            XB_SPIN(xb_ld(&bar[XB_XGEN(b.x)]) == gen, bar);
            __builtin_amdgcn_fence(__ATOMIC_ACQUIRE, "agent");
            asm volatile("s_waitcnt vmcnt(0)" ::: "memory");
        }
    }
    __syncthreads();
}

struct Args { const float* in[19]; float* out; unsigned char* ws; int ph_lo, ph_hi, li, pad; };
#define OPQ_S(x) asm volatile("" : "+s"(x))
#define OPQ_V(x) asm volatile("" : "+v"(x))
struct Frame {
    LAS unsigned char* lds; char* ldsg;
    int tid, lane, wave, vcu, G;
    float* out; unsigned char* ws;
};
__device__ __forceinline__ Frame fresh(const Frame& F0) { Frame F = F0; OPQ_S(F.ws); OPQ_S(F.out); int ln = lane_id(); OPQ_V(ln); F.lane = ln; F.tid = F.wave * 64 + ln; F.ldsg = (char*)(__attribute__((address_space(3))) char*)F.lds; return F; }
__device__ __forceinline__ float wave_sum(float v) {
#pragma unroll
    for (int o = 1; o < 64; o <<= 1) v += __shfl_xor(v, o);
    return v;
}
__device__ __forceinline__ unsigned f2bf(float f) { unsigned u = __builtin_bit_cast(unsigned, f); return (u + 0x7fffu + ((u >> 16) & 1u)) >> 16; }
typedef float f32x2_t __attribute__((ext_vector_type(2))); typedef __bf16 bf16x2_t __attribute__((ext_vector_type(2)));
__device__ __forceinline__ unsigned pk2(float lo, float hi) { f32x2_t v = {lo, hi}; bf16x2_t b = __builtin_convertvector(v, bf16x2_t); return __builtin_bit_cast(unsigned, b); }

enum WKind { WK_IE = 0, WK_OE = 1, WK_IO = 2, WK_OO = 3, WK_PW = 4 };
typedef short v4i16_t __attribute__((ext_vector_type(4)));
template <int KIND>
__device__ __forceinline__ void p0_transpose_item(const float* W, int K, int N, bf16_t* WT, LAS unsigned char* tile, int item, int lane) {
    const int nblk = N / 64, kb = item / nblk, nb = item % nblk, k0 = 64 * kb, n0 = 64 * nb;
    const int r = lane >> 4, c4 = lane & 15;
    f32x4 v[16];
    const float* src = W + (size_t)(k0 + r) * N + n0 + 4 * c4;
#pragma unroll
    for (int i = 0; i < 16; ++i) v[i] = *(const GAS f32x4*)(src + (size_t)(4 * i) * N);
#pragma unroll
    for (int i = 0; i < 16; ++i) { u32x2 o; o.x = pk2(v[i][0], v[i][1]); o.y = pk2(v[i][2], v[i][3]); *(LAS u32x2*)(tile + (4 * i + r) * 192 + 8 * c4) = o; }
    LDS_WAIT(); asm volatile("" ::: "memory");
    const int g = lane >> 4, q = (lane >> 2) & 3, pp = lane & 3, nn = n0 + 16 * g + (lane & 15);
    const int prow = KIND == WK_IE ? phys_ie(nn) : KIND == WK_IO ? phys_io(nn) : KIND == WK_PW ? nn : phys_out(nn);
    const LAS unsigned char* rb = tile + q * 192 + (16 * g + 4 * pp) * 2;
    bf16_t* dst = WT + (size_t)prow * K + k0;
#pragma unroll
    for (int c = 0; c < 8; ++c) {
        const v4i16_t lo = __builtin_amdgcn_ds_read_tr16_b64_v4i16((LAS v4i16_t*)(rb + (8 * c) * 192));
        const v4i16_t hi = __builtin_amdgcn_ds_read_tr16_b64_v4i16((LAS v4i16_t*)(rb + (8 * c + 4) * 192));
        u32x4 o; const u32x2 a = __builtin_bit_cast(u32x2, lo), b = __builtin_bit_cast(u32x2, hi); o.x = a.x; o.y = a.y; o.z = b.x; o.w = b.y;
        *(GAS u32x4*)(dst + 8 * c) = o;
    }
    LDS_WAIT(); asm volatile("" ::: "memory");
}
__device__ __forceinline__ void p0_phase(Frame& F, const Args& args) {
    const float* cp = args.in[2]; const float* cs = args.in[3]; const float* ada_w = args.in[8]; const float* ada_b = args.in[9];
    float* mod = (float*)(F.ws + WS_MOD);
    __syncthreads();
    LAS float* sc = (LAS float*)F.lds;
    LAS float* red = (LAS float*)(F.lds + 81920);
    for (int i = F.tid; i < NSEQ * DM; i += NWAVES * 64) { const int b = i / DM, k = i % DM; const float c = b < NB_P ? cp[b * DM + k] : cs[(b - NB_P) * DM + k]; sc[i] = c / (1.f + expf(-c)); }
    __syncthreads();
    for (int rp_ = 0; rp_ < (EXP_PH == 11 ? 2 : 1); ++rp_)
    for (int u = F.vcu; u < DEPTH * (MODW / 32); u += F.G) {
        const int l = u / (MODW / 32), j0 = (u % (MODW / 32)) * 32, kr = F.tid >> 3, cj = F.tid & 7;
        float acc[NSEQ][4];
#pragma unroll
        for (int b = 0; b < NSEQ; ++b) { acc[b][0] = 0.f; acc[b][1] = 0.f; acc[b][2] = 0.f; acc[b][3] = 0.f; }
        const float* wp = ada_w + ((size_t)l * DM + kr) * MODW + j0 + 4 * cj;
#pragma unroll 8
        for (int it = 0; it < DM / 64; ++it) {
            const f32x4 w = *(const f32x4*)(wp + (size_t)it * 64 * MODW); const int k = kr + 64 * it;
#pragma unroll
            for (int b = 0; b < NSEQ; ++b) { const float s = sc[b * DM + k]; acc[b][0] += s * w[0]; acc[b][1] += s * w[1]; acc[b][2] += s * w[2]; acc[b][3] += s * w[3]; }
        }
#pragma unroll
        for (int b = 0; b < NSEQ; ++b)
#pragma unroll
            for (int e = 0; e < 4; ++e) { float v = acc[b][e]; v += __shfl_xor(v, 8); v += __shfl_xor(v, 16); v += __shfl_xor(v, 32); if (F.lane < 8) red[(F.wave * 8 + F.lane) * 40 + b * 4 + e] = v; }
        __syncthreads();
        if (F.tid < 320) { const int cj2 = F.tid / 40, be = F.tid % 40, b = be >> 2, e = be & 3; float s = 0.f;
#pragma unroll
            for (int w = 0; w < NWAVES; ++w) s += red[(w * 8 + cj2) * 40 + be];
            const int j = j0 + 4 * cj2 + e; mod[((size_t)l * NSEQ + b) * MODW + j] = s + ada_b[l * MODW + j]; }
        __syncthreads();
    }
    __syncthreads();
    LAS unsigned char* tile = F.lds + F.wave * 12288;
    const int gw = F.vcu * NWAVES + F.wave, NGW = F.G * NWAVES;
    constexpr int I_IE = (DM / 64) * (N_EVEN_IN / 64), I_OE = (DM / 64) * (DM / 64), I_IO = (DM / 64) * (N_ODD_IN / 64), I_PW = (PG / 64) * (PG / 64);
    constexpr int NITEMS = 2 * (I_IE + I_OE + I_IO + I_OE) + 8 * I_PW;
    for (int rp_ = 0; rp_ < (EXP_PH == 12 ? 2 : 1); ++rp_)
    for (int it = gw; it < NITEMS; it += NGW) {
        int r = it;
        if (r < 2 * I_IE) { const int li = r / I_IE; p0_transpose_item<WK_IE>(args.in[11] + (size_t)li * DM * N_EVEN_IN, DM, N_EVEN_IN, (bf16_t*)(F.ws + WS_WIE) + (size_t)li * N_EVEN_IN * DM, tile, r % I_IE, F.lane); continue; } r -= 2 * I_IE;
        if (r < 2 * I_OE) { const int li = r / I_OE; p0_transpose_item<WK_OE>(args.in[12] + (size_t)li * DM * DM, DM, DM, (bf16_t*)(F.ws + WS_WOE) + (size_t)li * DM * DM, tile, r % I_OE, F.lane); continue; } r -= 2 * I_OE;
        if (r < 2 * I_IO) { const int li = r / I_IO; p0_transpose_item<WK_IO>(args.in[15] + (size_t)li * DM * N_ODD_IN, DM, N_ODD_IN, (bf16_t*)(F.ws + WS_WIO) + (size_t)li * N_ODD_IN * DM, tile, r % I_IO, F.lane); continue; } r -= 2 * I_IO;
        if (r < 2 * I_OE) { const int li = r / I_OE; p0_transpose_item<WK_OO>(args.in[17] + (size_t)li * DM * DM, DM, DM, (bf16_t*)(F.ws + WS_WOO) + (size_t)li * DM * DM, tile, r % I_OE, F.lane); continue; } r -= 2 * I_OE;
        { const int g = r / I_PW; p0_transpose_item<WK_PW>(args.in[13] + (size_t)g * PG * PG, PG, PG, (bf16_t*)(F.ws + WS_WPW) + (size_t)g * PG * PG, tile, r % I_PW, F.lane); }
    }
    float* rc = (float*)(F.ws + WS_ROPE); float* rsn = rc + (size_t)ROPE_ROWS * 64;
    for (int rp_ = 0; rp_ < (EXP_PH == 13 ? 2 : 1); ++rp_)
    for (int i = gw * 64 + F.lane; i < ROPE_ROWS * 64; i += NGW * 64) {
        const int row = i >> 6, dd = i & 63; const double pos = row < T_P ? (double)row : (double)(PAST + row - T_P);
        const double inv = pow(10000.0, -(double)dd / 64.0), ang = pos * inv;
        rc[i] = (float)cos(ang); rsn[i] = (float)sin(ang);
    }
}

__device__ __forceinline__ void p1_phase(Frame& F, const Args& args) {
    const float* mod = (const float*)(F.ws + WS_MOD); float* shw = (float*)(F.ws + WS_SHW);
    const int gw = F.vcu * NWAVES + F.wave, NGW = F.G * NWAVES;
    constexpr int NTILES = (2 * N_EVEN_IN + 2 * N_ODD_IN) / 16;
    for (int tt = gw; tt < NTILES; tt += NGW) {
        int l, p0; const bf16_t* wt;
        if (tt < 2 * N_EVEN_IN / 16) { const int li = tt / (N_EVEN_IN / 16); p0 = (tt % (N_EVEN_IN / 16)) * 16; l = 2 * li; wt = (const bf16_t*)(F.ws + WS_WIE) + ((size_t)li * N_EVEN_IN + p0) * DM; }
        else { const int t2 = tt - 2 * N_EVEN_IN / 16, li = t2 / (N_ODD_IN / 16); p0 = (t2 % (N_ODD_IN / 16)) * 16; l = 2 * li + 1; wt = (const bf16_t*)(F.ws + WS_WIO) + ((size_t)li * N_ODD_IN + p0) * DM; }
        const int fr = F.lane & 15, fq = F.lane >> 4;
        const bf16_t* wp = wt + (size_t)fr * DM + 8 * fq;
        const float* sp = mod + ((size_t)l * NSEQ + (fr < NSEQ ? fr : 0)) * MODW + 8 * fq;
        const float keep = fr < NSEQ ? 1.f : 0.f;
        f32x4 acc = {0.f, 0.f, 0.f, 0.f};
#pragma unroll 8
        for (int ks = 0; ks < DM / 32; ++ks) {
            const bf16x8 w = *(const GAS bf16x8*)(wp + 32 * ks);
            const f32x4 s0 = *(const f32x4*)(sp + 32 * ks) * keep, s1 = *(const f32x4*)(sp + 32 * ks + 4) * keep;
            u32x4 sb; sb.x = pk2(s0[0], s0[1]); sb.y = pk2(s0[2], s0[3]); sb.z = pk2(s1[0], s1[1]); sb.w = pk2(s1[2], s1[3]);
            acc = __builtin_amdgcn_mfma_f32_16x16x32_bf16(w, __builtin_bit_cast(bf16x8, sb), acc, 0, 0, 0);
        }
        if (fr < NSEQ) *(f32x4*)(shw + ((size_t)l * NSEQ + fr) * SHW_LD + p0 + 4 * fq) = acc;
    }
    const float* g0 = args.in[10]; float* partss = (float*)(F.ws + WS_PARTSS); bf16_t* A = (bf16_t*)(F.ws + WS_A);
    for (int row = gw; row < MP + MS; row += NGW) {
        const float* xr = row < MP ? args.in[0] + (size_t)row * DM : args.in[1] + (size_t)(row - MP) * DM;
        const int b = row < MP ? row / T_P : NB_P + (row - MP) / T_S;
        const float* scl = mod + ((size_t)0 * NSEQ + b) * MODW + DM; float ss = 0.f;
#pragma unroll
        for (int i = 0; i < 8; ++i) { const int c = 4 * (F.lane + 64 * i);
            const f32x4 x = *(const f32x4*)(xr + c), g = *(const f32x4*)(g0 + c), s = *(const f32x4*)(scl + c);
            ss += (x[0] * x[0] + x[1] * x[1]) + (x[2] * x[2] + x[3] * x[3]);
            const f32x4 a = x * (g * (s + 1.0f)); u32x2 o; o.x = pk2(a[0], a[1]); o.y = pk2(a[2], a[3]);
            *(GAS u32x2*)(A + (size_t)row * DM + c) = o; }
        ss = wave_sum(ss);
        if (row < MP) { if (F.lane < NPART) partss[(size_t)row * NPART + F.lane] = F.lane == 0 ? ss : 0.f; }
        else ((float*)(F.ws + WS_PSS_S))[(size_t)(row - MP) * 64 + F.lane] = F.lane == 0 ? ss : 0.f;
    }
}

__device__ __forceinline__ void att_phase(Frame& F) {
    using bf = at::bf16;
    const bf* QR = (const bf*)(F.ws + WS_QR); const bf* KR = (const bf*)(F.ws + WS_KR); const bf* VB = (const bf*)(F.ws + WS_VB);
    bf* OP = (bf*)(F.ws + WS_OPART); float* ML = (float*)(F.ws + WS_ML);
    const int cls = (int)blockIdx.x & 7, idx = (int)blockIdx.x >> 3, per = F.G >> 3;
    for (int q = idx; q < 96; q += per) {
        const int bh = 2 * cls + q / 48, w = q % 48, pat = w >> 4, z = w & 15;
        const int b = bh >> 3, h = bh & 7;
        const int dil = pat == 0 ? 1 : pat == 1 ? 4 : 16;
        const int nblk = 16 / dil;
        const int res = z / nblk, blk = z % nblk;
        const int ld = dil * D_ATTN, skv = T_P / dil, P0 = blk * at::QB;
        const size_t base = ((size_t)b * T_P + res) * D_ATTN + h * HD;
        at::BlockRef<bf, bf> cur;
        cur.Q = QR + base + (size_t)P0 * ld; cur.K = KR + base; cur.V = VB + base;
        cur.O = OP + (size_t)pat * MP * D_ATTN + base + (size_t)P0 * ld;
        cur.ML = ML + (((size_t)pat * MP + (size_t)b * T_P + res + (size_t)P0 * dil) * NH + h) * 2;
        cur.P0 = P0;
        at::Seam<bf> S;
        at::causal_swa_prime<bf, bf>(cur, at::WINDOW, F.ldsg, S, ld, F.tid);
        at::causal_swa_block<bf, bf>(cur, cur, skv, at::WINDOW, F.ldsg, S, ld, dil * NH, F.tid);
    }
}

__device__ __forceinline__ void cmb_phase(Frame& F, const Args& args, int li) {
    const int gw = F.vcu * NWAVES + F.wave, NGW = F.G * NWAVES;
    const bf16_t* OP = (const bf16_t*)(F.ws + WS_OPART); const float* ML = (const float*)(F.ws + WS_ML);
    const bf16_t* GA = (const bf16_t*)(F.ws + WS_GA); bf16_t* MG = (bf16_t*)(F.ws + WS_MERGED);
    constexpr float C2 = 1.4426950408889634f * 0.08838834764831845f;
    for (int row = gw; row < MP; row += NGW) {
        const int h = F.lane >> 3;
        float m[3], l[3];
#pragma unroll
        for (int p = 0; p < 3; ++p) { const float* q = ML + (((size_t)p * MP + row) * NH + h) * 2; m[p] = q[0]; l[p] = q[1]; }
        const float mm = fmaxf(m[0], fmaxf(m[1], m[2]));
        float w[3]; float ws = 0.f;
#pragma unroll
        for (int p = 0; p < 3; ++p) { w[p] = __builtin_amdgcn_exp2f((m[p] - mm) * C2) * l[p]; ws += w[p]; }
        const float inv = 1.f / ws;
        float o[16];
#pragma unroll
        for (int e = 0; e < 16; ++e) o[e] = 0.f;
#pragma unroll
        for (int p = 0; p < 3; ++p) { const float wp = w[p] * inv; const bf16_t* src = OP + ((size_t)p * MP + row) * D_ATTN + 16 * F.lane;
#pragma unroll
            for (int hh = 0; hh < 2; ++hh) { const u32x4 v = *(const GAS u32x4*)(src + 8 * hh);
                o[8 * hh + 0] += wp * __uint_as_float(v.x << 16); o[8 * hh + 1] += wp * __uint_as_float(v.x & 0xffff0000u);
                o[8 * hh + 2] += wp * __uint_as_float(v.y << 16); o[8 * hh + 3] += wp * __uint_as_float(v.y & 0xffff0000u);
                o[8 * hh + 4] += wp * __uint_as_float(v.z << 16); o[8 * hh + 5] += wp * __uint_as_float(v.z & 0xffff0000u);
                o[8 * hh + 6] += wp * __uint_as_float(v.w << 16); o[8 * hh + 7] += wp * __uint_as_float(v.w & 0xffff0000u); } }
#pragma unroll
        for (int hh = 0; hh < 2; ++hh) { const u32x4 g = *(const GAS u32x4*)(GA + (size_t)row * D_ATTN + 16 * F.lane + 8 * hh); u32x4 r;
            r.x = pk2(o[8 * hh + 0] * __uint_as_float(g.x << 16), o[8 * hh + 1] * __uint_as_float(g.x & 0xffff0000u));
            r.y = pk2(o[8 * hh + 2] * __uint_as_float(g.y << 16), o[8 * hh + 3] * __uint_as_float(g.y & 0xffff0000u));
            r.z = pk2(o[8 * hh + 4] * __uint_as_float(g.z << 16), o[8 * hh + 5] * __uint_as_float(g.z & 0xffff0000u));
            r.w = pk2(o[8 * hh + 6] * __uint_as_float(g.w << 16), o[8 * hh + 7] * __uint_as_float(g.w & 0xffff0000u));
            *(GAS u32x4*)(MG + (size_t)row * DM + 16 * F.lane + 8 * hh) = r; }
    }
    const bf16_t* UB = (const bf16_t*)(F.ws + WS_UB); const bf16_t* GP = (const bf16_t*)(F.ws + WS_GP);
    const bf16_t* PW = (const bf16_t*)(F.ws + WS_WPW) + (size_t)li * 4 * PG * PG;
    const float* pscale = args.in[14] + (size_t)li * D_POOL;
    constexpr int LDA = 264;
    LAS bf16_t* Us = (LAS bf16_t*)F.lds;
    LAS bf16_t* As = (LAS bf16_t*)(F.lds + 40960);
    for (int u = F.vcu; u < (MP / 64) * 4; u += F.G) {
        const int rt = u >> 2, g = u & 3, R0 = rt * 64, t0 = R0 & (T_P - 1), wlen = 2 << g;
        __syncthreads();
        for (int i = F.tid; i < 79 * 32; i += NWAVES * 64) { const int rr = i >> 5, ck = i & 31, t = t0 - 15 + rr; u32x4 v = {0u, 0u, 0u, 0u};
            if (t >= 0) v = *(const GAS u32x4*)(UB + (size_t)(R0 - 15 + rr) * D_POOL + 256 * g + 8 * ck);
            *(LAS u32x4*)(Us + rr * 256 + 8 * ck) = v; }
        __syncthreads();
        for (int i = F.tid; i < 64 * 128; i += NWAVES * 64) { const int row = i >> 7, cp = i & 127; float s0 = 0.f, s1 = 0.f;
            for (int j = 0; j < wlen; ++j) { const unsigned v = *(const LAS unsigned*)(Us + (row + 15 - j) * 256 + 2 * cp); s0 += __uint_as_float(v << 16); s1 += __uint_as_float(v & 0xffff0000u); }
            const unsigned vc = *(const LAS unsigned*)(Us + (row + 15) * 256 + 2 * cp); const int t = t0 + row; const float ic = 1.f / (float)((t + 1) < wlen ? (t + 1) : wlen);
            *(LAS unsigned*)(As + row * LDA + 2 * cp) = pk2(s0 * ic - __uint_as_float(vc << 16), s1 * ic - __uint_as_float(vc & 0xffff0000u)); }
        __syncthreads();
        f32x4 acc[4][2];
#pragma unroll
        for (int mt = 0; mt < 4; ++mt) { acc[mt][0] = (f32x4){0.f, 0.f, 0.f, 0.f}; acc[mt][1] = (f32x4){0.f, 0.f, 0.f, 0.f}; }
        const int fr = F.lane & 15, fq = F.lane >> 4;
#pragma unroll 2
        for (int ks = 0; ks < 8; ++ks) {
            bf16x8 a[4], bb[2];
#pragma unroll
            for (int mt = 0; mt < 4; ++mt) a[mt] = *(const LAS bf16x8*)(As + (16 * mt + fr) * LDA + 32 * ks + 8 * fq);
#pragma unroll
            for (int nt = 0; nt < 2; ++nt) bb[nt] = *(const GAS bf16x8*)(PW + ((size_t)g * PG + 32 * F.wave + 16 * nt + fr) * PG + 32 * ks + 8 * fq);
#pragma unroll
            for (int mt = 0; mt < 4; ++mt)
#pragma unroll
                for (int nt = 0; nt < 2; ++nt) acc[mt][nt] = __builtin_amdgcn_mfma_f32_16x16x32_bf16(bb[nt], a[mt], acc[mt][nt], 0, 0, 0);
        }
#pragma unroll
        for (int nt = 0; nt < 2; ++nt) { const int col = 256 * g + 32 * F.wave + 16 * nt + 4 * fq; const f32x4 ps = *(const f32x4*)(pscale + col);
#pragma unroll
            for (int mt = 0; mt < 4; ++mt) { const int row = R0 + 16 * mt + fr; const u32x2 gv = *(const GAS u32x2*)(GP + (size_t)row * D_POOL + col); const f32x4 v = acc[mt][nt] * ps; u32x2 o;
                o.x = pk2(v[0] * __uint_as_float(gv.x << 16), v[1] * __uint_as_float(gv.x & 0xffff0000u)); o.y = pk2(v[2] * __uint_as_float(gv.y << 16), v[3] * __uint_as_float(gv.y & 0xffff0000u));
                *(GAS u32x2*)(MG + (size_t)row * DM + D_ATTN + col) = o; } }
    }
    __syncthreads();
}

__device__ __forceinline__ void cnv_phase(Frame& F, const Args& args, int li) {
    const bf16_t* UO = (const bf16_t*)(F.ws + WS_UO); const bf16_t* ZO = (const bf16_t*)(F.ws + WS_ZO); bf16_t* MG = (bf16_t*)(F.ws + WS_MERGED);
    const float* cw = args.in[16] + (size_t)li * 3 * D_CONV;
    for (int u = F.vcu; u < MP / 32; u += F.G) {
        const int cgp = F.tid & 255, rh = F.tid >> 8, r0 = u * 32 + rh * 16, c = 8 * cgp;
        float w0[8], w1[8], w2[8];
#pragma unroll
        for (int e = 0; e < 8; ++e) { w0[e] = cw[c + e]; w1[e] = cw[D_CONV + c + e]; w2[e] = cw[2 * D_CONV + c + e]; }
        float zm2[8], zm1[8];
        { const int t = r0 & (T_P - 1); u32x4 a = {0u, 0u, 0u, 0u}, b = {0u, 0u, 0u, 0u};
          if (t >= 2) a = *(const GAS u32x4*)(ZO + (size_t)(r0 - 2) * D_CONV + c);
          if (t >= 1) b = *(const GAS u32x4*)(ZO + (size_t)(r0 - 1) * D_CONV + c);
          zm2[0] = __uint_as_float(a.x << 16); zm2[1] = __uint_as_float(a.x & 0xffff0000u); zm2[2] = __uint_as_float(a.y << 16); zm2[3] = __uint_as_float(a.y & 0xffff0000u);
          zm2[4] = __uint_as_float(a.z << 16); zm2[5] = __uint_as_float(a.z & 0xffff0000u); zm2[6] = __uint_as_float(a.w << 16); zm2[7] = __uint_as_float(a.w & 0xffff0000u);
          zm1[0] = __uint_as_float(b.x << 16); zm1[1] = __uint_as_float(b.x & 0xffff0000u); zm1[2] = __uint_as_float(b.y << 16); zm1[3] = __uint_as_float(b.y & 0xffff0000u);
          zm1[4] = __uint_as_float(b.z << 16); zm1[5] = __uint_as_float(b.z & 0xffff0000u); zm1[6] = __uint_as_float(b.w << 16); zm1[7] = __uint_as_float(b.w & 0xffff0000u); }
#pragma unroll 4
        for (int i = 0; i < 16; ++i) { const size_t off = (size_t)(r0 + i) * D_CONV + c;
            const u32x4 zv = *(const GAS u32x4*)(ZO + off), uv = *(const GAS u32x4*)(UO + off);
            float z[8], uu[8];
            z[0] = __uint_as_float(zv.x << 16); z[1] = __uint_as_float(zv.x & 0xffff0000u); z[2] = __uint_as_float(zv.y << 16); z[3] = __uint_as_float(zv.y & 0xffff0000u);
            z[4] = __uint_as_float(zv.z << 16); z[5] = __uint_as_float(zv.z & 0xffff0000u); z[6] = __uint_as_float(zv.w << 16); z[7] = __uint_as_float(zv.w & 0xffff0000u);
            uu[0] = __uint_as_float(uv.x << 16); uu[1] = __uint_as_float(uv.x & 0xffff0000u); uu[2] = __uint_as_float(uv.y << 16); uu[3] = __uint_as_float(uv.y & 0xffff0000u);
            uu[4] = __uint_as_float(uv.z << 16); uu[5] = __uint_as_float(uv.z & 0xffff0000u); uu[6] = __uint_as_float(uv.w << 16); uu[7] = __uint_as_float(uv.w & 0xffff0000u);
            float y[8];
#pragma unroll
            for (int e = 0; e < 8; ++e) { y[e] = uu[e] * (w0[e] * zm2[e] + w1[e] * zm1[e] + w2[e] * z[e]); zm2[e] = zm1[e]; zm1[e] = z[e]; }
            u32x4 o; o.x = pk2(y[0], y[1]); o.y = pk2(y[2], y[3]); o.z = pk2(y[4], y[5]); o.w = pk2(y[6], y[7]);
            *(GAS u32x4*)(MG + off) = o; }
    }
}

__device__ __forceinline__ void fin_phase(Frame& F, const Args& args) {
    const int gw = F.vcu * NWAVES + F.wave, NGW = F.G * NWAVES;
    const float* partss = (const float*)(F.ws + WS_PARTSS); const float* fg = args.in[18]; float* y = F.out + O_YP;
    for (int row = gw; row < MP; row += NGW) {
        float s = F.lane < NPART ? partss[(size_t)row * NPART + F.lane] : 0.f; s = wave_sum(s);
        const float rstd = rsqrtf(s * (1.0f / DM) + EPS);
#pragma unroll
        for (int i = 0; i < 8; ++i) { const int c = 4 * (F.lane + 64 * i); f32x4 x = *(const f32x4*)(y + (size_t)row * DM + c); const f32x4 g = *(const f32x4*)(fg + c);
            x = x * rstd * g; *(f32x4*)(y + (size_t)row * DM + c) = x; }
    }
}

constexpr int SRAW_LD = 8192, NPS = 64;
constexpr float ATT_SCALE = 0.08838834764831845f;

template <int KIND, class Epi>
__device__ __forceinline__ void skinny_gemm(Frame& F, const bf16_t* As, const bf16_t* Bt, int N, const Epi& E) {
    LAS f32x4* red = (LAS f32x4*)F.lds;
    const int fr = F.lane & 15, fq = F.lane >> 4;
    for (int grp = F.vcu; grp < N / 32; grp += F.G) {
        const int c0 = grp * 32;
        f32x4 acc[4][2];
#pragma unroll
        for (int mt = 0; mt < 4; ++mt) { acc[mt][0] = (f32x4){0.f, 0.f, 0.f, 0.f}; acc[mt][1] = (f32x4){0.f, 0.f, 0.f, 0.f}; }
        const bf16_t* bp[2];
#pragma unroll
        for (int nt = 0; nt < 2; ++nt) { const int c = c0 + 16 * nt + fr; const int prow = KIND == WK_IE ? phys_ie(c) : KIND == WK_IO ? phys_io(c) : phys_out(c); bp[nt] = Bt + (size_t)prow * DM + 256 * F.wave + 8 * fq; }
        const bf16_t* ap = As + (size_t)fr * DM + 256 * F.wave + 8 * fq;
#pragma unroll 4
        for (int ks = 0; ks < 8; ++ks) {
            bf16x8 a[4], b[2];
#pragma unroll
            for (int nt = 0; nt < 2; ++nt) b[nt] = *(const GAS bf16x8*)(bp[nt] + 32 * ks);
#pragma unroll
            for (int mt = 0; mt < 4; ++mt) a[mt] = *(const GAS bf16x8*)(ap + (size_t)mt * 16 * DM + 32 * ks);
#pragma unroll
            for (int mt = 0; mt < 4; ++mt)
#pragma unroll
                for (int nt = 0; nt < 2; ++nt) acc[mt][nt] = __builtin_amdgcn_mfma_f32_16x16x32_bf16(b[nt], a[mt], acc[mt][nt], 0, 0, 0);
        }
        __syncthreads();
#pragma unroll
        for (int mt = 0; mt < 4; ++mt)
#pragma unroll
            for (int nt = 0; nt < 2; ++nt) red[(F.wave * 8 + mt * 2 + nt) * 64 + F.lane] = acc[mt][nt];
        __syncthreads();
        { const int s = F.tid >> 6, l2 = F.tid & 63; f32x4 sum = red[s * 64 + l2];
#pragma unroll
          for (int w = 1; w < NWAVES; ++w) sum += red[(w * 8 + s) * 64 + l2];
          const int m = 16 * (s >> 1) + (l2 & 15), c = c0 + 16 * (s & 1) + 4 * (l2 >> 4);
          E(m, c, sum, grp, F); }
    }
    __syncthreads();
}
__device__ __forceinline__ LAS float* sample_rstd_table(Frame& F) {
    LAS float* rs = (LAS float*)(F.lds + 65536 + 4096);
    const float* pss = (const float*)(F.ws + WS_PSS_S);
    { const int row = F.tid >> 3, j = F.tid & 7; const f32x4 a = *(const f32x4*)(pss + row * NPS + 8 * j), b = *(const f32x4*)(pss + row * NPS + 8 * j + 4);
      float s = (a[0] + a[1]) + (a[2] + a[3]) + (b[0] + b[1]) + (b[2] + b[3]); s += __shfl_xor(s, 1); s += __shfl_xor(s, 2); s += __shfl_xor(s, 4);
      if (j == 0) rs[row] = rsqrtf(s * (1.0f / DM) + EPS); }
    __syncthreads();
    return rs;
}
template <int KIND> struct EpiSRaw {
    const float* shw; LAS float* rs; float* sraw;
    __device__ __forceinline__ void operator()(int m, int c, f32x4 sum, int grp, Frame& F) const {
        const int seq = NB_P + (m >> 3); const int prow = KIND == WK_IE ? phys_ie(c) : phys_io(c);
        const f32x4 sh = *(const f32x4*)(shw + (size_t)seq * SHW_LD + prow);
        *(f32x4*)(sraw + (size_t)m * SRAW_LD + c) = sum * rs[m] + sh;
    }
};
struct EpiSG2 {
    const float* xin; float* xout; bf16_t* anext; const float* modl; const float* modn; const float* gn; float* pss;
    __device__ __forceinline__ void operator()(int m, int c, f32x4 sum, int grp, Frame& F) const {
        LAS float* sq = (LAS float*)(F.lds + 65536);
        const int seq = NB_P + (m >> 3);
        const f32x4 gt = *(const f32x4*)(modl + (size_t)seq * MODW + 2 * DM + c), x0 = *(const f32x4*)(xin + (size_t)m * DM + c);
        const f32x4 y = x0 + gt * sum;
        *(f32x4*)(xout + (size_t)m * DM + c) = y;
        if (anext) { const f32x4 sc = *(const f32x4*)(modn + (size_t)seq * MODW + DM + c), g = *(const f32x4*)(gn + c); const f32x4 a = y * (g * (sc + 1.0f));
            u32x2 o; o.x = pk2(a[0], a[1]); o.y = pk2(a[2], a[3]); *(GAS u32x2*)(anext + (size_t)m * DM + c) = o; }
        sq[m * 8 + ((c >> 2) & 7)] = (y[0] * y[0] + y[1] * y[1]) + (y[2] * y[2] + y[3] * y[3]);
        __syncthreads();
        if (F.tid < 64) { const f32x4 a = *(const LAS f32x4*)(sq + F.tid * 8), b = *(const LAS f32x4*)(sq + F.tid * 8 + 4); pss[F.tid * NPS + grp] = (a[0] + a[1]) + (a[2] + a[3]) + (b[0] + b[1]) + (b[2] + b[3]); }
    }
};

constexpr int SA_CH = 322, SA_WR = 41;
constexpr size_t WS_SNEW = WS_SML + 64 * 1024;
__device__ __forceinline__ int sa_row(int a) { return a < 768 ? ((a >> 3) << 4) + (a & 7) : a + 768; }
__device__ __forceinline__ void satt_phase(Frame& F, const Args& args, int li) {
    const float* sraw = (const float*)(F.ws + WS_SRAW);
    const float* rope_c = (const float*)(F.ws + WS_ROPE) + (size_t)T_P * 64; const float* rope_s = rope_c + (size_t)ROPE_ROWS * 64;
    const float* stk = args.in[4] + (size_t)li * NB_S * WBUF * D_ATTN; const float* stv = args.in[5] + (size_t)li * NB_S * WBUF * D_ATTN;
    float* sop = (float*)(F.ws + WS_SOP); float* sml = (float*)(F.ws + WS_SML); float* snew = (float*)(F.ws + WS_SNEW);
    LAS float* qs = (LAS float*)F.lds;
    LAS float* Pt = qs + 1024 + F.wave * 384;
    LAS float* st = qs + 1024 + 8 * 384;
    LAS float* mg = st + 128;
    const int fr = F.lane & 15, fq = F.lane >> 4;
    for (int u = F.vcu; u < NB_S * NH * 4; u += F.G) {
        const int c = u & 3, bh = u >> 2, b = bh >> 3, h = bh & 7;
        __syncthreads();
        { const int row = F.tid >> 6, d2 = F.tid & 63, m = b * T_S + row; const float cs = rope_c[row * 64 + d2], sn = rope_s[row * 64 + d2];
          const float* src = sraw + (size_t)m * SRAW_LD + h * HD + d2;
          const float q1 = src[0], q2 = src[64];
          qs[row * 128 + d2] = (q1 * cs - q2 * sn) * ATT_SCALE; qs[row * 128 + 64 + d2] = (q2 * cs + q1 * sn) * ATT_SCALE;
          if (c == 0 || c == 3) { const float k1 = src[D_ATTN], k2 = src[D_ATTN + 64], v1 = src[2 * D_ATTN], v2 = src[2 * D_ATTN + 64]; const float kr1 = k1 * cs - k2 * sn, kr2 = k2 * cs + k1 * sn;
              if (c == 3) { float* o = snew + (((size_t)bh * T_S + row) * 2) * HD + d2; o[0] = kr1; o[64] = kr2; o[HD] = v1; o[HD + 64] = v2; }
              else { const size_t o = (((size_t)li * NB_S + b) * T_S + row) * D_ATTN + h * HD + d2; F.out[O_NKS + o] = kr1; F.out[O_NKS + o + 64] = kr2; F.out[O_NVS + o] = v1; F.out[O_NVS + o + 64] = v2; } } }
        VM_WAIT(); __syncthreads();
        const int a0 = c * SA_CH + SA_WR * F.wave, a1 = (a0 + SA_WR < (c + 1) * SA_CH) ? a0 + SA_WR : (c + 1) * SA_CH, nrows = a1 > a0 ? a1 - a0 : 0;
        bf16x8 qf[4];
#pragma unroll
        for (int ks = 0; ks < 4; ++ks) { u32x4 w = {0u, 0u, 0u, 0u};
            if (fr < 8) { const f32x4 x0 = *(const LAS f32x4*)(qs + fr * 128 + 32 * ks + 8 * fq), x1 = *(const LAS f32x4*)(qs + fr * 128 + 32 * ks + 8 * fq + 4); w.x = pk2(x0[0], x0[1]); w.y = pk2(x0[2], x0[3]); w.z = pk2(x1[0], x1[1]); w.w = pk2(x1[2], x1[3]); }
            qf[ks] = __builtin_bit_cast(bf16x8, w); }
        const float* kbase = stk + ((size_t)b * WBUF * NH + h) * HD; const float* vbase = stv + ((size_t)b * WBUF * NH + h) * HD;
        const float* nbase = snew + (size_t)bh * T_S * 2 * HD;
#pragma unroll
        for (int i = 0; i < 3; ++i) {
            const int slot = 16 * i + fr; const bool valid = slot < nrows; const int r = sa_row(valid ? a0 + slot : a0);
            const float* kp = (r < WBUF ? kbase + (size_t)r * D_ATTN : nbase + (size_t)(r - WBUF) * 2 * HD) + 8 * fq;
            f32x4 acc = {0.f, 0.f, 0.f, 0.f};
#pragma unroll
            for (int ks = 0; ks < 4; ++ks) { const f32x4 k0 = *(const f32x4*)(kp + 32 * ks), k1 = *(const f32x4*)(kp + 32 * ks + 4);
                u32x4 w; w.x = pk2(k0[0], k0[1]); w.y = pk2(k0[2], k0[3]); w.z = pk2(k1[0], k1[1]); w.w = pk2(k1[2], k1[3]);
                acc = __builtin_amdgcn_mfma_f32_16x16x32_bf16(qf[ks], __builtin_bit_cast(bf16x8, w), acc, 0, 0, 0); }
            if (fq < 2) {
#pragma unroll
                for (int rg = 0; rg < 4; ++rg) { const int q = 4 * fq + rg, dl = WBUF + q - r;
                    const int mult = (dl >= 0 && dl <= 128 ? 1 : 0) + (dl >= 0 && (dl & 3) == 0 && dl <= 512 ? 1 : 0) + (dl >= 0 && (dl & 15) == 0 && dl <= 2048 ? 1 : 0);
                    Pt[slot * 8 + q] = (valid && mult > 0) ? acc[rg] + (mult == 1 ? 0.f : mult == 2 ? 0.6931471806f : 1.0986122887f) : -1e30f; } }
        }
        LDS_WAIT();
        { const int q = F.lane & 7, part = F.lane >> 3; float mx = -1e30f;
#pragma unroll
          for (int e = 0; e < 6; ++e) mx = fmaxf(mx, Pt[(part * 6 + e) * 8 + q]);
          mx = fmaxf(mx, __shfl_xor(mx, 8)); mx = fmaxf(mx, __shfl_xor(mx, 16)); mx = fmaxf(mx, __shfl_xor(mx, 32));
          float ls = 0.f;
#pragma unroll
          for (int e = 0; e < 6; ++e) { const float sp = Pt[(part * 6 + e) * 8 + q]; const float pv = sp <= -1e29f ? 0.f : __expf(sp - mx); Pt[(part * 6 + e) * 8 + q] = pv; ls += pv; }
          ls += __shfl_xor(ls, 8); ls += __shfl_xor(ls, 16); ls += __shfl_xor(ls, 32);
          if (part == 0) { st[(F.wave * 8 + q) * 2] = mx; st[(F.wave * 8 + q) * 2 + 1] = ls; } }
        LDS_WAIT();
        float o[8][2];
#pragma unroll
        for (int q = 0; q < 8; ++q) { o[q][0] = 0.f; o[q][1] = 0.f; }
        for (int s0 = 0; s0 < nrows; s0 += 8) {
            float vx[8], vy[8];
#pragma unroll
            for (int e = 0; e < 8; ++e) { const int s = s0 + e < nrows ? s0 + e : nrows - 1; const int r = sa_row(a0 + s);
                const float* vp = (r < WBUF ? vbase + (size_t)r * D_ATTN : nbase + (size_t)(r - WBUF) * 2 * HD + HD) + 2 * F.lane; vx[e] = vp[0]; vy[e] = vp[1]; }
#pragma unroll
            for (int e = 0; e < 8; ++e) { if (s0 + e < nrows) { const f32x4 p0 = *(const LAS f32x4*)(Pt + (s0 + e) * 8), p1 = *(const LAS f32x4*)(Pt + (s0 + e) * 8 + 4);
#pragma unroll
                for (int q = 0; q < 4; ++q) { o[q][0] += p0[q] * vx[e]; o[q][1] += p0[q] * vy[e]; o[4 + q][0] += p1[q] * vx[e]; o[4 + q][1] += p1[q] * vy[e]; } } }
        }
#pragma unroll
        for (int q = 0; q < 8; ++q) { mg[(F.wave * 8 + q) * 128 + 2 * F.lane] = o[q][0]; mg[(F.wave * 8 + q) * 128 + 2 * F.lane + 1] = o[q][1]; }
        __syncthreads();
        { const int q = F.wave; float M = -1e30f;
#pragma unroll
          for (int i = 0; i < 8; ++i) M = fmaxf(M, st[(i * 8 + q) * 2]);
          float L = 0.f, x0 = 0.f, x1 = 0.f;
#pragma unroll
          for (int i = 0; i < 8; ++i) { const float mi = st[(i * 8 + q) * 2]; const float w = mi <= -1e29f ? 0.f : __expf(mi - M); L += w * st[(i * 8 + q) * 2 + 1]; x0 += w * mg[(i * 8 + q) * 128 + 2 * F.lane]; x1 += w * mg[(i * 8 + q) * 128 + 2 * F.lane + 1]; }
          const size_t pi = (((size_t)(b * T_S + q) * NH + h) * 4 + c);
          float* op = sop + pi * HD + 2 * F.lane; op[0] = x0; op[1] = x1;
          if (F.lane == 0) { sml[pi * 2] = M; sml[pi * 2 + 1] = L; } }
    }
    __syncthreads();
}
__device__ __forceinline__ void scmb_phase(Frame& F, const Args& args, int li) {
    const float* sraw = (const float*)(F.ws + WS_SRAW); bf16_t* smg = (bf16_t*)(F.ws + WS_SMG);
    const float* sop = (const float*)(F.ws + WS_SOP); const float* sml = (const float*)(F.ws + WS_SML);
    const int gw = F.vcu * NWAVES + F.wave;
    if (gw < MS * NH) { const int m = gw >> 3, h = gw & 7; float mm[4], ll[4];
#pragma unroll
        for (int p = 0; p < 4; ++p) { const float* q = sml + (((size_t)m * NH + h) * 4 + p) * 2; mm[p] = q[0]; ll[p] = q[1]; }
        const float M = fmaxf(fmaxf(mm[0], mm[1]), fmaxf(mm[2], mm[3])); float o0 = 0.f, o1 = 0.f, den = 0.f;
#pragma unroll
        for (int p = 0; p < 4; ++p) { const float w = mm[p] <= -1e29f ? 0.f : __expf(mm[p] - M); den += w * ll[p]; const float* op = sop + (((size_t)m * NH + h) * 4 + p) * HD + 2 * F.lane; o0 += w * op[0]; o1 += w * op[1]; }
        const float inv = 1.f / den; const float* ga = sraw + (size_t)m * SRAW_LD + 3 * D_ATTN + h * HD + 2 * F.lane;
        *(GAS unsigned*)(smg + (size_t)m * DM + h * HD + 2 * F.lane) = pk2(o0 * inv * silu_f(ga[0]), o1 * inv * silu_f(ga[1])); }
    const float* stp = args.in[6] + (size_t)li * NB_S * 15 * D_POOL; const float* pw = args.in[13] + (size_t)li * 4 * PG * PG; const float* psc = args.in[14] + (size_t)li * D_POOL;
    LAS float* pooled = (LAS float*)F.lds;
    for (int m = F.vcu; m < MS; m += F.G) {
        const int b = m >> 3, t = m & 7;
        __syncthreads();
#pragma unroll
        for (int i = 0; i < 2; ++i) { const int c = F.tid + 512 * i, w = 2 << (c >> 8); float s = 0.f;
            for (int j = 0; j < w; ++j) { const int tt = t - j; s += tt >= 0 ? sraw[(size_t)(b * T_S + tt) * SRAW_LD + 4 * D_ATTN + c] : stp[((size_t)b * 15 + 15 + tt) * D_POOL + c]; }
            pooled[c] = s / (float)w - sraw[(size_t)m * SRAW_LD + 4 * D_ATTN + c]; }
        __syncthreads();
#pragma unroll
        for (int i = 0; i < 2; ++i) { const int d = F.tid + 512 * i, gi = d >> 8, dc = d & 255; const float* wp = pw + (size_t)gi * PG * PG + dc; float s = 0.f;
#pragma unroll 8
            for (int c = 0; c < PG; ++c) s += pooled[gi * PG + c] * wp[(size_t)c * PG];
            const float gp = sraw[(size_t)m * SRAW_LD + 4 * D_ATTN + D_POOL + d];
            smg[(size_t)m * DM + D_ATTN + d] = (bf16_t)f2bf(s * psc[d] * silu_f(gp)); }
        if (t == 0) { float* np = F.out + O_NPOOLS + ((size_t)li * NB_S + b) * 15 * D_POOL;
            for (int i = F.tid; i < 15 * D_POOL; i += NWAVES * 64) { const int r = i >> 10, c = i & 1023;
                np[i] = r < 7 ? stp[((size_t)b * 15 + 8 + r) * D_POOL + c] : sraw[(size_t)(b * T_S + r - 7) * SRAW_LD + 4 * D_ATTN + c]; } }
    }
    __syncthreads();
}
__device__ __forceinline__ void scnv_phase(Frame& F, const Args& args, int li) {
    const float* sraw = (const float*)(F.ws + WS_SRAW); bf16_t* smg = (bf16_t*)(F.ws + WS_SMG);
    const float* stc = args.in[7] + (size_t)li * NB_S * 2 * D_CONV; const float* cw = args.in[16] + (size_t)li * 3 * D_CONV;
    for (int m = F.vcu; m < MS; m += F.G) {
        const int b = m >> 3, t = m & 7, c = 4 * F.tid;
        f32x4 y = {0.f, 0.f, 0.f, 0.f}, zt = {0.f, 0.f, 0.f, 0.f};
#pragma unroll
        for (int kk = 0; kk < 3; ++kk) { const int tt = t - 2 + kk; f32x4 z;
            if (tt >= 0) { const float* p = sraw + (size_t)(b * T_S + tt) * SRAW_LD; z = *(const f32x4*)(p + D_CONV + c) * *(const f32x4*)(p + 2 * D_CONV + c); }
            else z = *(const f32x4*)(stc + ((size_t)b * 2 + 2 + tt) * D_CONV + c);
            y += z * *(const f32x4*)(cw + kk * D_CONV + c); zt = z; }
        const float* p = sraw + (size_t)m * SRAW_LD; const f32x4 bg = *(const f32x4*)(p + c), g = *(const f32x4*)(p + 3 * D_CONV + c);
        u32x2 o; o.x = pk2(bg[0] * y[0] * silu_f(g[0]), bg[1] * y[1] * silu_f(g[1])); o.y = pk2(bg[2] * y[2] * silu_f(g[2]), bg[3] * y[3] * silu_f(g[3]));
        *(GAS u32x2*)(smg + (size_t)m * DM + c) = o;
        if (t >= T_S - 2) *(f32x4*)(F.out + O_NCONVS + (((size_t)li * NB_S + b) * 2 + (t - (T_S - 2))) * D_CONV + c) = zt;
    }
}
__device__ __forceinline__ void sfin_phase(Frame& F, const Args& args) {
    const int gw = F.vcu * NWAVES + F.wave;
    if (gw < MS) { const float* pss = (const float*)(F.ws + WS_PSS_S); float s = pss[gw * NPS + F.lane]; s = wave_sum(s);
        const float rstd = rsqrtf(s * (1.0f / DM) + EPS); float* y = F.out + O_YS + (size_t)gw * DM; const float* fg = args.in[18];
#pragma unroll
        for (int i = 0; i < 8; ++i) { const int c = 4 * (F.lane + 64 * i); f32x4 x = *(const f32x4*)(y + c); x = x * rstd * *(const f32x4*)(fg + c); *(f32x4*)(y + c) = x; } }
}
constexpr int PH_FIN = 2 + 4 * DEPTH, PH_END = PH_FIN + 1;
#define REP(id) for (int rep_ = 0; rep_ < ((EXP_PH == (id)) ? 2 : 1); ++rep_)
__global__ void __launch_bounds__(NWAVES * 64, 2) mk_fwd(Args args) {
    extern __shared__ __attribute__((aligned(16))) unsigned char lds[];
    Frame F0;
    F0.lds = (LAS unsigned char*)lds; F0.ldsg = nullptr;
    F0.wave = __builtin_amdgcn_readfirstlane((int)threadIdx.x >> 6); F0.lane = lane_id(); F0.tid = F0.wave * 64 + F0.lane;
    F0.G = gridDim.x; { const int bx = blockIdx.x; F0.vcu = (F0.G % 8 == 0) ? (bx % 8) * (F0.G / 8) + bx / 8 : bx; }
    F0.out = args.out; F0.ws = args.ws;
    volatile LAS unsigned* MISC = (volatile LAS unsigned*)(F0.lds + MISC_OFF);
    for (int u = F0.tid; u < (LDS_BYTES - LDSCTL_OFF) / 4; u += NWAVES * 64) ((LAS unsigned*)(F0.lds + LDSCTL_OFF))[u] = 0u;
    __syncthreads();
    unsigned* ctl = (unsigned*)(F0.ws + WS_CTL);
    XcdBarrier bar = xcd_barrier_post(ctl + CW_BAR + args.li * XCD_BAR_WORDS, MISC + 8, F0.wave);
    const int lo = args.ph_lo, hi = args.ph_hi;
#define IN(k) (lo <= (k) && (k) < hi)
#define SEAM(k) do { if (IN(k) && (k) + 1 < hi) { xcd_barrier(bar); if (EXP_PH == 10) xcd_barrier(bar); } } while (0)
    if (IN(0)) REP(0) { Frame F = fresh(F0); p0_phase(F, args); } SEAM(0);
    if (IN(1)) REP(1) { Frame F = fresh(F0); p1_phase(F, args); } SEAM(1);
#pragma unroll 1
    for (int l = 0; l < DEPTH; ++l) {
        const int pb = 2 + 4 * l, li = l >> 1;
        if ((l & 1) == 0) {
            if (IN(pb)) REP(2) { Frame F = fresh(F0);
                pg8::Gemm g{(const bf16_t*)(F.ws + WS_A), (const bf16_t*)(F.ws + WS_WIE) + (size_t)li * N_EVEN_IN * DM, MP, N_EVEN_IN, DM};
                pg8::StaticOrder S; S.init(MP, N_EVEN_IN, F.G, (int)blockIdx.x);
                const float* rope_c = (const float*)(F.ws + WS_ROPE);
                pg8::EpiG1E E{(const float*)(F.ws + WS_PARTSS), (const float*)(F.ws + WS_SHW) + (size_t)l * NSEQ * SHW_LD, rope_c, rope_c + (size_t)ROPE_ROWS * 64, (bf16_t*)(F.ws + WS_QR),
                              F.out + O_NKP + (size_t)li * NB_P * 2048 * D_ATTN, F.out + O_NVP + (size_t)li * NB_P * 2048 * D_ATTN, F.out + O_NPOOLP + (size_t)li * NB_P * 15 * D_POOL};
                pg8::gemm_phase<pg8::EpiG1E, pg8::StaticOrder, true, true>(F.lds, g, S, E, F.tid);
                { LAS float* rs = sample_rstd_table(F); EpiSRaw<WK_IE> ES{(const float*)(F.ws + WS_SHW) + (size_t)l * NSEQ * SHW_LD, rs, (float*)(F.ws + WS_SRAW)};
                  skinny_gemm<WK_IE>(F, (const bf16_t*)(F.ws + WS_AS), g.Bt, N_EVEN_IN, ES); }
            } SEAM(pb);
            if (IN(pb + 1)) REP(3) { Frame F = fresh(F0); att_phase(F); } if (IN(pb + 1)) REP(4) { Frame F = fresh(F0); satt_phase(F, args, li); } SEAM(pb + 1);
            if (IN(pb + 2)) REP(5) { Frame F = fresh(F0); cmb_phase(F, args, li); } if (IN(pb + 2)) REP(6) { Frame F = fresh(F0); scmb_phase(F, args, li); } SEAM(pb + 2);
        } else {
            if (IN(pb)) REP(8) { Frame F = fresh(F0);
                pg8::Gemm g{(const bf16_t*)(F.ws + WS_A), (const bf16_t*)(F.ws + WS_WIO) + (size_t)li * N_ODD_IN * DM, MP, N_ODD_IN, DM};
                pg8::StaticOrder S; S.init(MP, N_ODD_IN, F.G, (int)blockIdx.x);
                pg8::EpiG1O E{(const float*)(F.ws + WS_PARTSS), (const float*)(F.ws + WS_SHW) + (size_t)l * NSEQ * SHW_LD, (bf16_t*)(F.ws + WS_UO), (bf16_t*)(F.ws + WS_ZO), F.out + O_NCONVP + (size_t)li * NB_P * 2 * D_CONV};
                pg8::gemm_phase<pg8::EpiG1O, pg8::StaticOrder, true, true>(F.lds, g, S, E, F.tid);
                { LAS float* rs = sample_rstd_table(F); EpiSRaw<WK_IO> ES{(const float*)(F.ws + WS_SHW) + (size_t)l * NSEQ * SHW_LD, rs, (float*)(F.ws + WS_SRAW)};
                  skinny_gemm<WK_IO>(F, (const bf16_t*)(F.ws + WS_AS), g.Bt, N_ODD_IN, ES); }
            } SEAM(pb);
            if (IN(pb + 1)) REP(9) { Frame F = fresh(F0); cnv_phase(F, args, li); } if (IN(pb + 1)) { Frame F = fresh(F0); scnv_phase(F, args, li); } SEAM(pb + 1);
        }
        if (IN(pb + 3)) for (int rep_ = 0; rep_ < ((EXP_PH == 7 && l == 0) ? 2 : 1); ++rep_) { Frame F = fresh(F0);
            const bf16_t* wt = (const bf16_t*)(F.ws + ((l & 1) ? WS_WOO : WS_WOE)) + (size_t)li * DM * DM;
            pg8::Gemm g{(const bf16_t*)(F.ws + WS_MERGED), wt, MP, DM, DM};
            pg8::StaticOrder S; S.init(MP, DM, F.G, (int)blockIdx.x);
            const bool last = (l == DEPTH - 1); const float* mod = (const float*)(F.ws + WS_MOD);
            pg8::EpiG2 E{l == 0 ? args.in[0] : F.out + O_YP, F.out + O_YP, last ? nullptr : (bf16_t*)(F.ws + WS_A), mod + (size_t)l * NSEQ * MODW,
                         mod + (size_t)(last ? l : l + 1) * NSEQ * MODW, args.in[10] + (size_t)(last ? l : l + 1) * DM, (float*)(F.ws + WS_PARTSS)};
            pg8::gemm_phase<pg8::EpiG2, pg8::StaticOrder, false, true>(F.lds, g, S, E, F.tid);
            { EpiSG2 ES{l == 0 ? args.in[1] : F.out + O_YS, F.out + O_YS, last ? nullptr : (bf16_t*)(F.ws + WS_AS), E.modl, E.modn, E.gn, (float*)(F.ws + WS_PSS_S)};
              __syncthreads(); skinny_gemm<WK_OE>(F, (const bf16_t*)(F.ws + WS_SMG), wt, DM, ES); }
        } SEAM(pb + 3);
    }
    if (IN(PH_FIN)) { Frame F = fresh(F0); fin_phase(F, args); sfin_phase(F, args); }
#undef IN
#undef SEAM
}
__global__ void k_siluc(const float* __restrict__ cp, const float* __restrict__ cs, float* __restrict__ sc) {
    const int i = blockIdx.x * blockDim.x + threadIdx.x;
    if (i < 10 * DM) { const int b = i / DM, k = i % DM; const float c = b < 2 ? cp[b * DM + k] : cs[(b - 2) * DM + k]; sc[i] = silu_f(c); }
}
__global__ void k_ada(const float* __restrict__ sc, const float* __restrict__ aw, const float* __restrict__ ab, float* __restrict__ mod) {
    const int j = blockIdx.x * blockDim.x + threadIdx.x;
    const int l = blockIdx.y;
    if (j >= 3 * DM) return;
    float acc[10];
#pragma unroll
    for (int b = 0; b < 10; ++b) acc[b] = 0.f;
    const float* w = aw + (size_t)l * DM * 3 * DM + j;
    for (int k = 0; k < DM; ++k) {
        const float wv = w[(size_t)k * 3 * DM];
#pragma unroll
        for (int b = 0; b < 10; ++b) {
            acc[b] += sc[b * DM + k] * wv;
        }
    }
#pragma unroll
    for (int b = 0; b < 10; ++b) mod[((size_t)l * 10 + b) * 3 * DM + j] = acc[b] + ab[l * 3 * DM + j];
}

__global__ void k_norm(const float* __restrict__ x, const float* __restrict__ g, const float* __restrict__ modp  , int T, float* __restrict__ h) {
    const int row = blockIdx.x, b = row / T;
    __shared__ float red[256];
    float s = 0.f;
    for (int c = threadIdx.x; c < DM; c += 256) { const float v = x[(size_t)row * DM + c]; s += v * v; }
    red[threadIdx.x] = s; __syncthreads();
    for (int o = 128; o > 0; o >>= 1) { if (threadIdx.x < o) red[threadIdx.x] += red[threadIdx.x + o]; __syncthreads(); }
    const float rstd = rsqrtf(red[0] / DM + EPS);
    for (int c = threadIdx.x; c < DM; c += 256) {
        float v = x[(size_t)row * DM + c] * rstd * g[c];
        if (modp) { const float sh = modp[(size_t)b * 3 * DM + c], sc = modp[(size_t)b * 3 * DM + DM + c]; v = v * (1.f + sc) + sh; }
        h[(size_t)row * DM + c] = v;
    }
}

__global__ void __launch_bounds__(256) k_gemm(const float* __restrict__ A, int lda, const float* __restrict__ W, int ldw, float* __restrict__ C, int ldc, int K) {
    __shared__ float As[16][64 + 4], Ws[16][64 + 4];
    const int tx = threadIdx.x & 15, ty = threadIdx.x >> 4;
    const int m0 = blockIdx.y * 64, n0 = blockIdx.x * 64;
    float acc[4][4] = {};
    for (int k0 = 0; k0 < K; k0 += 16) {
        for (int i = threadIdx.x; i < 64 * 16; i += 256) { const int r = i >> 4, kk = i & 15; As[kk][r] = A[(size_t)(m0 + r) * lda + k0 + kk]; }
        for (int i = threadIdx.x; i < 16 * 64; i += 256) { const int kk = i >> 6, c = i & 63; Ws[kk][c] = W[(size_t)(k0 + kk) * ldw + n0 + c]; }
        __syncthreads();
#pragma unroll
        for (int kk = 0; kk < 16; ++kk) {
            float a[4], w[4];
#pragma unroll
            for (int i = 0; i < 4; ++i) { a[i] = As[kk][ty * 4 + i]; w[i] = Ws[kk][tx * 4 + i]; }
#pragma unroll
            for (int i = 0; i < 4; ++i)
#pragma unroll
                for (int j = 0; j < 4; ++j) acc[i][j] += a[i] * w[j];
        }
        __syncthreads();
    }
#pragma unroll
    for (int i = 0; i < 4; ++i)
#pragma unroll
        for (int j = 0; j < 4; ++j) C[(size_t)(m0 + ty * 4 + i) * ldc + n0 + tx * 4 + j] = acc[i][j];
}

__global__ void k_rotary(float* __restrict__ proj, int T, int pos0) {
    const int row = blockIdx.x, t = row % T;
    const float pos = (float)(pos0 + t);
    for (int i = threadIdx.x; i < 2 * NH * 64; i += blockDim.x) {
        const int which = i / (NH * 64), r = i % (NH * 64), hh = r / 64, dd = r % 64;
        const float inv = powf(10000.f, -(float)dd / 64.f);
        const float ang = pos * inv, c = cosf(ang), s = sinf(ang);
        float* p = proj + (size_t)row * N_EVEN_IN + which * D_ATTN + hh * HD;
        const float x1 = p[dd], x2 = p[dd + 64];
        p[dd] = x1 * c - x2 * s; p[dd + 64] = x2 * c + x1 * s;
    }
}

__global__ void __launch_bounds__(64) k_attn(const float* __restrict__ proj, const float* __restrict__ stk, const float* __restrict__ stv, int T, int npre, float* __restrict__ attn) {
    const int row = blockIdx.x, h = blockIdx.y, b = row / T, t = row % T, lane = threadIdx.x;
    __shared__ float qs[HD];
    __shared__ float ps[3 * 129];
    __shared__ int pidx[3 * 129];
    const float scale = 0.08838834764831845f;
    for (int d = lane; d < HD; d += 64) qs[d] = proj[(size_t)row * N_EVEN_IN + h * HD + d] * scale;
    __syncthreads();
    const int e = npre + t;
    const int dil[3] = {1, 4, 16};
    float mymax = -1e30f;
    for (int i = lane; i < 3 * 129; i += 64) {
        const int p = i / 129, j = i % 129;
        const int idx = e - j * dil[p];
        float s = -1e30f;
        if (idx >= 0) {
            const float* kr = idx < npre ? stk + (((size_t)b * npre + idx) * NH + h) * HD : proj + (size_t)(b * T + idx - npre) * N_EVEN_IN + D_ATTN + h * HD;
            float a = 0.f;
            for (int d = 0; d < HD; ++d) a += qs[d] * kr[d];
            s = a;
        }
        ps[i] = s; pidx[i] = idx;
        mymax = fmaxf(mymax, s);
    }
    for (int o = 32; o > 0; o >>= 1) mymax = fmaxf(mymax, __shfl_xor(mymax, o));
    __syncthreads();
    float mysum = 0.f;
    for (int i = lane; i < 3 * 129; i += 64) { const float pv = pidx[i] >= 0 ? expf(ps[i] - mymax) : 0.f; ps[i] = pv; mysum += pv; }
    for (int o = 32; o > 0; o >>= 1) mysum += __shfl_xor(mysum, o);
    __syncthreads();
    float o0 = 0.f, o1 = 0.f;
    for (int i = 0; i < 3 * 129; ++i) {
        const int idx = pidx[i];
        if (idx < 0) continue;
        const float* vr = idx < npre ? stv + (((size_t)b * npre + idx) * NH + h) * HD : proj + (size_t)(b * T + idx - npre) * N_EVEN_IN + 2 * D_ATTN + h * HD;
        const float pv = ps[i];
        o0 += pv * vr[lane]; o1 += pv * vr[lane + 64];
    }
    attn[(size_t)row * D_ATTN + h * HD + lane] = o0 / mysum;
    attn[(size_t)row * D_ATTN + h * HD + lane + 64] = o1 / mysum;
}

__global__ void k_pooled(const float* __restrict__ proj, const float* __restrict__ prefix, int T, int pos0, float* __restrict__ pooled) {
    const int row = blockIdx.x, b = row / T, t = row % T;
    for (int c = threadIdx.x; c < D_POOL; c += blockDim.x) {
        const int gi = c / PG, w = 2 << gi;
        float s = 0.f;
        for (int j = 0; j < w; ++j) {
            const int tt = t - j;
            float v;
            if (tt >= 0) v = proj[(size_t)(b * T + tt) * N_EVEN_IN + 4 * D_ATTN + c];
            else v = prefix ? prefix[((size_t)b * 15 + (15 + tt)) * D_POOL + c] : 0.f;
            s += v;
        }
        const int pos = pos0 + t;
        const float cnt = (float)(w < pos + 1 ? w : pos + 1);
        pooled[(size_t)row * D_POOL + c] = s / cnt - proj[(size_t)row * N_EVEN_IN + 4 * D_ATTN + c];
    }
}

__global__ void k_merge(const float* __restrict__ proj, const float* __restrict__ attn, const float* __restrict__ mixed, const float* __restrict__ pscale, float* __restrict__ merged, int presilu) {
    const int row = blockIdx.x;
    for (int c = threadIdx.x; c < D_ATTN; c += blockDim.x) {
        { const float ga = proj[(size_t)row * N_EVEN_IN + 3 * D_ATTN + c]; merged[(size_t)row * DM + c] = attn[(size_t)row * D_ATTN + c] * (presilu ? ga : silu_f(ga)); }
        { const float gp = proj[(size_t)row * N_EVEN_IN + 4 * D_ATTN + D_POOL + c]; merged[(size_t)row * DM + D_ATTN + c] = mixed[(size_t)row * D_POOL + c] * pscale[c] * (presilu ? gp : silu_f(gp)); }
    }
}

__global__ void k_resid(float* __restrict__ x, const float* __restrict__ mix, const float* __restrict__ modp, int T) {
    const int row = blockIdx.x, b = row / T;
    for (int c = threadIdx.x; c < DM; c += blockDim.x) x[(size_t)row * DM + c] += modp[(size_t)b * 3 * DM + 2 * DM + c] * mix[(size_t)row * DM + c];
}

__global__ void k_convgate(const float* __restrict__ proj, const float* __restrict__ prefix, const float* __restrict__ cw, int T, float* __restrict__ v, float* __restrict__ newconv) {
    const int row = blockIdx.x, b = row / T, t = row % T;
    for (int c = threadIdx.x; c < D_CONV; c += blockDim.x) {
        float y = 0.f;
        for (int kk = 0; kk < 3; ++kk) {
            const int tt = t - 2 + kk;
            float z;
            if (tt >= 0) { const float* p = proj + (size_t)(b * T + tt) * N_ODD_IN; z = p[D_CONV + c] * p[2 * D_CONV + c]; }
            else z = prefix ? prefix[((size_t)b * 2 + (2 + tt)) * D_CONV + c] : 0.f;
            y += z * cw[kk * D_CONV + c];
        }
        const float* p = proj + (size_t)row * N_ODD_IN;
        v[(size_t)row * DM + c] = p[c] * y * silu_f(p[3 * D_CONV + c]);
        if (t >= T - 2) newconv[((size_t)b * 2 + (t - (T - 2))) * D_CONV + c] = p[D_CONV + c] * p[2 * D_CONV + c];
    }
}

__global__ void k_copykv(const float* __restrict__ proj, int T, int keep, float* __restrict__ ok, float* __restrict__ ov) {
    const int row = blockIdx.x, b = row / T, t = row % T;
    if (t < T - keep) return;
    for (int c = threadIdx.x; c < D_ATTN; c += blockDim.x) {
        ok[((size_t)b * keep + t - (T - keep)) * D_ATTN + c] = proj[(size_t)row * N_EVEN_IN + D_ATTN + c];
        ov[((size_t)b * keep + t - (T - keep)) * D_ATTN + c] = proj[(size_t)row * N_EVEN_IN + 2 * D_ATTN + c];
    }
}
__global__ void k_newpool(const float* __restrict__ proj, const float* __restrict__ prefix, int T, float* __restrict__ out) {
    const int b = blockIdx.x / 15, i = blockIdx.x % 15;
    const int e = T + i;
    for (int c = threadIdx.x; c < D_POOL; c += blockDim.x) {
        float v;
        if (e < 15) v = prefix ? prefix[((size_t)b * 15 + e) * D_POOL + c] : 0.f;
        else v = proj[(size_t)(b * T + e - 15) * N_EVEN_IN + 4 * D_ATTN + c];
        out[((size_t)b * 15 + i) * D_POOL + c] = v;
    }
}


__global__ void k_adapt_g1e(const bf16_t* __restrict__ QR, const bf16_t* __restrict__ KR, const bf16_t* __restrict__ VB, const bf16_t* __restrict__ GA, const bf16_t* __restrict__ UB, const bf16_t* __restrict__ GP, float* __restrict__ proj) {
    const int row = blockIdx.x;
    for (int c = threadIdx.x; c < D_ATTN; c += blockDim.x) {
        float* p = proj + (size_t)row * N_EVEN_IN; const size_t o = (size_t)row * D_ATTN + c;
        p[c] = bf2f(QR[o]); p[D_ATTN + c] = bf2f(KR[o]); p[2 * D_ATTN + c] = bf2f(VB[o]); p[3 * D_ATTN + c] = bf2f(GA[o]); p[4 * D_ATTN + c] = bf2f(UB[o]); p[5 * D_ATTN + c] = bf2f(GP[o]);
    }
}
__global__ void k_bf2f(const bf16_t* __restrict__ src, float* __restrict__ dst, size_t n) {
    for (size_t i = (size_t)blockIdx.x * blockDim.x + threadIdx.x; i < n; i += (size_t)gridDim.x * blockDim.x) dst[i] = bf2f(src[i]);
}
#ifndef MK_UPTO
#define MK_UPTO 19
#endif
struct NaiveBufs { float *xb, *hb, *proj, *attn, *pooled, *mixed, *merged, *mix, *scb, *mod; };
struct Trunk {
    int B, T, pos0, npre; const float* x_in; const float* st_k; const float* st_v; const float* st_pool; const float* st_conv; int bmod0;
    float *y, *nk, *nv, *npool, *nconv; size_t nk_l, npool_l, nconv_l; int keep;
};
static void naive_run(const Trunk& R, const NaiveBufs& N, void* const* d_in, int l0, int s0, bool final_norm, hipStream_t stream) {
    const float* norm_g = (const float*)d_in[10]; const float* w_in_even = (const float*)d_in[11]; const float* w_out_even = (const float*)d_in[12];
    const float* pool_w = (const float*)d_in[13]; const float* pool_scale = (const float*)d_in[14];
    const float* w_in_odd = (const float*)d_in[15]; const float* conv_w = (const float*)d_in[16]; const float* w_out_odd = (const float*)d_in[17]; const float* final_g = (const float*)d_in[18];
    const int M = R.B * R.T;
    for (int l = l0; l < DEPTH; ++l) {
        const int li = l / 2, s = (l == l0) ? s0 : 0;
        const float* modp = N.mod + ((size_t)l * 10 + R.bmod0) * 3 * DM;
        if (s == 0) k_norm<<<M, 256, 0, stream>>>(N.xb, norm_g + l * DM, modp, R.T, N.hb);
        if (l % 2 == 0) {
            if (s == 0) {
                k_gemm<<<dim3(N_EVEN_IN / 64, M / 64), 256, 0, stream>>>(N.hb, DM, w_in_even + (size_t)li * DM * N_EVEN_IN, N_EVEN_IN, N.proj, N_EVEN_IN, DM);
                k_rotary<<<M, 256, 0, stream>>>(N.proj, R.T, R.pos0);
                k_copykv<<<M, 256, 0, stream>>>(N.proj, R.T, R.keep, R.nk + li * R.nk_l, R.nv + li * R.nk_l);
            }
            if (s <= 1) {
                const float* sk = R.st_k ? R.st_k + (size_t)li * NB_S * WBUF * D_ATTN : nullptr;
                const float* sv = R.st_v ? R.st_v + (size_t)li * NB_S * WBUF * D_ATTN : nullptr;
                k_attn<<<dim3(M, NH), 64, 0, stream>>>(N.proj, sk, sv, R.T, R.npre, N.attn);
                const float* pp = R.st_pool ? R.st_pool + (size_t)li * NB_S * 15 * D_POOL : nullptr;
                k_pooled<<<M, 256, 0, stream>>>(N.proj, pp, R.T, R.pos0, N.pooled);
                if (s == 0) k_newpool<<<R.B * 15, 256, 0, stream>>>(N.proj, pp, R.T, R.npool + li * R.npool_l);
                for (int gi = 0; gi < 4; ++gi)
                    k_gemm<<<dim3(PG / 64, M / 64), 256, 0, stream>>>(N.pooled + gi * PG, D_POOL, pool_w + ((size_t)li * 4 + gi) * PG * PG, PG, N.mixed + gi * PG, D_POOL, PG);
                k_merge<<<M, 256, 0, stream>>>(N.proj, N.attn, N.mixed, pool_scale + li * D_POOL, N.merged, s == 1 ? 1 : 0);
            }
            k_gemm<<<dim3(DM / 64, M / 64), 256, 0, stream>>>(N.merged, DM, w_out_even + (size_t)li * DM * DM, DM, N.mix, DM, DM);
        } else {
            if (s == 0) {
                k_gemm<<<dim3(N_ODD_IN / 64, M / 64), 256, 0, stream>>>(N.hb, DM, w_in_odd + (size_t)li * DM * N_ODD_IN, N_ODD_IN, N.proj, N_ODD_IN, DM);
                const float* cp = R.st_conv ? R.st_conv + (size_t)li * NB_S * 2 * D_CONV : nullptr;
                k_convgate<<<M, 256, 0, stream>>>(N.proj, cp, conv_w + (size_t)li * 3 * D_CONV, R.T, N.merged, R.nconv + li * R.nconv_l);
            }
            k_gemm<<<dim3(DM / 64, M / 64), 256, 0, stream>>>(N.merged, DM, w_out_odd + (size_t)li * DM * DM, DM, N.mix, DM, DM);
        }
        k_resid<<<M, 256, 0, stream>>>(N.xb, N.mix, modp, R.T);
    }
    if (final_norm) k_norm<<<M, 256, 0, stream>>>(N.xb, final_g, nullptr, R.T, R.y);
}

extern "C" void kernel_launch(void* const* d_in, const int* in_sizes, int n_in, void* d_out, int out_size, void* d_ws, size_t ws_size, hipStream_t stream) {
    static int grid = 0;
    if (grid == 0) {
        int dev = 0, cus = 0, per_cu = 0;
        if (n_in != 19 || (size_t)out_size != O_END || ws_size < 700 * MiB) { fprintf(stderr, "kernel_launch: unexpected shapes (n_in %d out %d ws %zu)\n", n_in, out_size, ws_size); grid = -1; return; }
        if (hipGetDevice(&dev) != hipSuccess || hipDeviceGetAttribute(&cus, hipDeviceAttributeMultiprocessorCount, dev) != hipSuccess) { grid = -1; return; }
        if (hipFuncSetAttribute((const void*)mk_fwd, hipFuncAttributeMaxDynamicSharedMemorySize, LDS_BYTES) != hipSuccess) { fprintf(stderr, "kernel_launch: hipFuncSetAttribute failed\n"); grid = -1; return; }
        if (hipOccupancyMaxActiveBlocksPerMultiprocessor(&per_cu, (const void*)mk_fwd, NWAVES * 64, LDS_BYTES) != hipSuccess || per_cu < 1) { fprintf(stderr, "kernel_launch: occupancy query says %d blocks per CU\n", per_cu); }
        (void)hipGetLastError();
        grid = cus;
        if (grid != 256) fprintf(stderr, "kernel_launch: %d CUs (built for 256)\n", grid);
    }
    if (grid < 0) return;
    (void)hipMemsetAsync((char*)d_ws + WS_CTL, 0, CTL_ZERO_BYTES, stream);
    Args a{};
    for (int i = 0; i < 19; ++i) a.in[i] = (const float*)d_in[i];
    a.out = (float*)d_out; a.ws = (unsigned char*)d_ws;
    if (MK_UPTO == PH_END) { a.ph_lo = 0; a.ph_hi = PH_END; a.li = 0; hipLaunchKernelGGL(mk_fwd, dim3(grid), dim3(NWAVES * 64), LDS_BYTES, stream, a); }
    else { int li = 0;
      for (int ph = 0; ph < MK_UPTO; ++ph) {
          if (ph >= 2 && ph < PH_FIN) { const int l = (ph - 2) / 4, s = (ph - 2) % 4; if ((l & 1) && s == 2) continue; }
          a.ph_lo = ph; a.ph_hi = ph + 1; a.li = li++;
          hipLaunchKernelGGL(mk_fwd, dim3(grid), dim3(NWAVES * 64), LDS_BYTES, stream, a);
      } }
    float* out = (float*)d_out;
    float* nf = (float*)((char*)d_ws + WS_NAIVE); size_t w = 0;
    NaiveBufs N;
    const size_t MR = (size_t)T_P;
    N.xb = nf + w; w += MR * DM; N.hb = nf + w; N.mix = N.hb; w += MR * DM; N.proj = nf + w; w += MR * N_ODD_IN;
    N.attn = nf + w; w += MR * D_ATTN; N.pooled = nf + w; w += MR * D_POOL; N.mixed = nf + w; w += MR * D_POOL; N.merged = nf + w; w += MR * DM;
    N.scb = nf + w; w += (size_t)10 * DM;
    N.mod = (float*)((char*)d_ws + WS_MOD);
    if (MK_UPTO < 1) { k_siluc<<<10 * DM / 256, 256, 0, stream>>>((const float*)d_in[2], (const float*)d_in[3], N.scb); k_ada<<<dim3(3 * DM / 256, 4), 256, 0, stream>>>(N.scb, (const float*)d_in[8], (const float*)d_in[9], N.mod); }
    if (MK_UPTO < PH_END) {
        const int l0 = MK_UPTO < 2 ? 0 : (MK_UPTO - 2) / 4, s0 = MK_UPTO < 2 ? 0 : (MK_UPTO - 2) % 4;
        for (int b = 0; b < NB_P; ++b) {
            Trunk R{1, T_P, 0, 0, (const float*)d_in[0] + (size_t)b * T_P * DM, nullptr, nullptr, nullptr, nullptr, b,
                    out + O_YP + (size_t)b * T_P * DM, out + O_NKP + (size_t)b * 2048 * D_ATTN, out + O_NVP + (size_t)b * 2048 * D_ATTN, out + O_NPOOLP + (size_t)b * 15 * D_POOL, out + O_NCONVP + (size_t)b * 2 * D_CONV,
                    (size_t)NB_P * 2048 * D_ATTN, (size_t)NB_P * 15 * D_POOL, (size_t)NB_P * 2 * D_CONV, 2048};
            const float* xsrc = (l0 == 0) ? R.x_in : out + O_YP + (size_t)b * T_P * DM;
            (void)hipMemcpyAsync(N.xb, xsrc, (size_t)T_P * DM * sizeof(float), hipMemcpyDeviceToDevice, stream);
            const size_t ro = (size_t)b * T_P;
            if (l0 < DEPTH && (l0 % 2 == 0) && s0 == 1)
                k_adapt_g1e<<<T_P, 256, 0, stream>>>((const bf16_t*)((char*)d_ws + WS_QR) + ro * D_ATTN, (const bf16_t*)((char*)d_ws + WS_KR) + ro * D_ATTN, (const bf16_t*)((char*)d_ws + WS_VB) + ro * D_ATTN,
                                                      (const bf16_t*)((char*)d_ws + WS_GA) + ro * D_ATTN, (const bf16_t*)((char*)d_ws + WS_UB) + ro * D_ATTN, (const bf16_t*)((char*)d_ws + WS_GP) + ro * D_ATTN, N.proj);
            if (l0 < DEPTH && ((l0 % 2 == 0 && s0 == 3) || (l0 % 2 == 1 && s0 == 2)))
                k_bf2f<<<2048, 256, 0, stream>>>((const bf16_t*)((char*)d_ws + WS_MERGED) + ro * DM, N.merged, (size_t)T_P * DM);
            naive_run(R, N, d_in, l0, s0, true, stream);
        }
    }
    if (MK_UPTO < PH_END) {
        Trunk R{NB_S, T_S, PAST, WBUF, (const float*)d_in[1], (const float*)d_in[4], (const float*)d_in[5], (const float*)d_in[6], (const float*)d_in[7], 2,
                out + O_YS, out + O_NKS, out + O_NVS, out + O_NPOOLS, out + O_NCONVS, (size_t)NB_S * T_S * D_ATTN, (size_t)NB_S * 15 * D_POOL, (size_t)NB_S * 2 * D_CONV, T_S};
        (void)hipMemcpyAsync(N.xb, R.x_in, (size_t)MS * DM * sizeof(float), hipMemcpyDeviceToDevice, stream);
        naive_run(R, N, d_in, 0, 0, true, stream);
    }
}
```

```cpp
#include <hip/hip_runtime.h>
#include <hip/hip_bf16.h>
#include <cstdio>
#include <cstdint>
#include <cmath>

#ifndef EXP_PH
#define EXP_PH -1
#endif
constexpr int DM = 2048, NB_P = 2, T_P = 4096, NB_S = 8, T_S = 8, DEPTH = 4;
constexpr int D_ATTN = 1024, HD = 128, NH = 8, D_POOL = 1024, PG = 256, D_CONV = 2048;
constexpr int N_EVEN_IN = 6144, N_ODD_IN = 8192, WBUF = 2048, PAST = 16384;
constexpr int MP = NB_P * T_P;
constexpr int MS = NB_S * T_S;
constexpr float EPS = 1e-6f;
constexpr int NSEQ = NB_P + NB_S;
constexpr int MODW = 3 * DM;
constexpr int SHW_LD = 8192;
constexpr int ROPE_ROWS = T_P + T_S;
constexpr int NPART = 8;

constexpr size_t O_YP = 0;
constexpr size_t O_YS = O_YP + (size_t)MP * DM;
constexpr size_t O_NKP = O_YS + (size_t)MS * DM;
constexpr size_t O_NVP = O_NKP + (size_t)2 * NB_P * 2048 * D_ATTN;
constexpr size_t O_NPOOLP = O_NVP + (size_t)2 * NB_P * 2048 * D_ATTN;
constexpr size_t O_NCONVP = O_NPOOLP + (size_t)2 * NB_P * 15 * D_POOL;
constexpr size_t O_NKS = O_NCONVP + (size_t)2 * NB_P * 2 * D_CONV;
constexpr size_t O_NVS = O_NKS + (size_t)2 * NB_S * T_S * D_ATTN;
constexpr size_t O_NPOOLS = O_NVS + (size_t)2 * NB_S * T_S * D_ATTN;
constexpr size_t O_NCONVS = O_NPOOLS + (size_t)2 * NB_S * 15 * D_POOL;
constexpr size_t O_END = O_NCONVS + (size_t)2 * NB_S * 2 * D_CONV;

constexpr size_t MiB = 1u << 20;
constexpr size_t WS_CTL = 0, CTL_ZERO_BYTES = 1 * MiB;
constexpr size_t WS_MOD = 1 * MiB;
constexpr size_t WS_SHW = 2 * MiB;
constexpr size_t WS_ROPE = 4 * MiB;
constexpr size_t WS_PARTSS = 7 * MiB;
constexpr size_t WS_WIE = 16 * MiB;
constexpr size_t WS_WOE = 64 * MiB;
constexpr size_t WS_WIO = 80 * MiB;
constexpr size_t WS_WOO = 144 * MiB;
constexpr size_t WS_WPW = 160 * MiB;
constexpr size_t WS_A = 162 * MiB;
constexpr size_t WS_AS = WS_A + (size_t)MP * DM * 2;
constexpr size_t WS_QR = 196 * MiB, WS_KR = 212 * MiB, WS_VB = 228 * MiB, WS_GA = 244 * MiB, WS_UB = 260 * MiB, WS_GP = 276 * MiB;
constexpr size_t WS_OPART = 292 * MiB;
constexpr size_t WS_ML = 340 * MiB;
constexpr size_t WS_MERGED = 342 * MiB;
constexpr size_t WS_UO = WS_QR, WS_ZO = WS_QR + 32 * MiB;
constexpr size_t WS_END = 374 * MiB;
constexpr size_t WS_NAIVE = 376 * MiB;

constexpr size_t WS_SRAW = 8 * MiB;
constexpr size_t WS_SMG = 10 * MiB;
constexpr size_t WS_PSS_S = 10 * MiB + 512 * 1024;
constexpr size_t WS_SOP = 11 * MiB;
constexpr size_t WS_SML = 12 * MiB;

typedef unsigned short bf16_t;
typedef float f32x4 __attribute__((ext_vector_type(4)));
typedef unsigned u32x4 __attribute__((ext_vector_type(4)));
typedef unsigned u32x2 __attribute__((ext_vector_type(2)));
typedef short bf16x8 __attribute__((ext_vector_type(8)));

__host__ __device__ __forceinline__ float bf2f(bf16_t v) { union { unsigned u; float f; } x; x.u = (unsigned)v << 16; return x.f; }
__device__ __forceinline__ float silu_f(float x) { return x / (1.f + expf(-x)); }
__device__ __forceinline__ float silu_fast(float x) { return x * __builtin_amdgcn_rcpf(1.f + __expf(-x)); }

__host__ __device__ __forceinline__ int nat8_phys(int j) { const int bj = j >> 7, wc = (j >> 5) & 3, fq = (j >> 3) & 3, n = (j >> 2) & 1, e = j & 3; return 128 * bj + 32 * wc + 16 * n + 4 * fq + e; }
__host__ __device__ __forceinline__ int phys_ie(int c) {
    const int grp = c >> 10, cc = c & 1023;
    if (grp < 2) {
        const int h = cc >> 7, d = cc & 127, bj = d >> 6, dd = d & 63, pn = 4 * grp + (h >> 1), hl = h & 1;
        const int wc = 2 * hl + (dd >> 5), fq = (dd >> 3) & 3, n = (dd >> 2) & 1, e = dd & 3;
        return 256 * pn + 128 * bj + 32 * wc + 16 * n + 4 * fq + e;
    }
    return 256 * (4 * grp + (cc >> 8)) + nat8_phys(cc & 255);
}
__host__ __device__ __forceinline__ int phys_io(int c) {
    const int grp = c >> 11, ch = c & 2047, pn = ch >> 6, r = ch & 63, wc = r >> 4, fq = (r >> 2) & 3, e = r & 3, bj = grp >> 1, n = grp & 1;
    return 256 * pn + 128 * bj + 32 * wc + 16 * n + 4 * fq + e;
}
__host__ __device__ __forceinline__ int phys_out(int c) { return (c & ~255) + nat8_phys(c & 255); }
namespace pg8 {
#define PG8_LAS __attribute__((address_space(3)))
typedef unsigned short bf16_t;
typedef short bf16x8 __attribute__((ext_vector_type(8)));
typedef float f32x4 __attribute__((ext_vector_type(4)));
typedef unsigned u32x4 __attribute__((ext_vector_type(4)));
constexpr int BM = 256, BK = 64, HALF = 128, HTB = HALF * BK * 2  , STAGE_BYTES = 8 * HTB, NXCD = 8, WGM = 8;

__host__ __device__ __forceinline__ int lds_byte(int r, int c) { const int st = (r >> 4) * 2 + (c >> 5), rr = r & 15, cc = c & 31, ob = rr * 64 + cc * 2; return st * 1024 + (ob ^ (((ob >> 9) & 1) << 5)); }
__host__ __device__ __forceinline__ void stage_rc(int b, int& R, int& C) { const int st = b / 1024, sb = b % 1024, swz = sb ^ (((sb >> 9) & 1) << 5); R = (st >> 1) * 16 + swz / 64; C = (st & 1) * 32 + (swz % 64) / 2; }
__host__ __device__ __forceinline__ int perm32(int rho) { const int n = rho >> 4, i = rho & 15; return 8 * (i >> 2) + 4 * n + (i & 3); }

struct Unit { int pm, pn, ui; };
struct Gemm { const bf16_t* A; const bf16_t* Bt; int M, N, K; };

struct StaticOrder {
    int nM, nN, nwg, G, c;
    __host__ __device__ void init(int M, int N, int G_, int c_) { nM = M / BM; nN = N / BM; nwg = nM * nN; G = G_; c = c_; }
    __host__ __device__ bool next(int i, Unit& u) const {
        const long L = (long)i * G + c; if (L >= nwg) return false;
        int wgid = (int)L; { const int q = nwg / NXCD, r = nwg % NXCD, xcd = wgid % NXCD, off = wgid / NXCD; wgid = (xcd < r ? xcd * (q + 1) : r * (q + 1) + (xcd - r) * q) + off; }
        const int nig = WGM * nN, gid = wgid / nig, fm = gid * WGM, gsz = (nM - fm) < WGM ? (nM - fm) : WGM;
        u.pm = fm + ((wgid % nig) % gsz); u.pn = (wgid % nig) / gsz; u.ui = i; return true;
    }
    __device__ __forceinline__ void a_ready(const Unit&) const {}
    __device__ __forceinline__ void done(const Unit&) const {}
};

__device__ __forceinline__ unsigned cvt_pk_bf16(float lo, float hi) { unsigned r; asm volatile("v_cvt_pk_bf16_f32 %0, %1, %2" : "=v"(r) : "v"(lo), "v"(hi)); return r; }
typedef float f32x2 __attribute__((ext_vector_type(2)));
__device__ __forceinline__ u32x4 pack8v(const f32x4 a, const f32x4 b) { u32x4 w; w.x = cvt_pk_bf16(a[0], a[1]); w.y = cvt_pk_bf16(a[2], a[3]); w.z = cvt_pk_bf16(b[0], b[1]); w.w = cvt_pk_bf16(b[2], b[3]); return w; }
__device__ __forceinline__ f32x4 silu4(const f32x4 v) { f32x4 r; r[0] = silu_fast(v[0]); r[1] = silu_fast(v[1]); r[2] = silu_fast(v[2]); r[3] = silu_fast(v[3]); return r; }
__device__ __forceinline__ float row_rstd(const float* partss, int row) {
    const f32x4* pp = (const f32x4*)(partss + (size_t)row * NPART); float s = 0.f;
#pragma unroll
    for (int i = 0; i < NPART / 4; ++i) { const f32x4 v = pp[i]; s += (v[0] + v[1]) + (v[2] + v[3]); }
    return rsqrtf(s * (1.0f / DM) + EPS);
}
template <class Sched> __device__ __forceinline__ void fill_rstd_table(PG8_LAS float* rs_tab, const float* partss, const Sched& S, int tid) {
    Unit u;
    for (int i = 0; i < 4; ++i) { if (!S.next(i, u)) break; if (tid < BM) rs_tab[i * BM + tid] = row_rstd(partss, u.pm * BM + tid); }
    asm volatile("s_waitcnt lgkmcnt(0)" ::: "memory"); __builtin_amdgcn_s_barrier(); asm volatile("" ::: "memory");
}

constexpr size_t GSTRIDE = (size_t)8 * 1024 * 1024;
struct EpiG1E {
    static constexpr bool PERM = false, AFTER_DRAIN = false;
    PG8_LAS float* rs_tab; const float* shw;
    const float* rope_c; const float* rope_s;
    bf16_t* base6;
    float *nk, *nv, *npool;
    __device__ __forceinline__ void operator()(const f32x4 (&acc)[2][2][4][2], const Unit& u, int wr, int wc, int fr, int fq) const {
        asm volatile("" : "+v"(fr), "+v"(fq));
        const int grp = u.pn >> 2, pq = u.pn & 3, b = u.pm >> 4;
        f32x4 sh[2][2];
#pragma unroll
        for (int bj = 0; bj < 2; ++bj)
#pragma unroll
            for (int n = 0; n < 2; ++n) sh[bj][n] = *(const f32x4*)(shw + (size_t)b * SHW_LD + u.pn * BM + bj * HALF + wc * 32 + n * 16 + fq * 4);
        if (grp < 2) {
            const int head = 2 * pq + (wc >> 1), dd0 = 32 * (wc & 1) + 8 * fq;
            bf16_t* dstb = base6 + (size_t)grp * GSTRIDE + head * HD + dd0;
#pragma unroll
            for (int ai = 0; ai < 2; ++ai) {
                f32x4 c0[4], c1[4], s0[4], s1[4];
#pragma unroll
                for (int m = 0; m < 4; ++m) { const int t = (u.pm * BM + ai * HALF + wr * 64 + m * 16 + fr) & (T_P - 1);
                    c0[m] = *(const f32x4*)(rope_c + (size_t)t * 64 + dd0); c1[m] = *(const f32x4*)(rope_c + (size_t)t * 64 + dd0 + 4);
                    s0[m] = *(const f32x4*)(rope_s + (size_t)t * 64 + dd0); s1[m] = *(const f32x4*)(rope_s + (size_t)t * 64 + dd0 + 4); }
#pragma unroll
                for (int m = 0; m < 4; ++m) {
                    const int rl = ai * HALF + wr * 64 + m * 16 + fr, row = u.pm * BM + rl, t = row & (T_P - 1);
                    const float rs = rs_tab[u.ui * BM + rl];
                    const f32x4 x10 = acc[ai][0][m][0] * rs + sh[0][0], x11 = acc[ai][0][m][1] * rs + sh[0][1];
                    const f32x4 x20 = acc[ai][1][m][0] * rs + sh[1][0], x21 = acc[ai][1][m][1] * rs + sh[1][1];
                    const f32x4 o10 = x10 * c0[m] - x20 * s0[m], o11 = x11 * c1[m] - x21 * s1[m], o20 = x20 * c0[m] + x10 * s0[m], o21 = x21 * c1[m] + x11 * s1[m];
                    bf16_t* d = dstb + (size_t)row * D_ATTN;
                    *(u32x4*)d = pack8v(o10, o11); *(u32x4*)(d + 64) = pack8v(o20, o21);
                    if (grp == 1 && t >= T_P - 2048) {
                        float* o = nk + ((size_t)b * 2048 + (t - (T_P - 2048))) * D_ATTN + head * HD + dd0;
                        *(f32x4*)o = o10; *(f32x4*)(o + 4) = o11; *(f32x4*)(o + 64) = o20; *(f32x4*)(o + 68) = o21;
                    }
                }
                asm volatile("" ::: "memory");
            }
        } else {
            bf16_t* dstb = base6 + (size_t)grp * GSTRIDE + pq * 256 + wc * 32 + 8 * fq;
            const bool gate = (grp == 3) || (grp == 5);
#pragma unroll
            for (int ai = 0; ai < 2; ++ai)
#pragma unroll
                for (int m = 0; m < 4; ++m) {
                    const int rl = ai * HALF + wr * 64 + m * 16 + fr, row = u.pm * BM + rl, t = row & (T_P - 1);
                    const float rs = rs_tab[u.ui * BM + rl];
#pragma unroll
                    for (int bj = 0; bj < 2; ++bj) {
                        f32x4 v0 = acc[ai][bj][m][0] * rs + sh[bj][0], v1 = acc[ai][bj][m][1] * rs + sh[bj][1];
                        if (gate) { v0 = silu4(v0); v1 = silu4(v1); }
                        *(u32x4*)(dstb + (size_t)row * D_ATTN + bj * HALF) = pack8v(v0, v1);
                        const int col = pq * 256 + bj * HALF + wc * 32 + 8 * fq;
                        if (grp == 2 && t >= T_P - 2048) { float* o = nv + ((size_t)b * 2048 + (t - (T_P - 2048))) * D_ATTN + col; *(f32x4*)o = v0; *(f32x4*)(o + 4) = v1; }
                        if (grp == 4 && t >= T_P - 15) { float* o = npool + ((size_t)b * 15 + (t - (T_P - 15))) * D_POOL + col; *(f32x4*)o = v0; *(f32x4*)(o + 4) = v1; }
                    }
                    asm volatile("" ::: "memory");
                }
        }
    }
};

struct EpiG1O {
    static constexpr bool PERM = false, AFTER_DRAIN = false;
    PG8_LAS float* rs_tab; const float* shw;
    bf16_t *UO, *ZO; float* nconv;
    __device__ __forceinline__ void operator()(const f32x4 (&acc)[2][2][4][2], const Unit& u, int wr, int wc, int fr, int fq) const {
        asm volatile("" : "+v"(fr), "+v"(fq));
        const int b = u.pm >> 4, ch0 = 64 * u.pn + 16 * wc + 4 * fq;
        f32x4 sh[2][2];
#pragma unroll
        for (int bj = 0; bj < 2; ++bj)
#pragma unroll
            for (int n = 0; n < 2; ++n) sh[bj][n] = *(const f32x4*)(shw + (size_t)b * SHW_LD + u.pn * BM + bj * HALF + wc * 32 + n * 16 + fq * 4);
#pragma unroll
        for (int ai = 0; ai < 2; ++ai)
#pragma unroll
            for (int m = 0; m < 4; ++m) {
                const int rl = ai * HALF + wr * 64 + m * 16 + fr, row = u.pm * BM + rl, t = row & (T_P - 1);
                const float rs = rs_tab[u.ui * BM + rl];
                const f32x4 bg = acc[ai][0][m][0] * rs + sh[0][0], cg = acc[ai][0][m][1] * rs + sh[0][1], hh = acc[ai][1][m][0] * rs + sh[1][0], g = acc[ai][1][m][1] * rs + sh[1][1];
                const f32x4 uu = bg * silu4(g), zz = cg * hh;
                u32x2 wu, wz; wu.x = cvt_pk_bf16(uu[0], uu[1]); wu.y = cvt_pk_bf16(uu[2], uu[3]); wz.x = cvt_pk_bf16(zz[0], zz[1]); wz.y = cvt_pk_bf16(zz[2], zz[3]);
                *(u32x2*)(UO + (size_t)row * D_CONV + ch0) = wu; *(u32x2*)(ZO + (size_t)row * D_CONV + ch0) = wz;
                if (t >= T_P - 2) *(f32x4*)(nconv + ((size_t)b * 2 + (t - (T_P - 2))) * D_CONV + ch0) = zz;
                asm volatile("" ::: "memory");
            }
    }
};

struct EpiG2 {
    static constexpr bool PERM = false, AFTER_DRAIN = true;
    const float* xin; float* xout; bf16_t* anext;
    const float* modl;
    const float* modn; const float* gn;
    float* partss;
    __device__ __forceinline__ void operator()(const f32x4 (&acc)[2][2][4][2], const Unit& u, int wr, int wc, int fr, int fq) const {}
    __device__ __forceinline__ void fused(f32x4 (&acc)[2][2][4][2], const Unit& u, int wr, int wc, int fr, int fq, PG8_LAS unsigned char* lds, int wid, int lane) const {
        asm volatile("" : "+v"(fr), "+v"(fq), "+v"(lane));
        const int b = u.pm >> 4;
        PG8_LAS float* P = (PG8_LAS float*)lds;
        f32x4 gt[2][2], gs[2][2];
#pragma unroll
        for (int bj = 0; bj < 2; ++bj) { const int col0 = u.pn * BM + bj * HALF + wc * 32 + 8 * fq;
#pragma unroll
            for (int n = 0; n < 2; ++n) { gt[bj][n] = *(const f32x4*)(modl + (size_t)b * MODW + 2 * DM + col0 + 4 * n);
                if (anext) { const f32x4 sc = *(const f32x4*)(modn + (size_t)b * MODW + DM + col0 + 4 * n), g = *(const f32x4*)(gn + col0 + 4 * n); gs[bj][n] = g * (sc + 1.0f); }
                else gs[bj][n] = (f32x4){0.f, 0.f, 0.f, 0.f}; } }
#pragma unroll
        for (int ai = 0; ai < 2; ++ai)
#pragma unroll
            for (int m = 0; m < 4; ++m) {
                const int rl = ai * HALF + wr * 64 + m * 16 + fr, row = u.pm * BM + rl; float ss = 0.f;
#pragma unroll
                for (int bj = 0; bj < 2; ++bj) { const size_t off = (size_t)row * DM + u.pn * BM + bj * HALF + wc * 32 + 8 * fq;
                    const f32x4 x0 = *(const f32x4*)(xin + off), x1 = *(const f32x4*)(xin + off + 4);
                    const f32x4 y0 = x0 + gt[bj][0] * acc[ai][bj][m][0], y1 = x1 + gt[bj][1] * acc[ai][bj][m][1];
                    *(f32x4*)(xout + off) = y0; *(f32x4*)(xout + off + 4) = y1;
                    ss += (y0[0] * y0[0] + y0[1] * y0[1]) + (y0[2] * y0[2] + y0[3] * y0[3]) + (y1[0] * y1[0] + y1[1] * y1[1]) + (y1[2] * y1[2] + y1[3] * y1[3]);
                    if (anext) *(u32x4*)(anext + off) = pack8v(y0 * gs[bj][0], y1 * gs[bj][1]); }
                ss += __shfl_xor(ss, 16); ss += __shfl_xor(ss, 32);
                if (fq == 0) P[rl * 4 + wc] = ss;
                if (m & 1) asm volatile("" ::: "memory");
            }
        asm volatile("s_waitcnt lgkmcnt(0)" ::: "memory"); __builtin_amdgcn_s_barrier(); asm volatile("" ::: "memory");
        const int tid = wid * 64 + lane;
        if (tid < BM) { const f32x4 v = *(const PG8_LAS f32x4*)(P + tid * 4); partss[(size_t)(u.pm * BM + tid) * NPART + u.pn] = (v[0] + v[1]) + (v[2] + v[3]); }
    }
};
template <class Epi, class Sched, bool ALIGN_EPI = false, bool SP2 = false>
__device__ __forceinline__ void gemm_phase(PG8_LAS unsigned char* lds, const Gemm g, const Sched& S, const Epi& E, int tid_in) {
    int tid_ = tid_in; asm volatile("" : "+v"(tid_));
    const int tid = tid_, wid = __builtin_amdgcn_readfirstlane(tid >> 6), lane = tid & 63, wr = wid >> 2, wc = wid & 3, fr = lane & 15, fq = lane >> 4;
    const int K = g.K, nt = K / BK;
    unsigned voffA[2], voffB[2];
#pragma unroll
    for (int i = 0; i < 2; ++i) { int R, C; stage_rc(tid * 16 + i * 8192, R, C); const int Rb = Epi::PERM ? ((R & ~31) + perm32(R & 31)) : R;
        voffA[i] = (unsigned)(R * K + C) * 2u; voffB[i] = (unsigned)(Rb * K + C) * 2u; }
    const size_t kstep = (size_t)(BK * 2);
    const size_t hstep = (size_t)HALF * K * 2;
    const size_t tstep = 2 * hstep;
    const unsigned ldsw = (unsigned)wid * 1024u;
    const int aoff = lds_byte(wr * 64 + fr, fq * 8), boff = lds_byte(wc * 32 + fr, fq * 8);
#define PG8_SA(b, h) (((b) * 2 + (h)) * HTB)
#define PG8_SB(b, h) ((4 + (b) * 2 + (h)) * HTB)
#define PG8_STAGE(bufoff, gbase, voff) do { _Pragma("unroll") for (int _i = 0; _i < 2; ++_i) \
        __builtin_amdgcn_global_load_lds((const unsigned*)((const char*)(gbase) + (voff)[_i]), (PG8_LAS unsigned*)(lds + (bufoff) + ldsw + _i * 8192), 16, 0, 0); } while (0)
#define PG8_LDA(dst, b, h) do { _Pragma("unroll") for (int m = 0; m < 4; ++m) _Pragma("unroll") for (int k = 0; k < 2; ++k) dst[m][k] = *(const PG8_LAS bf16x8*)(lds + PG8_SA(b, h) + aoff + m * 2048 + k * 1024); } while (0)
#define PG8_LDB(dst, b, h) do { _Pragma("unroll") for (int n = 0; n < 2; ++n) _Pragma("unroll") for (int k = 0; k < 2; ++k) dst[n][k] = *(const PG8_LAS bf16x8*)(lds + PG8_SB(b, h) + boff + n * 2048 + k * 1024); } while (0)
#define PG8_MMA(ai, bj, At, Bt) do { __builtin_amdgcn_s_setprio(1); _Pragma("unroll") for (int m = 0; m < 4; ++m) _Pragma("unroll") for (int n = 0; n < 2; ++n) _Pragma("unroll") for (int k = 0; k < 2; ++k) \
        acc[ai][bj][m][n] = __builtin_amdgcn_mfma_f32_16x16x32_bf16(Bt[n][k], At[m][k], acc[ai][bj][m][n], 0, 0, 0); __builtin_amdgcn_s_setprio(0); } while (0)
#define PG8_WAIT_V(n) asm volatile("s_waitcnt vmcnt(" #n ")" ::: "memory")
#define PG8_WAIT_L(n) asm volatile("s_waitcnt lgkmcnt(" #n ")" ::: "memory")
#define PG8_BAR __builtin_amdgcn_s_barrier()
#define PG8_SCHED __builtin_amdgcn_sched_barrier(0)
    Unit cur, nxt; int ui = 0;
    if (!S.next(0, cur)) return;
    f32x4 acc[2][2][4][2];
#pragma unroll
    for (int a = 0; a < 2; ++a)
#pragma unroll
        for (int b = 0; b < 2; ++b)
#pragma unroll
            for (int m = 0; m < 4; ++m)
#pragma unroll
                for (int n = 0; n < 2; ++n) acc[a][b][m][n] = (f32x4){0.f, 0.f, 0.f, 0.f};
    bf16x8 At[4][2], B0[2][2], B1[2][2];
    const char* cA = (const char*)g.A + (size_t)cur.pm * tstep; const char* cB = (const char*)g.Bt + (size_t)cur.pn * tstep;
    S.a_ready(cur);
    if constexpr (SP2) {
        PG8_STAGE(PG8_SB(0, 0), cB, voffB); PG8_STAGE(PG8_SB(0, 1), cB + hstep, voffB); PG8_STAGE(PG8_SA(0, 0), cA, voffA); PG8_STAGE(PG8_SA(0, 1), cA + hstep, voffA);
        if (wr == 1) PG8_BAR;
        PG8_WAIT_V(2); PG8_BAR;
        PG8_STAGE(PG8_SB(1, 0), cB + kstep, voffB); PG8_STAGE(PG8_SA(1, 0), cA + kstep, voffA); PG8_STAGE(PG8_SB(1, 1), cB + hstep + kstep, voffB);
        PG8_WAIT_V(6); PG8_BAR;
    } else {
        PG8_STAGE(PG8_SB(0, 0), cB, voffB); PG8_STAGE(PG8_SA(0, 0), cA, voffA); PG8_STAGE(PG8_SB(0, 1), cB + hstep, voffB); PG8_STAGE(PG8_SA(0, 1), cA + hstep, voffA);
        if (wr == 1) PG8_BAR;
        PG8_WAIT_V(4); PG8_BAR;
        PG8_STAGE(PG8_SB(1, 0), cB + kstep, voffB); PG8_STAGE(PG8_SA(1, 0), cA + kstep, voffA); PG8_STAGE(PG8_SB(1, 1), cB + hstep + kstep, voffB);
        PG8_WAIT_V(6); PG8_BAR;
    }
    for (;;) {
        const bool has_next = S.next(ui + 1, nxt);
        const char* nA = has_next ? (const char*)g.A + (size_t)nxt.pm * tstep : cA; const char* nB = has_next ? (const char*)g.Bt + (size_t)nxt.pn * tstep : cB;
        for (int t = 0; t < nt; t += 2) {
            const bool last = (t == nt - 2);
            const char* a1 = cA + (size_t)(t + 1) * kstep;
            const char* a2 = last ? nA : cA + (size_t)(t + 2) * kstep; const char* b2 = last ? nB : cB + (size_t)(t + 2) * kstep;
            const char* a3 = a2 + kstep; const char* b3 = b2 + kstep;
            if (last && has_next) S.a_ready(nxt);
            if constexpr (SP2) {
            PG8_LDB(B0, 0, 0); PG8_LDB(B1, 0, 1); PG8_SCHED; PG8_LDA(At, 0, 0); PG8_STAGE(PG8_SA(1, 1), a1 + hstep, voffA);
            PG8_WAIT_V(8); PG8_WAIT_L(0); PG8_BAR; PG8_MMA(0, 0, At, B0); PG8_MMA(0, 1, At, B1); PG8_BAR; PG8_SCHED;
            PG8_LDA(At, 0, 1); PG8_STAGE(PG8_SB(0, 0), b2, voffB); PG8_STAGE(PG8_SB(0, 1), b2 + hstep, voffB); PG8_STAGE(PG8_SA(0, 0), a2, voffA);
            PG8_WAIT_V(8); PG8_WAIT_L(0); PG8_BAR; PG8_MMA(1, 0, At, B0); PG8_MMA(1, 1, At, B1); PG8_BAR; PG8_SCHED;
            PG8_LDB(B0, 1, 0); PG8_LDB(B1, 1, 1); PG8_SCHED; PG8_LDA(At, 1, 0); PG8_STAGE(PG8_SA(0, 1), a2 + hstep, voffA);
            PG8_WAIT_V(8); PG8_WAIT_L(0); PG8_BAR; PG8_MMA(0, 0, At, B0); PG8_MMA(0, 1, At, B1); PG8_BAR; PG8_SCHED;
            PG8_LDA(At, 1, 1); PG8_STAGE(PG8_SB(1, 0), b3, voffB); PG8_STAGE(PG8_SB(1, 1), b3 + hstep, voffB); PG8_STAGE(PG8_SA(1, 0), a3, voffA);
            PG8_WAIT_V(8); PG8_WAIT_L(0); PG8_BAR; PG8_MMA(1, 0, At, B0); PG8_MMA(1, 1, At, B1); PG8_BAR; PG8_SCHED;
            } else {
            PG8_LDB(B0, 0, 0); PG8_SCHED; PG8_LDA(At, 0, 0); PG8_STAGE(PG8_SA(1, 1), a1 + hstep, voffA);
            PG8_WAIT_L(8); PG8_BAR; PG8_WAIT_L(0); PG8_MMA(0, 0, At, B0); PG8_BAR; PG8_SCHED;
            PG8_LDB(B1, 0, 1); PG8_STAGE(PG8_SB(0, 0), b2, voffB);
            PG8_BAR; PG8_WAIT_L(0); PG8_MMA(0, 1, At, B1); PG8_BAR;
            PG8_LDA(At, 0, 1); PG8_STAGE(PG8_SA(0, 0), a2, voffA);
            PG8_BAR; PG8_WAIT_L(0); PG8_MMA(1, 0, At, B0); PG8_BAR; PG8_SCHED;
            PG8_STAGE(PG8_SB(0, 1), b2 + hstep, voffB);
            PG8_WAIT_V(6); PG8_BAR; PG8_MMA(1, 1, At, B1); PG8_BAR;
            PG8_LDB(B0, 1, 0); PG8_SCHED; PG8_LDA(At, 1, 0); PG8_STAGE(PG8_SA(0, 1), a2 + hstep, voffA);
            PG8_WAIT_L(8); PG8_BAR; PG8_WAIT_L(0); PG8_MMA(0, 0, At, B0); PG8_BAR; PG8_SCHED;
            PG8_LDB(B1, 1, 1); PG8_STAGE(PG8_SB(1, 0), b3, voffB);
            PG8_BAR; PG8_WAIT_L(0); PG8_MMA(0, 1, At, B1); PG8_BAR;
            PG8_LDA(At, 1, 1); PG8_STAGE(PG8_SA(1, 0), a3, voffA);
            PG8_BAR; PG8_WAIT_L(0); PG8_MMA(1, 0, At, B0); PG8_BAR; PG8_SCHED;
            PG8_STAGE(PG8_SB(1, 1), b3 + hstep, voffB);
            PG8_WAIT_V(6); PG8_BAR; PG8_MMA(1, 1, At, B1); PG8_BAR;
            }
        }
        if constexpr (ALIGN_EPI) { if (wr == 0) PG8_BAR; }
        if constexpr (!Epi::AFTER_DRAIN) { E(acc, cur, wr, wc, fr, fq); if (EXP_PH == 17) { asm volatile("" ::: "memory"); E(acc, cur, wr, wc, fr, fq); } S.done(cur); }
        if (!has_next) break;
#pragma unroll
        for (int a = 0; a < 2; ++a)
#pragma unroll
            for (int b = 0; b < 2; ++b)
#pragma unroll
                for (int m = 0; m < 4; ++m)
#pragma unroll
                    for (int n = 0; n < 2; ++n) acc[a][b][m][n] = (f32x4){0.f, 0.f, 0.f, 0.f};
        cur = nxt; cA = nA; cB = nB; ++ui;
        if constexpr (ALIGN_EPI) { if (wr == 1) PG8_BAR; }
    }
    PG8_WAIT_V(0);
    if constexpr (!ALIGN_EPI) { if (wr == 0) PG8_BAR; }
    PG8_BAR;
    if constexpr (Epi::AFTER_DRAIN) { E.fused(acc, cur, wr, wc, fr, fq, lds, wid, lane); S.done(cur); }
#undef PG8_SA
#undef PG8_SB
#undef PG8_STAGE
#undef PG8_LDA
#undef PG8_LDB
#undef PG8_MMA
#undef PG8_WAIT_V
#undef PG8_WAIT_L
#undef PG8_BAR
#undef PG8_SCHED
}
}
namespace at {
using bf16 = __hip_bfloat16;
typedef short s16x4 __attribute__((ext_vector_type(4)));
typedef float f32x16 __attribute__((ext_vector_type(16)));
template <class A, class Bt> struct same_t { static constexpr bool v = false; };
template <class A> struct same_t<A, A> { static constexpr bool v = true; };
constexpr int D = 128;
constexpr int WINDOW = 129;
constexpr float THR = 8.f;
constexpr bool WSKIP = true;
constexpr float SCALE = 0.08838834764831845f;
constexpr int NW = 8, QBLK = 32, KVBLK = 64, QB = NW * QBLK;
constexpr int SHM_V = KVBLK * D * 2, SHM_K = KVBLK * D * 2;
constexpr int LDS_BYTES = 2 * SHM_V + 2 * SHM_K + NW * 64 * 4;
#define KSWZ(row, colB) ((row) * 256 + ((colB) ^ (((row) & 7) << 4)))
#define SBAR() __builtin_amdgcn_sched_barrier(0)
__device__ __forceinline__ int v_st(int k, int c) { const int kk = (k & ~0xC) | ((k & 4) << 1) | ((k & 8) >> 1); return ((kk >> 3) * 4 + (c >> 5)) * 512 + ((kk & 7) * 32 + (c & 31)) * 2; }
__device__ __forceinline__ int v_rd_base(int lane) { return ((lane & 3) << 3) | (((lane >> 2) & 3) << 6) | (((lane >> 4) & 1) << 5) | (((lane >> 5) & 1) << 8); }
constexpr int v_rd_off(int d0, int ks, int half) { return d0 * 512 + ks * 4096 + half * 2048; }
__device__ __forceinline__ int crow(int r, int hi) { return (r & 3) + 8 * (r >> 2) + 4 * hi; }
__device__ __forceinline__ unsigned cvtpk(float lo, float hi) {
    unsigned r; asm volatile("v_cvt_pk_bf16_f32 %0, %1, %2" : "=v"(r) : "v"(lo), "v"(hi)); return r;
}
__device__ __forceinline__ bf16x8 pack8(f32x4 a, f32x4 b) {
    u32x4 w = {cvtpk(a[0], a[1]), cvtpk(a[2], a[3]), cvtpk(b[0], b[1]), cvtpk(b[2], b[3])};
    return *reinterpret_cast<bf16x8*>(&w);
}
template <class T> __device__ __forceinline__ bf16x8 load8(const T* p) {
    if constexpr (same_t<T, float>::v) { return pack8(*(const f32x4*)p, *(const f32x4*)(p + 4)); }
    else { return *reinterpret_cast<const bf16x8*>(p); }
}
__device__ __forceinline__ void mask_tile(f32x16& p0, f32x16& p1, int dq, unsigned W) {
    const float NEG = -__builtin_inff();
#pragma unroll
    for (int r = 0; r < 16; ++r) {
        const int c = (r & 3) + 8 * (r >> 2);
        if ((unsigned)(dq - c) >= W) p0[r] = NEG;
        if ((unsigned)(dq - c - 32) >= W) p1[r] = NEG;
    }
}
__device__ __forceinline__ void partialSM(f32x16& p0, f32x16& p1, float& m_reg, float& mn, float& alpha) {
    float pmax = p0[0]; for (int r = 1; r < 16; ++r) pmax = fmaxf(pmax, p0[r]); for (int r = 0; r < 16; ++r) pmax = fmaxf(pmax, p1[r]);
    { auto rr = __builtin_amdgcn_permlane32_swap(__float_as_uint(pmax), __float_as_uint(pmax), false, false);
      pmax = fmaxf(__uint_as_float(rr[0]), __uint_as_float(rr[1])); }
    constexpr float C2 = 1.4426950408889634f * SCALE;
    if (__builtin_expect(__all((pmax - m_reg) * SCALE <= THR), 1)) { mn = m_reg; alpha = 1.f; }
    else { mn = fmaxf(m_reg, pmax); alpha = __builtin_amdgcn_exp2f((m_reg - mn) * C2); m_reg = mn; }
    const float mnL = -mn * C2;
    for (int r = 0; r < 16; ++r) p0[r] = fmaf(p0[r], C2, mnL); for (int r = 0; r < 16; ++r) p1[r] = fmaf(p1[r], C2, mnL);
    for (int r = 0; r < 16; ++r) p0[r] = __builtin_amdgcn_exp2f(p0[r]);
}
__device__ __forceinline__ void finishSM(f32x16& p0, f32x16& p1, float alpha, float& l_reg, bf16x8& pa0, bf16x8& pa1, bf16x8& pa2, bf16x8& pa3) {
    for (int r = 0; r < 16; ++r) p1[r] = __builtin_amdgcn_exp2f(p1[r]);
    float ps = 0; for (int r = 0; r < 16; ++r) ps += p0[r]; for (int r = 0; r < 16; ++r) ps += p1[r];
    { auto rr = __builtin_amdgcn_permlane32_swap(__float_as_uint(ps), __float_as_uint(ps), false, false);
      ps = __uint_as_float(rr[0]) + __uint_as_float(rr[1]); }
    l_reg = l_reg * alpha + ps;
#define PK4(P, B_, OUT) do { unsigned a0 = cvtpk(P[B_+0], P[B_+1]), a1 = cvtpk(P[B_+2], P[B_+3]);                          \
        unsigned b0 = cvtpk(P[B_+4], P[B_+5]), b1 = cvtpk(P[B_+6], P[B_+7]);                                             \
        auto r0 = __builtin_amdgcn_permlane32_swap(a0, b0, false, false); auto r1 = __builtin_amdgcn_permlane32_swap(a1, b1, false, false); \
        u32x4 w = {r0[0], r1[0], r0[1], r1[1]}; OUT = *reinterpret_cast<bf16x8*>(&w); } while (0)
    PK4(p0, 0, pa0); PK4(p0, 8, pa1); PK4(p1, 0, pa2); PK4(p1, 8, pa3);
#undef PK4
}
template <int KB, bool SK>
__device__ __forceinline__ void qkt(f32x16& p0, f32x16& p1, const char* K_lds, int r32, int hi, const bf16x8* qr, bool act) {
    if (SK && !act) { const float NEG = -__builtin_inff();
#pragma unroll
        for (int r = 0; r < 16; ++r) { p0[r] = NEG; p1[r] = NEG; } return; }
    p0 = f32x16{}; p1 = f32x16{};
    const char* kb[4];
#pragma unroll
    for (int dd = 0; dd < 4; ++dd) kb[dd] = K_lds + KB * SHM_K + KSWZ(r32, (dd * 16 + hi * 8) * 2);
#pragma unroll
    for (int d0 = 0; d0 < 8; ++d0) { const char* a = kb[d0 & 3] + (d0 >> 2) * 128;
        bf16x8 b0 = *reinterpret_cast<const bf16x8*>(a);
        bf16x8 b1 = *reinterpret_cast<const bf16x8*>(a + 32 * 256);
        p0 = __builtin_amdgcn_mfma_f32_32x32x16_bf16(b0, qr[d0], p0, 0, 0, 0);
        p1 = __builtin_amdgcn_mfma_f32_32x32x16_bf16(b1, qr[d0], p1, 0, 0, 0); }
}
template <int VB, bool SK>
__device__ __forceinline__ void pv_tile(f32x16* o, int vb0, bf16x8 pa0, bf16x8 pa1, bf16x8 pa2, bf16x8 pa3, bool act) {
    if (SK && !act) return;
#define TRRD(dst, off) asm volatile("ds_read_b64_tr_b16 %0, %1 offset:%2" : "=&v"(dst) : "v"(vb0), "i"(off) : "memory")
#define PV_D0(d0) do { s16x4 l0, l1, l2, l3, h0, h1, h2, h3; constexpr int b_ = VB * SHM_V + v_rd_off(d0, 0, 0);     \
        TRRD(l0, b_); TRRD(h0, b_ + 2048); TRRD(l1, b_ + 4096); TRRD(h1, b_ + 6144); TRRD(l2, b_ + 8192); TRRD(h2, b_ + 10240); TRRD(l3, b_ + 12288); TRRD(h3, b_ + 14336); \
        asm volatile("s_waitcnt lgkmcnt(0)" ::: "memory"); SBAR();                 \
        o[d0] = __builtin_amdgcn_mfma_f32_32x32x16_bf16(pa0, (bf16x8){l0[0], l0[1], l0[2], l0[3], h0[0], h0[1], h0[2], h0[3]}, o[d0], 0, 0, 0);   \
        o[d0] = __builtin_amdgcn_mfma_f32_32x32x16_bf16(pa1, (bf16x8){l1[0], l1[1], l1[2], l1[3], h1[0], h1[1], h1[2], h1[3]}, o[d0], 0, 0, 0);   \
        o[d0] = __builtin_amdgcn_mfma_f32_32x32x16_bf16(pa2, (bf16x8){l2[0], l2[1], l2[2], l2[3], h2[0], h2[1], h2[2], h2[3]}, o[d0], 0, 0, 0);   \
        o[d0] = __builtin_amdgcn_mfma_f32_32x32x16_bf16(pa3, (bf16x8){l3[0], l3[1], l3[2], l3[3], h3[0], h3[1], h3[2], h3[3]}, o[d0], 0, 0, 0); } while (0)
    PV_D0(0); PV_D0(1); PV_D0(2); PV_D0(3);
#undef PV_D0
#undef TRRD
}

template <class TIn, class TOut> struct BlockRef { const TIn* Q; const TIn* K; const TIn* V; TOut* O; float* ML; int P0; };
template <class TIn> struct Seam {
    bf16x8 qr[8];
    bf16x8 st_v0, st_v1, st_k0, st_k1; f32x4 sf0, sf1, sf2, sf3;
    f32x4 tq[16];
};
__device__ __forceinline__ int swa_jlo(int P0, int W) { const int lowk = P0 - W + 1; return lowk > 0 ? lowk / KVBLK : 0; }
#define TROW(p, k0) ((p) + (size_t)(k0) * ld)
#define VMW() asm volatile("s_waitcnt vmcnt(0)" ::: "memory")
#define VMWN(n) asm volatile("s_waitcnt vmcnt(%0)" :: "i"(n) : "memory")
#define SLOAD_H(Kp, Vp, k0) do { const TIn* vt_ = TROW(Vp, k0); const TIn* kt_ = TROW(Kp, k0); S.st_v0 = load8<TIn>(vt_ + ro0); S.st_v1 = load8<TIn>(vt_ + ro1);              \
                         S.st_k0 = load8<TIn>(kt_ + ro0); S.st_k1 = load8<TIn>(kt_ + ro1); } while (0)
#define SWRITE_HK(bf) do { *(bf16x8*)(K_lds + (bf) * SHM_K + kws) = S.st_k0; *(bf16x8*)(K_lds + (bf) * SHM_K + kws + 32 * 256) = S.st_k1; } while (0)
#define SWRITE_HV(bf) do { *(bf16x8*)(V_lds + (bf) * SHM_V + vst0) = S.st_v0; *(bf16x8*)(V_lds + (bf) * SHM_V + vst1) = S.st_v1; } while (0)
#define SWRITE_H(bf) do { SWRITE_HV(bf); SWRITE_HK(bf); } while (0)
#define SLOAD_F(p, k0) do { const float* pt_ = TROW(p, k0); S.sf0 = *(const f32x4*)(pt_ + ro0); S.sf1 = *(const f32x4*)(pt_ + ro0 + 4);                \
                            S.sf2 = *(const f32x4*)(pt_ + ro1); S.sf3 = *(const f32x4*)(pt_ + ro1 + 4); } while (0)
#define SWRITE_KF(bf) do { *(bf16x8*)(K_lds + (bf) * SHM_K + kws) = pack8(S.sf0, S.sf1); *(bf16x8*)(K_lds + (bf) * SHM_K + kws + 32 * 256) = pack8(S.sf2, S.sf3); } while (0)
#define SWRITE_VF(bf) do { *(bf16x8*)(V_lds + (bf) * SHM_V + vst0) = pack8(S.sf0, S.sf1); *(bf16x8*)(V_lds + (bf) * SHM_V + vst1) = pack8(S.sf2, S.sf3); } while (0)
template <class TIn, class TOut>
__device__ __forceinline__ void causal_swa_prime(const BlockRef<TIn, TOut>& cur, int W, char* lds, Seam<TIn>& S, int ld, int tid_in) {
    constexpr bool F32 = same_t<TIn, float>::v;
    int tid_ = tid_in; asm volatile("" : "+v"(tid_));
    const int tid = tid_, wid = __builtin_amdgcn_readfirstlane(tid >> 6), lane = tid & 63, r32 = lane & 31, hi = lane >> 5;
    const int sr = tid >> 4, sc = (tid & 15) * 8, kws = KSWZ(sr, sc * 2); char* K_lds = lds + 2 * SHM_V;
    const unsigned ro0 = (unsigned)(sr * ld + sc), ro1 = (unsigned)((32 + sr) * ld + sc);
    const int kb0 = swa_jlo(cur.P0, W) * KVBLK;
    for (int d0 = 0; d0 < 8; ++d0) S.qr[d0] = load8<TIn>(cur.Q + (unsigned)((wid * QBLK + r32) * ld + d0 * 16 + hi * 8));
    if constexpr (F32) { SLOAD_F((const float*)cur.K, kb0); VMW(); SWRITE_KF(0); SBAR(); SLOAD_F((const float*)cur.V, kb0); }
    else { SLOAD_H(cur.K, cur.V, kb0); VMW(); SWRITE_HK(0); }
    __syncthreads();
}
struct CmbRef { const unsigned short* O1; const unsigned short* O2; const float* ML1; const float* ML2; const unsigned short* GA; unsigned short* MG; };
template <class TIn, class TOut, bool CMB = false>
__device__ __forceinline__ void causal_swa_block(const BlockRef<TIn, TOut>& cur, const BlockRef<TIn, TOut>& nxt, int skv, int W, char* lds, Seam<TIn>& S, int ld, int mlstride, int tid_in, const CmbRef cmb = CmbRef{}) {
    constexpr bool F32 = same_t<TIn, float>::v;
    int tid_ = tid_in; asm volatile("" : "+v"(tid_));
    const int tid = tid_, wid = __builtin_amdgcn_readfirstlane(tid >> 6), lane = tid & 63, r32 = lane & 31, hi = lane >> 5;
    const int j_lo = swa_jlo(cur.P0, W);
    int j_hi = (cur.P0 + QB - 1) / KVBLK + 1; if (j_hi > skv / KVBLK) j_hi = skv / KVBLK;
    const int NT = j_hi - j_lo;
    const int kbn = swa_jlo(nxt.P0, W) * KVBLK;
    const int qlo = cur.P0 + wid * QBLK, qm = qlo + r32 - 4 * hi;
    char* V_lds = lds; char* K_lds = lds + 2 * SHM_V;
    float* ws = (float*)(lds + 2 * SHM_V + 2 * SHM_K) + wid * 64; float* li_l = ws, * al_l = ws + 32;
    float m_reg = -1e30f, l_reg = 0; f32x16 o[4] = {};
    const unsigned ro0 = (unsigned)((tid >> 4) * ld + (tid & 15) * 8), ro1 = (unsigned)((32 + (tid >> 4)) * ld + (tid & 15) * 8);
    const int sr = tid >> 4, sc = (tid & 15) * 8, vst0 = v_st(sr, sc), vst1 = v_st(32 + sr, sc), kws = KSWZ(sr, sc * 2);
    const int vb0 = (int)(uintptr_t)V_lds + v_rd_base(lane);
    const TIn* Kh = cur.K; const TIn* Vh = cur.V;
#define RESC(a) do { if (__any((a) < 1.f)) { if (hi == 0) al_l[r32] = (a); asm volatile("s_waitcnt lgkmcnt(0)" ::: "memory");              \
                     for (int d_ = 0; d_ < 4; ++d_) for (int r = 0; r < 16; ++r) o[d_][r] *= al_l[crow(r, hi)]; } } while (0)
#define KBASE(t) ((j_lo + (t)) * KVBLK)
#define ACT(t) (KBASE(t) <= qlo + QBLK - 1 && KBASE(t) + KVBLK - 1 >= qlo - W + 1)
#define MASKT(P0_, P1_, t) do { const int kb_ = KBASE(t); if ((!SK || ACT(t)) && (kb_ + KVBLK - 1 > qlo || kb_ <= qlo + QBLK - 1 - W)) mask_tile(P0_, P1_, qm - kb_, (unsigned)W); } while (0)
    constexpr int NQL = F32 ? 16 : 8;
    constexpr bool SK = WSKIP && !F32;
#define SEAM_K0() do { VMWN(NQL); if constexpr (F32) { SWRITE_KF(0); SBAR(); SLOAD_F((const float*)nxt.V, kbn); } else { SWRITE_HK(0); } SBAR(); } while (0)
    f32x16 pA0, pA1, pB0, pB1; float mnA, mnB, alA, alB; bf16x8 pa0, pa1, pa2, pa3;
    if constexpr (F32) { VMW(); SWRITE_VF(0); SBAR(); } else { SWRITE_HV(0); SBAR(); }
    if (NT > 1) { if constexpr (F32) SLOAD_F((const float*)Kh, KBASE(1)); else SLOAD_H(Kh, Vh, KBASE(1)); }
    SBAR(); qkt<0, SK>(pA0, pA1, K_lds, r32, hi, S.qr, ACT(0));
    if constexpr (F32) { if (NT > 1) { VMW(); SWRITE_KF(1); SBAR(); SLOAD_F((const float*)Vh, KBASE(1)); } }
    MASKT(pA0, pA1, 0); partialSM(pA0, pA1, m_reg, mnA, alA);
    if (NT > 1) { VMW(); if constexpr (F32) { SWRITE_VF(1); SBAR(); if (NT > 2) SLOAD_F((const float*)Kh, KBASE(2)); } else SWRITE_H(1); }
    __syncthreads();
#define HALF_STEP(PX0, PX1, mnX, alX, PY0, PY1, alY, t, KB, VB, SB) do {                                                      \
        SBAR(); qkt<KB, SK>(PX0, PX1, K_lds, r32, hi, S.qr, ACT(t));                                             \
        finishSM(PY0, PY1, alY, l_reg, pa0, pa1, pa2, pa3); SBAR();                                                           \
        if ((t) + 1 < NT) { if constexpr (F32) { VMW(); SWRITE_KF(SB); SBAR(); SLOAD_F((const float*)Vh, KBASE((t) + 1)); }  \
                            else { SLOAD_H(Kh, Vh, KBASE((t) + 1)); } SBAR(); }                                               \
        pv_tile<VB, SK>(o, vb0, pa0, pa1, pa2, pa3, ACT((t) - 1)); MASKT(PX0, PX1, (t)); partialSM(PX0, PX1, m_reg, mnX, alX);                                        \
        __syncthreads();                                                                                                      \
        if ((t) + 1 < NT) { VMW(); if constexpr (F32) { SWRITE_VF(SB); SBAR(); if ((t) + 2 < NT) SLOAD_F((const float*)Kh, KBASE((t) + 2)); } \
                            else { SWRITE_H(SB); } }                                                                          \
        RESC(alX); __syncthreads(); } while (0)
    for (int t = 1; t + 1 < NT; t += 2) {
        HALF_STEP(pB0, pB1, mnB, alB, pA0, pA1, alA, t, 1, 0, 0);
        HALF_STEP(pA0, pA1, mnA, alA, pB0, pB1, alB, t + 1, 0, 1, 1);
    }
    const bool even = (NT & 1) == 0;
    if (even) { SBAR(); qkt<1, SK>(pB0, pB1, K_lds, r32, hi, S.qr, ACT(NT - 1)); SBAR(); }
#define QROW(e) (nxt.Q + (unsigned)((wid * QBLK + r32) * ld + ((e) >> 1) * 16 + hi * 8 + ((e) & 1) * 4))
    if constexpr (F32) { SLOAD_F((const float*)nxt.K, kbn); SBAR();
#pragma unroll
        for (int e = 0; e < 8; ++e) S.tq[e] = *(const f32x4*)QROW(e); }
    else { SLOAD_H(nxt.K, nxt.V, kbn); SBAR();
#pragma unroll
        for (int d0 = 0; d0 < 8; ++d0) S.qr[d0] = load8<TIn>(nxt.Q + (unsigned)((wid * QBLK + r32) * ld + d0 * 16 + hi * 8)); }
    SBAR();
    finishSM(pA0, pA1, alA, l_reg, pa0, pa1, pa2, pa3); SBAR();
    if constexpr (F32) {
#pragma unroll
        for (int e = 8; e < 16; ++e) S.tq[e] = *(const f32x4*)QROW(e); SBAR(); }
#undef QROW
    pv_tile<0, SK>(o, vb0, pa0, pa1, pa2, pa3, ACT(even ? NT - 2 : NT - 1));
    if (even) { MASKT(pB0, pB1, NT - 1); partialSM(pB0, pB1, m_reg, mnB, alB); __syncthreads(); RESC(alB);
        finishSM(pB0, pB1, alB, l_reg, pa0, pa1, pa2, pa3); SBAR(); pv_tile<1, SK>(o, vb0, pa0, pa1, pa2, pa3, ACT(NT - 1)); }
    SBAR(); SEAM_K0();
    int r32e = r32, hie = hi; asm volatile("" : "+v"(r32e), "+v"(hie));
    if constexpr (!CMB) {
    if (hi == 0) li_l[r32] = l_reg; asm volatile("s_waitcnt lgkmcnt(0)" ::: "memory");
    float rli[16];
#pragma unroll
    for (int r = 0; r < 16; ++r) rli[r] = __builtin_amdgcn_rcpf(li_l[crow(r, hie)]);
    if (hie == 0) { float* mlp = cur.ML + (unsigned)((wid * QBLK + r32e) * mlstride * 2); mlp[0] = m_reg; mlp[1] = l_reg; }
    TOut* Ow = cur.O + (unsigned)(wid * QBLK * ld);
#pragma unroll
    for (int r = 0; r < 16; ++r) { const int orow = crow(r, hie);
#pragma unroll
        for (int d0 = 0; d0 < 4; ++d0) { const float v = o[d0][r] * rli[r];
            if constexpr (same_t<TOut, float>::v) { Ow[(unsigned)(orow * ld + d0 * 32 + r32e)] = v; }
            else { const float vn = __shfl_xor(v, 1);
                   if ((r32e & 1) == 0) *(unsigned*)(Ow + (unsigned)(orow * ld + d0 * 32 + r32e)) = cvtpk(v, vn); } } }
    } else {
    if (hi == 0) { li_l[r32] = l_reg; al_l[r32] = m_reg; } asm volatile("s_waitcnt lgkmcnt(0)" ::: "memory");
    constexpr float C2c = 1.4426950408889634f * SCALE;
    float c0[16], c1[16], c2[16];
#pragma unroll
    for (int r = 0; r < 16; ++r) { const int rho = wid * QBLK + crow(r, hie);
        const float m0 = al_l[crow(r, hie)], l0 = li_l[crow(r, hie)];
        const float m1 = cmb.ML1[(unsigned)(rho * mlstride * 2)], l1 = cmb.ML1[(unsigned)(rho * mlstride * 2 + 1)], m2 = cmb.ML2[(unsigned)(rho * mlstride * 2)], l2 = cmb.ML2[(unsigned)(rho * mlstride * 2 + 1)];
        const float M = fmaxf(m0, fmaxf(m1, m2));
        const float e0 = __builtin_amdgcn_exp2f((m0 - M) * C2c), w1 = __builtin_amdgcn_exp2f((m1 - M) * C2c) * l1, w2 = __builtin_amdgcn_exp2f((m2 - M) * C2c) * l2;
        const float inv = __builtin_amdgcn_rcpf(e0 * l0 + w1 + w2);
        c0[r] = e0 * inv; c1[r] = w1 * inv; c2[r] = w2 * inv; }
#pragma unroll
    for (int d0 = 0; d0 < 4; ++d0) {
        unsigned short p1[16], p2[16], g[16];
#pragma unroll
        for (int r = 0; r < 16; ++r) { const unsigned off = (unsigned)((wid * QBLK + crow(r, hie)) * ld + d0 * 32 + r32e); p1[r] = cmb.O1[off]; p2[r] = cmb.O2[off]; g[r] = cmb.GA[off]; }
#pragma unroll
        for (int r = 0; r < 16; ++r) {
            float v = c0[r] * o[d0][r] + c1[r] * __uint_as_float((unsigned)p1[r] << 16) + c2[r] * __uint_as_float((unsigned)p2[r] << 16);
            v *= __uint_as_float((unsigned)g[r] << 16);
            const float vn = __shfl_xor(v, 1);
            if ((r32e & 1) == 0) *(unsigned*)(cmb.MG + (unsigned)((wid * QBLK + crow(r, hie)) * 2 * ld + d0 * 32 + r32e)) = cvtpk(v, vn); }
    }
    }
    if constexpr (F32) {
#pragma unroll
        for (int d0 = 0; d0 < 8; ++d0) S.qr[d0] = pack8(S.tq[2 * d0], S.tq[2 * d0 + 1]); }
    __syncthreads();
#undef RESC
#undef KBASE
#undef ACT
#undef MASKT
#undef SEAM_K0
#undef HALF_STEP
}
#undef TROW
#undef VMW
#undef VMWN
#undef SLOAD_H
#undef SWRITE_HK
#undef SWRITE_HV
#undef SWRITE_H
#undef SLOAD_F
#undef SWRITE_KF
#undef SWRITE_VF

}
constexpr int NWAVES = 8;
constexpr int RING_BYTES = 131072;
constexpr int LDSCTL_OFF = RING_BYTES, MISC_OFF = LDSCTL_OFF + 320;
constexpr int LDS_BYTES = 147456;
constexpr int CW_BAR = 4096;

#define GAS __attribute__((address_space(1)))
#define LAS __attribute__((address_space(3)))
typedef GAS unsigned gu32;
#define RLX_AGENT __ATOMIC_RELAXED, __HIP_MEMORY_SCOPE_AGENT
#define LDS_WAIT() asm volatile("s_waitcnt lgkmcnt(0)" ::: "memory")
#define VM_WAIT() asm volatile("s_waitcnt vmcnt(0)" ::: "memory")

#define XB_TMO      128
#define XB_XCNT(j)  (256  + 64 * (j))
#define XB_XSUB(j)  (1280 + 64 * (j))
#define XB_XGEN(j)  (2304 + 64 * (j))
#define XB_TOP      3328
#define XB_TOPGEN   3392
#define XCD_BAR_WORDS 3456
#define XB_SPIN_CAP (1u << 18)
__device__ __forceinline__ unsigned xb_ld(unsigned* p)              { return __hip_atomic_load(p, __ATOMIC_RELAXED, __HIP_MEMORY_SCOPE_AGENT); }
__device__ __forceinline__ unsigned xb_add(unsigned* p, unsigned v) { return __hip_atomic_fetch_add(p, v, __ATOMIC_RELAXED, __HIP_MEMORY_SCOPE_AGENT); }
__device__ __forceinline__ unsigned xb_xcc_id() { return (unsigned)__builtin_amdgcn_s_getreg((3 << 11) | 20) & 0xFu; }
#define XB_SPIN(cond, bar) do { unsigned _sp = 0; while (cond) { __builtin_amdgcn_s_sleep(1); \
    if ((++_sp & 255u) == 0u) { if (xb_ld(&(bar)[XB_TMO])) break; if (_sp > XB_SPIN_CAP) { atomicAdd(&(bar)[XB_TMO], 1u); break; } } } } while (0)
__device__ __forceinline__ int lane_id() { int l; asm volatile("v_mbcnt_lo_u32_b32 %0, -1, 0\n\tv_mbcnt_hi_u32_b32 %0, -1, %0" : "=v"(l)); return l; }
struct XcdBarrier { unsigned* bar; unsigned x; volatile LAS unsigned* st; int wave; };
__device__ __forceinline__ XcdBarrier xcd_barrier_post(unsigned* bar, volatile LAS unsigned* st, int wave) {
    XcdBarrier b; b.bar = bar; b.x = xb_xcc_id(); b.st = st; b.wave = wave;
    if (wave == 0 && lane_id() == 0) (void)xb_add(&bar[XB_XCNT(b.x)], 1u);
    return b;
}
__device__ __forceinline__ void xcd_barrier_complete(unsigned* bar, unsigned x, unsigned& nloc, unsigned& nx) {
    const unsigned G = gridDim.x * gridDim.y * gridDim.z;
    unsigned sum, cnt, mine, sp = 0u;
    for (;;) {
        sum = 0u; cnt = 0u; mine = 0u;
#pragma unroll
        for (unsigned j = 0; j < 16; ++j) { const unsigned c = xb_ld(&bar[XB_XCNT(j)]); sum += c; cnt += (c > 0u) ? 1u : 0u; mine = (j == x) ? c : mine; }
        if (sum == G) break;
        __builtin_amdgcn_s_sleep(1);
        if ((++sp & 255u) == 0u) { if (xb_ld(&bar[XB_TMO])) break; if (sp > XB_SPIN_CAP) { atomicAdd(&bar[XB_TMO], 1u); break; } }
    }
    nloc = mine > 0u ? mine : 1u; nx = cnt > 0u ? cnt : 1u;
}
__device__ __forceinline__ void xcd_barrier(const XcdBarrier& b) {
    asm volatile("s_waitcnt vmcnt(0)" ::: "memory");
    __syncthreads();
    if (b.wave == 0 && lane_id() == 0) {
        unsigned* bar = b.bar;
        __builtin_amdgcn_s_waitcnt(0);
        unsigned nloc = b.st[0], nx = b.st[1];
        if (nloc == 0u) { xcd_barrier_complete(bar, b.x, nloc, nx); b.st[0] = nloc; b.st[1] = nx; }
        const unsigned old = xb_add(&bar[XB_XSUB(b.x)], 1u);
        const unsigned gen = old / nloc;
        if (old + 1u == (gen + 1u) * nloc) {
            __builtin_amdgcn_fence(__ATOMIC_RELEASE, "agent");
            asm volatile("s_waitcnt vmcnt(0)" ::: "memory");
            const unsigned og = xb_add(&bar[XB_TOP], 1u);
            const unsigned tg = og / nx;
            if (og + 1u == (tg + 1u) * nx) xb_add(&bar[XB_TOPGEN], 1u);
            else XB_SPIN(xb_ld(&bar[XB_TOPGEN]) == tg, bar);
            __builtin_amdgcn_fence(__ATOMIC_ACQUIRE, "agent");
            xb_add(&bar[XB_XGEN(b.x)], 1u);
            asm volatile("s_waitcnt vmcnt(0)" ::: "memory");
        } else {
            XB_SPIN(xb_ld(&bar[XB_XGEN(b.x)]) == gen, bar);
            __builtin_amdgcn_fence(__ATOMIC_ACQUIRE, "agent");
            asm volatile("s_waitcnt vmcnt(0)" ::: "memory");
        }
    }
    __syncthreads();
}

struct Args { const float* in[19]; float* out; unsigned char* ws; int ph_lo, ph_hi, li, pad; };
#define OPQ_S(x) asm volatile("" : "+s"(x))
#define OPQ_V(x) asm volatile("" : "+v"(x))
struct Frame {
    LAS unsigned char* lds; char* ldsg;
    int tid, lane, wave, vcu, G, bx;
    float* out; unsigned char* ws;
};
__device__ __forceinline__ Frame fresh(const Frame& F0) { Frame F = F0; OPQ_S(F.ws); OPQ_S(F.out); OPQ_S(F.bx); OPQ_S(F.vcu); int ln = lane_id(); OPQ_V(ln); F.lane = ln; F.tid = F.wave * 64 + ln; F.ldsg = (char*)(__attribute__((address_space(3))) char*)F.lds; return F; }
__device__ __forceinline__ float wave_sum(float v) {
#pragma unroll
    for (int o = 1; o < 64; o <<= 1) v += __shfl_xor(v, o);
    return v;
}
__device__ __forceinline__ unsigned f2bf(float f) { unsigned u = __builtin_bit_cast(unsigned, f); return (u + 0x7fffu + ((u >> 16) & 1u)) >> 16; }
typedef float f32x2_t __attribute__((ext_vector_type(2))); typedef __bf16 bf16x2_t __attribute__((ext_vector_type(2)));
__device__ __forceinline__ unsigned pk2(float lo, float hi) { f32x2_t v = {lo, hi}; bf16x2_t b = __builtin_convertvector(v, bf16x2_t); return __builtin_bit_cast(unsigned, b); }

enum WKind { WK_IE = 0, WK_OE = 1, WK_IO = 2, WK_OO = 3, WK_PW = 4 };
typedef short v4i16_t __attribute__((ext_vector_type(4)));
template <int KIND>
__device__ __forceinline__ void p0_transpose_item(const float* W, int K, int N, bf16_t* WT, LAS unsigned char* tile, int item, int lane) {
    const int nblk = N / 64, kb = item / nblk, nb = item % nblk, k0 = 64 * kb, n0 = 64 * nb;
    const int r = lane >> 4, c4 = lane & 15;
    f32x4 v[16];
    const float* src = W + (size_t)(k0 + r) * N + n0 + 4 * c4;
#pragma unroll
    for (int i = 0; i < 16; ++i) v[i] = *(const GAS f32x4*)(src + (size_t)(4 * i) * N);
#pragma unroll
    for (int i = 0; i < 16; ++i) { u32x2 o; o.x = pk2(v[i][0], v[i][1]); o.y = pk2(v[i][2], v[i][3]); *(LAS u32x2*)(tile + (4 * i + r) * 192 + 8 * c4) = o; }
    LDS_WAIT(); asm volatile("" ::: "memory");
    const int g = lane >> 4, q = (lane >> 2) & 3, pp = lane & 3, nn = n0 + 16 * g + (lane & 15);
    const int prow = KIND == WK_IE ? phys_ie(nn) : KIND == WK_IO ? phys_io(nn) : KIND == WK_PW ? nn : phys_out(nn);
    const LAS unsigned char* rb = tile + q * 192 + (16 * g + 4 * pp) * 2;
    bf16_t* dst = WT + (size_t)prow * K + k0;
#pragma unroll
    for (int c = 0; c < 8; ++c) {
        const v4i16_t lo = __builtin_amdgcn_ds_read_tr16_b64_v4i16((LAS v4i16_t*)(rb + (8 * c) * 192));
        const v4i16_t hi = __builtin_amdgcn_ds_read_tr16_b64_v4i16((LAS v4i16_t*)(rb + (8 * c + 4) * 192));
        u32x4 o; const u32x2 a = __builtin_bit_cast(u32x2, lo), b = __builtin_bit_cast(u32x2, hi); o.x = a.x; o.y = a.y; o.z = b.x; o.w = b.y;
        *(GAS u32x4*)(dst + 8 * c) = o;
    }
    LDS_WAIT(); asm volatile("" ::: "memory");
}
__device__ __forceinline__ void p0_phase(Frame& F, const Args& args) {
    const float* cp = args.in[2]; const float* cs = args.in[3]; const float* ada_w = args.in[8]; const float* ada_b = args.in[9];
    float* mod = (float*)(F.ws + WS_MOD);
    __syncthreads();
    LAS float* sc = (LAS float*)F.lds;
    LAS float* red = (LAS float*)(F.lds + 81920);
    for (int i = F.tid; i < NSEQ * DM; i += NWAVES * 64) { const int b = i / DM, k = i % DM; const float c = b < NB_P ? cp[b * DM + k] : cs[(b - NB_P) * DM + k]; sc[i] = c / (1.f + expf(-c)); }
    __syncthreads();
    for (int rp_ = 0; rp_ < (EXP_PH == 11 ? 2 : 1); ++rp_)
    for (int u = F.vcu; u < DEPTH * (MODW / 32); u += F.G) {
        const int l = u / (MODW / 32), j0 = (u % (MODW / 32)) * 32, kr = F.tid >> 3, cj = F.tid & 7;
        float acc[NSEQ][4];
#pragma unroll
        for (int b = 0; b < NSEQ; ++b) { acc[b][0] = 0.f; acc[b][1] = 0.f; acc[b][2] = 0.f; acc[b][3] = 0.f; }
        const float* wp = ada_w + ((size_t)l * DM + kr) * MODW + j0 + 4 * cj;
#pragma unroll 8
        for (int it = 0; it < DM / 64; ++it) {
            const f32x4 w = *(const f32x4*)(wp + (size_t)it * 64 * MODW); const int k = kr + 64 * it;
#pragma unroll
            for (int b = 0; b < NSEQ; ++b) { const float s = sc[b * DM + k]; acc[b][0] += s * w[0]; acc[b][1] += s * w[1]; acc[b][2] += s * w[2]; acc[b][3] += s * w[3]; }
        }
#pragma unroll
        for (int b = 0; b < NSEQ; ++b)
#pragma unroll
            for (int e = 0; e < 4; ++e) { float v = acc[b][e]; v += __shfl_xor(v, 8); v += __shfl_xor(v, 16); v += __shfl_xor(v, 32); if (F.lane < 8) red[(F.wave * 8 + F.lane) * 40 + b * 4 + e] = v; }
        __syncthreads();
        if (F.tid < 320) { const int cj2 = F.tid / 40, be = F.tid % 40, b = be >> 2, e = be & 3; float s = 0.f;
#pragma unroll
            for (int w = 0; w < NWAVES; ++w) s += red[(w * 8 + cj2) * 40 + be];
            const int j = j0 + 4 * cj2 + e; mod[((size_t)l * NSEQ + b) * MODW + j] = s + ada_b[l * MODW + j]; }
        __syncthreads();
    }
    __syncthreads();
    LAS unsigned char* tile = F.lds + F.wave * 12288;
    const int gw = F.vcu * NWAVES + F.wave, NGW = F.G * NWAVES;
    constexpr int I_IE = (DM / 64) * (N_EVEN_IN / 64), I_OE = (DM / 64) * (DM / 64), I_IO = (DM / 64) * (N_ODD_IN / 64), I_PW = (PG / 64) * (PG / 64);
    constexpr int NITEMS = 2 * (I_IE + I_OE + I_IO + I_OE) + 8 * I_PW;
    for (int rp_ = 0; rp_ < (EXP_PH == 12 ? 2 : 1); ++rp_)
    for (int it = gw; it < NITEMS; it += NGW) {
        int r = it;
        if (r < 2 * I_IE) { const int li = r / I_IE; p0_transpose_item<WK_IE>(args.in[11] + (size_t)li * DM * N_EVEN_IN, DM, N_EVEN_IN, (bf16_t*)(F.ws + WS_WIE) + (size_t)li * N_EVEN_IN * DM, tile, r % I_IE, F.lane); continue; } r -= 2 * I_IE;
        if (r < 2 * I_OE) { const int li = r / I_OE; p0_transpose_item<WK_OE>(args.in[12] + (size_t)li * DM * DM, DM, DM, (bf16_t*)(F.ws + WS_WOE) + (size_t)li * DM * DM, tile, r % I_OE, F.lane); continue; } r -= 2 * I_OE;
        if (r < 2 * I_IO) { const int li = r / I_IO; p0_transpose_item<WK_IO>(args.in[15] + (size_t)li * DM * N_ODD_IN, DM, N_ODD_IN, (bf16_t*)(F.ws + WS_WIO) + (size_t)li * N_ODD_IN * DM, tile, r % I_IO, F.lane); continue; } r -= 2 * I_IO;
        if (r < 2 * I_OE) { const int li = r / I_OE; p0_transpose_item<WK_OO>(args.in[17] + (size_t)li * DM * DM, DM, DM, (bf16_t*)(F.ws + WS_WOO) + (size_t)li * DM * DM, tile, r % I_OE, F.lane); continue; } r -= 2 * I_OE;
        { const int g = r / I_PW; p0_transpose_item<WK_PW>(args.in[13] + (size_t)g * PG * PG, PG, PG, (bf16_t*)(F.ws + WS_WPW) + (size_t)g * PG * PG, tile, r % I_PW, F.lane); }
    }
    float* rc = (float*)(F.ws + WS_ROPE); float* rsn = rc + (size_t)ROPE_ROWS * 64;
    for (int rp_ = 0; rp_ < (EXP_PH == 13 ? 2 : 1); ++rp_)
    for (int i = gw * 64 + F.lane; i < ROPE_ROWS * 64; i += NGW * 64) {
        const int row = i >> 6, dd = i & 63; const double pos = row < T_P ? (double)row : (double)(PAST + row - T_P);
        const double inv = pow(10000.0, -(double)dd / 64.0), ang = pos * inv;
        rc[i] = (float)cos(ang); rsn[i] = (float)sin(ang);
    }
}

__device__ __forceinline__ void p1_phase(Frame& F, const Args& args) {
    const float* mod = (const float*)(F.ws + WS_MOD); float* shw = (float*)(F.ws + WS_SHW);
    const int gw = F.vcu * NWAVES + F.wave, NGW = F.G * NWAVES;
    constexpr int NTILES = (2 * N_EVEN_IN + 2 * N_ODD_IN) / 16;
    for (int tt = gw; tt < NTILES; tt += NGW) {
        int l, p0; const bf16_t* wt;
        if (tt < 2 * N_EVEN_IN / 16) { const int li = tt / (N_EVEN_IN / 16); p0 = (tt % (N_EVEN_IN / 16)) * 16; l = 2 * li; wt = (const bf16_t*)(F.ws + WS_WIE) + ((size_t)li * N_EVEN_IN + p0) * DM; }
        else { const int t2 = tt - 2 * N_EVEN_IN / 16, li = t2 / (N_ODD_IN / 16); p0 = (t2 % (N_ODD_IN / 16)) * 16; l = 2 * li + 1; wt = (const bf16_t*)(F.ws + WS_WIO) + ((size_t)li * N_ODD_IN + p0) * DM; }
        const int fr = F.lane & 15, fq = F.lane >> 4;
        const bf16_t* wp = wt + (size_t)fr * DM + 8 * fq;
        const float* sp = mod + ((size_t)l * NSEQ + (fr < NSEQ ? fr : 0)) * MODW + 8 * fq;
        const float keep = fr < NSEQ ? 1.f : 0.f;
        f32x4 acc = {0.f, 0.f, 0.f, 0.f};
#pragma unroll 8
        for (int ks = 0; ks < DM / 32; ++ks) {
            const bf16x8 w = *(const GAS bf16x8*)(wp + 32 * ks);
            const f32x4 s0 = *(const f32x4*)(sp + 32 * ks) * keep, s1 = *(const f32x4*)(sp + 32 * ks + 4) * keep;
            u32x4 sb; sb.x = pk2(s0[0], s0[1]); sb.y = pk2(s0[2], s0[3]); sb.z = pk2(s1[0], s1[1]); sb.w = pk2(s1[2], s1[3]);
            acc = __builtin_amdgcn_mfma_f32_16x16x32_bf16(w, __builtin_bit_cast(bf16x8, sb), acc, 0, 0, 0);
        }
        if (fr < NSEQ) *(f32x4*)(shw + ((size_t)l * NSEQ + fr) * SHW_LD + p0 + 4 * fq) = acc;
    }
    const float* g0 = args.in[10]; float* partss = (float*)(F.ws + WS_PARTSS); bf16_t* A = (bf16_t*)(F.ws + WS_A);
    for (int row = gw; row < MP + MS; row += NGW) {
        const float* xr = row < MP ? args.in[0] + (size_t)row * DM : args.in[1] + (size_t)(row - MP) * DM;
        const int b = row < MP ? row / T_P : NB_P + (row - MP) / T_S;
        const float* scl = mod + ((size_t)0 * NSEQ + b) * MODW + DM; float ss = 0.f;
#pragma unroll
        for (int i = 0; i < 8; ++i) { const int c = 4 * (F.lane + 64 * i);
            const f32x4 x = *(const f32x4*)(xr + c), g = *(const f32x4*)(g0 + c), s = *(const f32x4*)(scl + c);
            ss += (x[0] * x[0] + x[1] * x[1]) + (x[2] * x[2] + x[3] * x[3]);
            const f32x4 a = x * (g * (s + 1.0f)); u32x2 o; o.x = pk2(a[0], a[1]); o.y = pk2(a[2], a[3]);
            *(GAS u32x2*)(A + (size_t)row * DM + c) = o; }
        ss = wave_sum(ss);
        if (row < MP) { if (F.lane < NPART) partss[(size_t)row * NPART + F.lane] = F.lane == 0 ? ss : 0.f; }
        else ((float*)(F.ws + WS_PSS_S))[(size_t)(row - MP) * 64 + F.lane] = F.lane == 0 ? ss : 0.f;
    }
}

template <bool CMB>
__device__ __forceinline__ void att_phase(Frame& F) {
    using bf = at::bf16;
    const bf* QR = (const bf*)(F.ws + WS_QR); const bf* KR = (const bf*)(F.ws + WS_KR); const bf* VB = (const bf*)(F.ws + WS_VB);
    bf* OP = (bf*)(F.ws + WS_OPART); float* ML = (float*)(F.ws + WS_ML);
    const int cls = F.bx & 7, idx = F.bx >> 3, per = F.G >> 3;
    constexpr int NU = CMB ? 32 : 64, UPB = CMB ? 16 : 32;
    for (int q = idx; q < NU; q += per) {
        const int bh = 2 * cls + q / UPB, w = q % UPB, pat = CMB ? 0 : 1 + (w >> 4), z = w & 15;
        const int b = bh >> 3, h = bh & 7;
        const int dil = pat == 0 ? 1 : pat == 1 ? 4 : 16;
        const int nblk = 16 / dil;
        const int res = z / nblk, blk = z % nblk;
        const int ld = dil * D_ATTN, skv = T_P / dil, P0 = blk * at::QB;
        const size_t base = ((size_t)b * T_P + res) * D_ATTN + h * HD;
        at::BlockRef<bf, bf> cur;
        cur.Q = QR + base + (size_t)P0 * ld; cur.K = KR + base; cur.V = VB + base;
        cur.O = OP + (size_t)pat * MP * D_ATTN + base + (size_t)P0 * ld;
        cur.ML = ML + (((size_t)pat * MP + (size_t)b * T_P + res + (size_t)P0 * dil) * NH + h) * 2;
        cur.P0 = P0;
        at::Seam<bf> S;
        at::causal_swa_prime<bf, bf>(cur, at::WINDOW, F.ldsg, S, ld, F.tid);
        if constexpr (CMB) {
            const size_t rb = ((size_t)b * T_P + P0) * D_ATTN + h * HD;
            at::CmbRef cr{(const unsigned short*)(F.ws + WS_OPART) + (size_t)1 * MP * D_ATTN + rb, (const unsigned short*)(F.ws + WS_OPART) + (size_t)2 * MP * D_ATTN + rb,
                          ML + (((size_t)1 * MP + (size_t)b * T_P + P0) * NH + h) * 2, ML + (((size_t)2 * MP + (size_t)b * T_P + P0) * NH + h) * 2,
                          (const unsigned short*)(F.ws + WS_GA) + rb, (unsigned short*)(F.ws + WS_MERGED) + ((size_t)b * T_P + P0) * DM + h * HD};
            at::causal_swa_block<bf, bf, true>(cur, cur, skv, at::WINDOW, F.ldsg, S, ld, dil * NH, F.tid, cr);
        } else at::causal_swa_block<bf, bf, false>(cur, cur, skv, at::WINDOW, F.ldsg, S, ld, dil * NH, F.tid);
    }
}

__device__ __forceinline__ void pool_phase(Frame& F, const Args& args, int li) {
    bf16_t* MG = (bf16_t*)(F.ws + WS_MERGED);
    const bf16_t* UB = (const bf16_t*)(F.ws + WS_UB); const bf16_t* GP = (const bf16_t*)(F.ws + WS_GP);
    const bf16_t* PW = (const bf16_t*)(F.ws + WS_WPW) + (size_t)li * 4 * PG * PG;
    const float* pscale = args.in[14] + (size_t)li * D_POOL;
    constexpr int LDA = 264;
    LAS bf16_t* Us = (LAS bf16_t*)F.lds;
    LAS bf16_t* As = (LAS bf16_t*)(F.lds + 40960);
    for (int u = F.vcu; u < (MP / 64) * 4; u += F.G) {
        const int rt = u >> 2, g = u & 3, R0 = rt * 64, t0 = R0 & (T_P - 1), wlen = 2 << g;
        const int fr = F.lane & 15, fq = F.lane >> 4;
        bf16x8 bb[8][2];
#pragma unroll
        for (int ks = 0; ks < 8; ++ks)
#pragma unroll
            for (int nt = 0; nt < 2; ++nt) bb[ks][nt] = *(const GAS bf16x8*)(PW + ((size_t)g * PG + 32 * F.wave + 16 * nt + fr) * PG + 32 * ks + 8 * fq);
        u32x2 gv[4][2]; f32x4 ps[2];
#pragma unroll
        for (int nt = 0; nt < 2; ++nt) { const int col = 256 * g + 32 * F.wave + 16 * nt + 4 * fq; ps[nt] = *(const f32x4*)(pscale + col);
#pragma unroll
            for (int mt = 0; mt < 4; ++mt) gv[mt][nt] = *(const GAS u32x2*)(GP + (size_t)(R0 + 16 * mt + fr) * D_POOL + col); }
        __syncthreads();
        for (int i = F.tid; i < 79 * 32; i += NWAVES * 64) { const int rr = i >> 5, ck = i & 31, t = t0 - 15 + rr; u32x4 v = {0u, 0u, 0u, 0u};
            if (t >= 0) v = *(const GAS u32x4*)(UB + (size_t)(R0 - 15 + rr) * D_POOL + 256 * g + 8 * ck);
            *(LAS u32x4*)(Us + rr * 256 + 8 * ck) = v; }
        __syncthreads();
        {
            const int cp = F.tid & 127, rg = F.tid >> 7; const LAS bf16_t* up = Us + (16 * rg + 15) * 256 + 2 * cp; float s0 = 0.f, s1 = 0.f;
            for (int j = 1; j < wlen; ++j) { const unsigned v = *(const LAS unsigned*)(up - j * 256); s0 += __uint_as_float(v << 16); s1 += __uint_as_float(v & 0xffff0000u); }
#pragma unroll 4
            for (int i = 0; i < 16; ++i) { const unsigned vc = *(const LAS unsigned*)(up + i * 256); const float a0 = __uint_as_float(vc << 16), a1 = __uint_as_float(vc & 0xffff0000u);
                s0 += a0; s1 += a1;
                const int t = t0 + 16 * rg + i; const float ic = 1.f / (float)((t + 1) < wlen ? (t + 1) : wlen);
                *(LAS unsigned*)(As + (16 * rg + i) * LDA + 2 * cp) = pk2(s0 * ic - a0, s1 * ic - a1);
                const unsigned vo = *(const LAS unsigned*)(up + (i - wlen + 1) * 256); s0 -= __uint_as_float(vo << 16); s1 -= __uint_as_float(vo & 0xffff0000u); } }
        __syncthreads();
        f32x4 acc[4][2];
#pragma unroll
        for (int mt = 0; mt < 4; ++mt) { acc[mt][0] = (f32x4){0.f, 0.f, 0.f, 0.f}; acc[mt][1] = (f32x4){0.f, 0.f, 0.f, 0.f}; }
#pragma unroll
        for (int ks = 0; ks < 8; ++ks) {
            bf16x8 a[4];
#pragma unroll
            for (int mt = 0; mt < 4; ++mt) a[mt] = *(const LAS bf16x8*)(As + (16 * mt + fr) * LDA + 32 * ks + 8 * fq);
#pragma unroll
            for (int mt = 0; mt < 4; ++mt)
#pragma unroll
                for (int nt = 0; nt < 2; ++nt) acc[mt][nt] = __builtin_amdgcn_mfma_f32_16x16x32_bf16(bb[ks][nt], a[mt], acc[mt][nt], 0, 0, 0);
        }
#pragma unroll
        for (int nt = 0; nt < 2; ++nt) { const int col = 256 * g + 32 * F.wave + 16 * nt + 4 * fq;
#pragma unroll
            for (int mt = 0; mt < 4; ++mt) { const int row = R0 + 16 * mt + fr; const u32x2 gq = gv[mt][nt]; const f32x4 v = acc[mt][nt] * ps[nt]; u32x2 o;
                o.x = pk2(v[0] * __uint_as_float(gq.x << 16), v[1] * __uint_as_float(gq.x & 0xffff0000u)); o.y = pk2(v[2] * __uint_as_float(gq.y << 16), v[3] * __uint_as_float(gq.y & 0xffff0000u));
                *(GAS u32x2*)(MG + (size_t)row * DM + D_ATTN + col) = o; } }
    }
    __syncthreads();
}

__device__ __forceinline__ void cnv_phase(Frame& F, const Args& args, int li) {
    const bf16_t* UO = (const bf16_t*)(F.ws + WS_UO); const bf16_t* ZO = (const bf16_t*)(F.ws + WS_ZO); bf16_t* MG = (bf16_t*)(F.ws + WS_MERGED);
    const float* cw = args.in[16] + (size_t)li * 3 * D_CONV;
    for (int u = F.vcu; u < MP / 32; u += F.G) {
        const int cgp = F.tid & 255, rh = F.tid >> 8, r0 = u * 32 + rh * 16, c = 8 * cgp;
        float w0[8], w1[8], w2[8];
#pragma unroll
        for (int e = 0; e < 8; ++e) { w0[e] = cw[c + e]; w1[e] = cw[D_CONV + c + e]; w2[e] = cw[2 * D_CONV + c + e]; }
        float zm2[8], zm1[8];
        { const int t = r0 & (T_P - 1); u32x4 a = {0u, 0u, 0u, 0u}, b = {0u, 0u, 0u, 0u};
          if (t >= 2) a = *(const GAS u32x4*)(ZO + (size_t)(r0 - 2) * D_CONV + c);
          if (t >= 1) b = *(const GAS u32x4*)(ZO + (size_t)(r0 - 1) * D_CONV + c);
          zm2[0] = __uint_as_float(a.x << 16); zm2[1] = __uint_as_float(a.x & 0xffff0000u); zm2[2] = __uint_as_float(a.y << 16); zm2[3] = __uint_as_float(a.y & 0xffff0000u);
          zm2[4] = __uint_as_float(a.z << 16); zm2[5] = __uint_as_float(a.z & 0xffff0000u); zm2[6] = __uint_as_float(a.w << 16); zm2[7] = __uint_as_float(a.w & 0xffff0000u);
          zm1[0] = __uint_as_float(b.x << 16); zm1[1] = __uint_as_float(b.x & 0xffff0000u); zm1[2] = __uint_as_float(b.y << 16); zm1[3] = __uint_as_float(b.y & 0xffff0000u);
          zm1[4] = __uint_as_float(b.z << 16); zm1[5] = __uint_as_float(b.z & 0xffff0000u); zm1[6] = __uint_as_float(b.w << 16); zm1[7] = __uint_as_float(b.w & 0xffff0000u); }
#pragma unroll 4
        for (int i = 0; i < 16; ++i) { const size_t off = (size_t)(r0 + i) * D_CONV + c;
            const u32x4 zv = *(const GAS u32x4*)(ZO + off), uv = *(const GAS u32x4*)(UO + off);
            float z[8], uu[8];
            z[0] = __uint_as_float(zv.x << 16); z[1] = __uint_as_float(zv.x & 0xffff0000u); z[2] = __uint_as_float(zv.y << 16); z[3] = __uint_as_float(zv.y & 0xffff0000u);
            z[4] = __uint_as_float(zv.z << 16); z[5] = __uint_as_float(zv.z & 0xffff0000u); z[6] = __uint_as_float(zv.w << 16); z[7] = __uint_as_float(zv.w & 0xffff0000u);
            uu[0] = __uint_as_float(uv.x << 16); uu[1] = __uint_as_float(uv.x & 0xffff0000u); uu[2] = __uint_as_float(uv.y << 16); uu[3] = __uint_as_float(uv.y & 0xffff0000u);
            uu[4] = __uint_as_float(uv.z << 16); uu[5] = __uint_as_float(uv.z & 0xffff0000u); uu[6] = __uint_as_float(uv.w << 16); uu[7] = __uint_as_float(uv.w & 0xffff0000u);
            float y[8];
#pragma unroll
            for (int e = 0; e < 8; ++e) { y[e] = uu[e] * (w0[e] * zm2[e] + w1[e] * zm1[e] + w2[e] * z[e]); zm2[e] = zm1[e]; zm1[e] = z[e]; }
            u32x4 o; o.x = pk2(y[0], y[1]); o.y = pk2(y[2], y[3]); o.z = pk2(y[4], y[5]); o.w = pk2(y[6], y[7]);
            *(GAS u32x4*)(MG + off) = o; }
    }
}

__device__ __forceinline__ void fin_phase(Frame& F, const Args& args) {
    const int gw = F.vcu * NWAVES + F.wave, NGW = F.G * NWAVES;
    const float* partss = (const float*)(F.ws + WS_PARTSS); const float* fg = args.in[18]; float* y = F.out + O_YP;
    for (int row = gw; row < MP; row += NGW) {
        float s = F.lane < NPART ? partss[(size_t)row * NPART + F.lane] : 0.f; s = wave_sum(s);
        const float rstd = rsqrtf(s * (1.0f / DM) + EPS);
#pragma unroll
        for (int i = 0; i < 8; ++i) { const int c = 4 * (F.lane + 64 * i); f32x4 x = *(const f32x4*)(y + (size_t)row * DM + c); const f32x4 g = *(const f32x4*)(fg + c);
            x = x * rstd * g; *(f32x4*)(y + (size_t)row * DM + c) = x; }
    }
}

constexpr int SRAW_LD = 8192, NPS = 64;
constexpr float ATT_SCALE = 0.08838834764831845f;

template <int KIND, class Epi>
__device__ __forceinline__ void skinny_gemm(Frame& F, const bf16_t* As, const bf16_t* Bt, int N, const Epi& E) {
    LAS f32x4* red = (LAS f32x4*)F.lds;
    const int fr = F.lane & 15, fq = F.lane >> 4;
    for (int grp = F.vcu; grp < N / 32; grp += F.G) {
        const int c0 = grp * 32;
        f32x4 acc[4][2];
#pragma unroll
        for (int mt = 0; mt < 4; ++mt) { acc[mt][0] = (f32x4){0.f, 0.f, 0.f, 0.f}; acc[mt][1] = (f32x4){0.f, 0.f, 0.f, 0.f}; }
        const bf16_t* bp[2];
#pragma unroll
        for (int nt = 0; nt < 2; ++nt) { const int c = c0 + 16 * nt + fr; const int prow = KIND == WK_IE ? phys_ie(c) : KIND == WK_IO ? phys_io(c) : phys_out(c); bp[nt] = Bt + (size_t)prow * DM + 256 * F.wave + 8 * fq; }
        const bf16_t* ap = As + (size_t)fr * DM + 256 * F.wave + 8 * fq;
#pragma unroll 4
        for (int ks = 0; ks < 8; ++ks) {
            bf16x8 a[4], b[2];
#pragma unroll
            for (int nt = 0; nt < 2; ++nt) b[nt] = *(const GAS bf16x8*)(bp[nt] + 32 * ks);
#pragma unroll
            for (int mt = 0; mt < 4; ++mt) a[mt] = *(const GAS bf16x8*)(ap + (size_t)mt * 16 * DM + 32 * ks);
#pragma unroll
            for (int mt = 0; mt < 4; ++mt)
#pragma unroll
                for (int nt = 0; nt < 2; ++nt) acc[mt][nt] = __builtin_amdgcn_mfma_f32_16x16x32_bf16(b[nt], a[mt], acc[mt][nt], 0, 0, 0);
        }
        __syncthreads();
#pragma unroll
        for (int mt = 0; mt < 4; ++mt)
#pragma unroll
            for (int nt = 0; nt < 2; ++nt) red[(F.wave * 8 + mt * 2 + nt) * 64 + F.lane] = acc[mt][nt];
        __syncthreads();
        { const int s = F.tid >> 6, l2 = F.tid & 63; f32x4 sum = red[s * 64 + l2];
#pragma unroll
          for (int w = 1; w < NWAVES; ++w) sum += red[(w * 8 + s) * 64 + l2];
          const int m = 16 * (s >> 1) + (l2 & 15), c = c0 + 16 * (s & 1) + 4 * (l2 >> 4);
          E(m, c, sum, grp, F); }
    }
    __syncthreads();
}
__device__ __forceinline__ LAS float* sample_rstd_table(Frame& F) {
    LAS float* rs = (LAS float*)(F.lds + 65536 + 4096);
    const float* pss = (const float*)(F.ws + WS_PSS_S);
    { const int row = F.tid >> 3, j = F.tid & 7; const f32x4 a = *(const f32x4*)(pss + row * NPS + 8 * j), b = *(const f32x4*)(pss + row * NPS + 8 * j + 4);
      float s = (a[0] + a[1]) + (a[2] + a[3]) + (b[0] + b[1]) + (b[2] + b[3]); s += __shfl_xor(s, 1); s += __shfl_xor(s, 2); s += __shfl_xor(s, 4);
      if (j == 0) rs[row] = rsqrtf(s * (1.0f / DM) + EPS); }
    __syncthreads();
    return rs;
}
template <int KIND> struct EpiSRaw {
    const float* shw; LAS float* rs; float* sraw;
    __device__ __forceinline__ void operator()(int m, int c, f32x4 sum, int grp, Frame& F) const {
        const int seq = NB_P + (m >> 3); const int prow = KIND == WK_IE ? phys_ie(c) : phys_io(c);
        const f32x4 sh = *(const f32x4*)(shw + (size_t)seq * SHW_LD + prow);
        *(f32x4*)(sraw + (size_t)m * SRAW_LD + c) = sum * rs[m] + sh;
    }
};
struct EpiSG2 {
    const float* xin; float* xout; bf16_t* anext; const float* modl; const float* modn; const float* gn; float* pss;
    __device__ __forceinline__ void operator()(int m, int c, f32x4 sum, int grp, Frame& F) const {
        LAS float* sq = (LAS float*)(F.lds + 65536);
        const int seq = NB_P + (m >> 3);
        const f32x4 gt = *(const f32x4*)(modl + (size_t)seq * MODW + 2 * DM + c), x0 = *(const f32x4*)(xin + (size_t)m * DM + c);
        const f32x4 y = x0 + gt * sum;
        *(f32x4*)(xout + (size_t)m * DM + c) = y;
        if (anext) { const f32x4 sc = *(const f32x4*)(modn + (size_t)seq * MODW + DM + c), g = *(const f32x4*)(gn + c); const f32x4 a = y * (g * (sc + 1.0f));
            u32x2 o; o.x = pk2(a[0], a[1]); o.y = pk2(a[2], a[3]); *(GAS u32x2*)(anext + (size_t)m * DM + c) = o; }
        sq[m * 8 + ((c >> 2) & 7)] = (y[0] * y[0] + y[1] * y[1]) + (y[2] * y[2] + y[3] * y[3]);
        __syncthreads();
        if (F.tid < 64) { const f32x4 a = *(const LAS f32x4*)(sq + F.tid * 8), b = *(const LAS f32x4*)(sq + F.tid * 8 + 4); pss[F.tid * NPS + grp] = (a[0] + a[1]) + (a[2] + a[3]) + (b[0] + b[1]) + (b[2] + b[3]); }
    }
};

constexpr int SA_CH = 322, SA_WR = 41;
constexpr size_t WS_SNEW = WS_SML + 64 * 1024;
__device__ __forceinline__ int sa_row(int a) { return a < 768 ? ((a >> 3) << 4) + (a & 7) : a + 768; }
__device__ __forceinline__ void satt_phase(Frame& F, const Args& args, int li) {
    const float* sraw = (const float*)(F.ws + WS_SRAW);
    const float* rope_c = (const float*)(F.ws + WS_ROPE) + (size_t)T_P * 64; const float* rope_s = rope_c + (size_t)ROPE_ROWS * 64;
    const float* stk = args.in[4] + (size_t)li * NB_S * WBUF * D_ATTN; const float* stv = args.in[5] + (size_t)li * NB_S * WBUF * D_ATTN;
    float* sop = (float*)(F.ws + WS_SOP); float* sml = (float*)(F.ws + WS_SML); float* snew = (float*)(F.ws + WS_SNEW);
    LAS float* qs = (LAS float*)F.lds;
    LAS float* Pt = qs + 1024 + F.wave * 384;
    LAS float* st = qs + 1024 + 8 * 384;
    LAS float* mg = st + 128;
    const int fr = F.lane & 15, fq = F.lane >> 4;
    for (int u = F.vcu; u < NB_S * NH * 4; u += F.G) {
        const int c = u & 3, bh = u >> 2, b = bh >> 3, h = bh & 7;
        __syncthreads();
        { const int row = F.tid >> 6, d2 = F.tid & 63, m = b * T_S + row; const float cs = rope_c[row * 64 + d2], sn = rope_s[row * 64 + d2];
          const float* src = sraw + (size_t)m * SRAW_LD + h * HD + d2;
          const float q1 = src[0], q2 = src[64];
          qs[row * 128 + d2] = (q1 * cs - q2 * sn) * ATT_SCALE; qs[row * 128 + 64 + d2] = (q2 * cs + q1 * sn) * ATT_SCALE;
          if (c == 0 || c == 3) { const float k1 = src[D_ATTN], k2 = src[D_ATTN + 64], v1 = src[2 * D_ATTN], v2 = src[2 * D_ATTN + 64]; const float kr1 = k1 * cs - k2 * sn, kr2 = k2 * cs + k1 * sn;
              if (c == 3) { float* o = snew + (((size_t)bh * T_S + row) * 2) * HD + d2; o[0] = kr1; o[64] = kr2; o[HD] = v1; o[HD + 64] = v2; }
              else { const size_t o = (((size_t)li * NB_S + b) * T_S + row) * D_ATTN + h * HD + d2; F.out[O_NKS + o] = kr1; F.out[O_NKS + o + 64] = kr2; F.out[O_NVS + o] = v1; F.out[O_NVS + o + 64] = v2; } } }
        VM_WAIT(); __syncthreads();
        const int a0 = c * SA_CH + SA_WR * F.wave, a1 = (a0 + SA_WR < (c + 1) * SA_CH) ? a0 + SA_WR : (c + 1) * SA_CH, nrows = a1 > a0 ? a1 - a0 : 0;
        bf16x8 qf[4];
#pragma unroll
        for (int ks = 0; ks < 4; ++ks) { u32x4 w = {0u, 0u, 0u, 0u};
            if (fr < 8) { const f32x4 x0 = *(const LAS f32x4*)(qs + fr * 128 + 32 * ks + 8 * fq), x1 = *(const LAS f32x4*)(qs + fr * 128 + 32 * ks + 8 * fq + 4); w.x = pk2(x0[0], x0[1]); w.y = pk2(x0[2], x0[3]); w.z = pk2(x1[0], x1[1]); w.w = pk2(x1[2], x1[3]); }
            qf[ks] = __builtin_bit_cast(bf16x8, w); }
        const float* kbase = stk + ((size_t)b * WBUF * NH + h) * HD; const float* vbase = stv + ((size_t)b * WBUF * NH + h) * HD;
        const float* nbase = snew + (size_t)bh * T_S * 2 * HD;
#pragma unroll
        for (int i = 0; i < 3; ++i) {
            const int slot = 16 * i + fr; const bool valid = slot < nrows; const int r = sa_row(valid ? a0 + slot : a0);
            const float* kp = (r < WBUF ? kbase + (size_t)r * D_ATTN : nbase + (size_t)(r - WBUF) * 2 * HD) + 8 * fq;
            f32x4 acc = {0.f, 0.f, 0.f, 0.f};
#pragma unroll
            for (int ks = 0; ks < 4; ++ks) { const f32x4 k0 = *(const f32x4*)(kp + 32 * ks), k1 = *(const f32x4*)(kp + 32 * ks + 4);
                u32x4 w; w.x = pk2(k0[0], k0[1]); w.y = pk2(k0[2], k0[3]); w.z = pk2(k1[0], k1[1]); w.w = pk2(k1[2], k1[3]);
                acc = __builtin_amdgcn_mfma_f32_16x16x32_bf16(qf[ks], __builtin_bit_cast(bf16x8, w), acc, 0, 0, 0); }
            if (fq < 2) {
#pragma unroll
                for (int rg = 0; rg < 4; ++rg) { const int q = 4 * fq + rg, dl = WBUF + q - r;
                    const int mult = (dl >= 0 && dl <= 128 ? 1 : 0) + (dl >= 0 && (dl & 3) == 0 && dl <= 512 ? 1 : 0) + (dl >= 0 && (dl & 15) == 0 && dl <= 2048 ? 1 : 0);
                    Pt[slot * 8 + q] = (valid && mult > 0) ? acc[rg] + (mult == 1 ? 0.f : mult == 2 ? 0.6931471806f : 1.0986122887f) : -1e30f; } }
        }
        float vx[16], vy[16];
#pragma unroll
        for (int e = 0; e < 16; ++e) { const int s = e < nrows ? e : (nrows > 0 ? nrows - 1 : 0); const int r = sa_row(a0 + s);
            const float* vp = (r < WBUF ? vbase + (size_t)r * D_ATTN : nbase + (size_t)(r - WBUF) * 2 * HD + HD) + 2 * F.lane; vx[e] = vp[0]; vy[e] = vp[1]; }
        LDS_WAIT();
        { const int q = F.lane & 7, part = F.lane >> 3; float mx = -1e30f;
#pragma unroll
          for (int e = 0; e < 6; ++e) mx = fmaxf(mx, Pt[(part * 6 + e) * 8 + q]);
          mx = fmaxf(mx, __shfl_xor(mx, 8)); mx = fmaxf(mx, __shfl_xor(mx, 16)); mx = fmaxf(mx, __shfl_xor(mx, 32));
          float ls = 0.f;
#pragma unroll
          for (int e = 0; e < 6; ++e) { const float sp = Pt[(part * 6 + e) * 8 + q]; const float pv = sp <= -1e29f ? 0.f : __expf(sp - mx); Pt[(part * 6 + e) * 8 + q] = pv; ls += pv; }
          ls += __shfl_xor(ls, 8); ls += __shfl_xor(ls, 16); ls += __shfl_xor(ls, 32);
          if (part == 0) { st[(F.wave * 8 + q) * 2] = mx; st[(F.wave * 8 + q) * 2 + 1] = ls; } }
        LDS_WAIT();
        float o[8][2];
#pragma unroll
        for (int q = 0; q < 8; ++q) { o[q][0] = 0.f; o[q][1] = 0.f; }
        for (int s0 = 0; s0 < nrows; s0 += 16) {
#pragma unroll
            for (int e = 0; e < 16; ++e) { if (s0 + e < nrows) { const f32x4 p0 = *(const LAS f32x4*)(Pt + (s0 + e) * 8), p1 = *(const LAS f32x4*)(Pt + (s0 + e) * 8 + 4);
#pragma unroll
                for (int q = 0; q < 4; ++q) { o[q][0] += p0[q] * vx[e]; o[q][1] += p0[q] * vy[e]; o[4 + q][0] += p1[q] * vx[e]; o[4 + q][1] += p1[q] * vy[e]; } } }
            if (s0 + 16 < nrows) {
#pragma unroll
                for (int e = 0; e < 16; ++e) { const int s = s0 + 16 + e < nrows ? s0 + 16 + e : nrows - 1; const int r = sa_row(a0 + s);
                    const float* vp = (r < WBUF ? vbase + (size_t)r * D_ATTN : nbase + (size_t)(r - WBUF) * 2 * HD + HD) + 2 * F.lane; vx[e] = vp[0]; vy[e] = vp[1]; } }
        }
#pragma unroll
        for (int q = 0; q < 8; ++q) { mg[(F.wave * 8 + q) * 128 + 2 * F.lane] = o[q][0]; mg[(F.wave * 8 + q) * 128 + 2 * F.lane + 1] = o[q][1]; }
        __syncthreads();
        { const int q = F.wave; float M = -1e30f;
#pragma unroll
          for (int i = 0; i < 8; ++i) M = fmaxf(M, st[(i * 8 + q) * 2]);
          float L = 0.f, x0 = 0.f, x1 = 0.f;
#pragma unroll
          for (int i = 0; i < 8; ++i) { const float mi = st[(i * 8 + q) * 2]; const float w = mi <= -1e29f ? 0.f : __expf(mi - M); L += w * st[(i * 8 + q) * 2 + 1]; x0 += w * mg[(i * 8 + q) * 128 + 2 * F.lane]; x1 += w * mg[(i * 8 + q) * 128 + 2 * F.lane + 1]; }
          const size_t pi = (((size_t)(b * T_S + q) * NH + h) * 4 + c);
          float* op = sop + pi * HD + 2 * F.lane; op[0] = x0; op[1] = x1;
          if (F.lane == 0) { sml[pi * 2] = M; sml[pi * 2 + 1] = L; } }
    }
    __syncthreads();
}
__device__ __forceinline__ void scmb_phase(Frame& F, const Args& args, int li) {
    const float* sraw = (const float*)(F.ws + WS_SRAW); bf16_t* smg = (bf16_t*)(F.ws + WS_SMG);
    const float* sop = (const float*)(F.ws + WS_SOP); const float* sml = (const float*)(F.ws + WS_SML);
    const int gw = F.vcu * NWAVES + F.wave;
    if (gw < MS * NH) { const int m = gw >> 3, h = gw & 7; float mm[4], ll[4];
#pragma unroll
        for (int p = 0; p < 4; ++p) { const float* q = sml + (((size_t)m * NH + h) * 4 + p) * 2; mm[p] = q[0]; ll[p] = q[1]; }
        const float M = fmaxf(fmaxf(mm[0], mm[1]), fmaxf(mm[2], mm[3])); float o0 = 0.f, o1 = 0.f, den = 0.f;
#pragma unroll
        for (int p = 0; p < 4; ++p) { const float w = mm[p] <= -1e29f ? 0.f : __expf(mm[p] - M); den += w * ll[p]; const float* op = sop + (((size_t)m * NH + h) * 4 + p) * HD + 2 * F.lane; o0 += w * op[0]; o1 += w * op[1]; }
        const float inv = 1.f / den; const float* ga = sraw + (size_t)m * SRAW_LD + 3 * D_ATTN + h * HD + 2 * F.lane;
        *(GAS unsigned*)(smg + (size_t)m * DM + h * HD + 2 * F.lane) = pk2(o0 * inv * silu_f(ga[0]), o1 * inv * silu_f(ga[1])); }
    const float* stp = args.in[6] + (size_t)li * NB_S * 15 * D_POOL; const float* psc = args.in[14] + (size_t)li * D_POOL;
    const bf16_t* PW = (const bf16_t*)(F.ws + WS_WPW) + (size_t)li * 4 * PG * PG;
    constexpr int LDA = 264;
    LAS bf16_t* As = (LAS bf16_t*)F.lds;
    if (F.vcu < 4) { const int g = F.vcu, wlen = 2 << g, fr = F.lane & 15, fq = F.lane >> 4;
        bf16x8 bb[8][2];
#pragma unroll
        for (int ks = 0; ks < 8; ++ks)
#pragma unroll
            for (int nt = 0; nt < 2; ++nt) bb[ks][nt] = *(const GAS bf16x8*)(PW + ((size_t)g * PG + 32 * F.wave + 16 * nt + fr) * PG + 32 * ks + 8 * fq);
        f32x4 gs[4][2];
#pragma unroll
        for (int nt = 0; nt < 2; ++nt) { const int col = 256 * g + 32 * F.wave + 16 * nt + 4 * fq; const f32x4 ps = *(const f32x4*)(psc + col);
#pragma unroll
            for (int mt = 0; mt < 4; ++mt) { const f32x4 gp = *(const f32x4*)(sraw + (size_t)(16 * mt + fr) * SRAW_LD + 4 * D_ATTN + D_POOL + col);
                gs[mt][nt][0] = silu_f(gp[0]) * ps[0]; gs[mt][nt][1] = silu_f(gp[1]) * ps[1]; gs[mt][nt][2] = silu_f(gp[2]) * ps[2]; gs[mt][nt][3] = silu_f(gp[3]) * ps[3]; } }
        __syncthreads();
#pragma unroll
        for (int k = 0; k < 2; ++k) { const int task = F.tid + 512 * k, bq = task >> 7, cp = task & 127, c = 256 * g + 2 * cp;
            float e0[23], e1[23];
#pragma unroll
            for (int i = 0; i < 23; ++i) { const float* p = i < 15 ? stp + ((size_t)bq * 15 + i) * D_POOL + c : sraw + (size_t)(bq * T_S + i - 15) * SRAW_LD + 4 * D_ATTN + c; e0[i] = p[0]; e1[i] = p[1]; }
            const float ic = 1.f / (float)wlen;
#pragma unroll
            for (int t = 0; t < 8; ++t) { float s0 = 0.f, s1 = 0.f;
#pragma unroll
                for (int j = 0; j < 16; ++j) { if (j < wlen) { s0 += e0[15 + t - j]; s1 += e1[15 + t - j]; } }
                *(LAS unsigned*)(As + (bq * T_S + t) * LDA + 2 * cp) = pk2(s0 * ic - e0[15 + t], s1 * ic - e1[15 + t]); } }
        __syncthreads();
        f32x4 acc[4][2];
#pragma unroll
        for (int mt = 0; mt < 4; ++mt) { acc[mt][0] = (f32x4){0.f, 0.f, 0.f, 0.f}; acc[mt][1] = (f32x4){0.f, 0.f, 0.f, 0.f}; }
#pragma unroll
        for (int ks = 0; ks < 8; ++ks) {
            bf16x8 a[4];
#pragma unroll
            for (int mt = 0; mt < 4; ++mt) a[mt] = *(const LAS bf16x8*)(As + (16 * mt + fr) * LDA + 32 * ks + 8 * fq);
#pragma unroll
            for (int mt = 0; mt < 4; ++mt)
#pragma unroll
                for (int nt = 0; nt < 2; ++nt) acc[mt][nt] = __builtin_amdgcn_mfma_f32_16x16x32_bf16(bb[ks][nt], a[mt], acc[mt][nt], 0, 0, 0);
        }
#pragma unroll
        for (int nt = 0; nt < 2; ++nt) { const int col = 256 * g + 32 * F.wave + 16 * nt + 4 * fq;
#pragma unroll
            for (int mt = 0; mt < 4; ++mt) { const f32x4 v = acc[mt][nt] * gs[mt][nt]; u32x2 o; o.x = pk2(v[0], v[1]); o.y = pk2(v[2], v[3]);
                *(GAS u32x2*)(smg + (size_t)(16 * mt + fr) * DM + D_ATTN + col) = o; } }
    } else if (F.vcu < 4 + NB_S) {
        const int bq = F.vcu - 4; float* np = F.out + O_NPOOLS + ((size_t)li * NB_S + bq) * 15 * D_POOL;
        for (int i = F.tid; i < 15 * D_POOL; i += NWAVES * 64) { const int r = i >> 10, c = i & 1023;
            np[i] = r < 7 ? stp[((size_t)bq * 15 + 8 + r) * D_POOL + c] : sraw[(size_t)(bq * T_S + r - 7) * SRAW_LD + 4 * D_ATTN + c]; }
    }
    __syncthreads();
}
__device__ __forceinline__ void scnv_phase(Frame& F, const Args& args, int li) {
    const float* sraw = (const float*)(F.ws + WS_SRAW); bf16_t* smg = (bf16_t*)(F.ws + WS_SMG);
    const float* stc = args.in[7] + (size_t)li * NB_S * 2 * D_CONV; const float* cw = args.in[16] + (size_t)li * 3 * D_CONV;
    for (int m = F.vcu; m < MS; m += F.G) {
        const int b = m >> 3, t = m & 7, c = 4 * F.tid;
        f32x4 y = {0.f, 0.f, 0.f, 0.f}, zt = {0.f, 0.f, 0.f, 0.f};
#pragma unroll
        for (int kk = 0; kk < 3; ++kk) { const int tt = t - 2 + kk; f32x4 z;
            if (tt >= 0) { const float* p = sraw + (size_t)(b * T_S + tt) * SRAW_LD; z = *(const f32x4*)(p + D_CONV + c) * *(const f32x4*)(p + 2 * D_CONV + c); }
            else z = *(const f32x4*)(stc + ((size_t)b * 2 + 2 + tt) * D_CONV + c);
            y += z * *(const f32x4*)(cw + kk * D_CONV + c); zt = z; }
        const float* p = sraw + (size_t)m * SRAW_LD; const f32x4 bg = *(const f32x4*)(p + c), g = *(const f32x4*)(p + 3 * D_CONV + c);
        u32x2 o; o.x = pk2(bg[0] * y[0] * silu_f(g[0]), bg[1] * y[1] * silu_f(g[1])); o.y = pk2(bg[2] * y[2] * silu_f(g[2]), bg[3] * y[3] * silu_f(g[3]));
        *(GAS u32x2*)(smg + (size_t)m * DM + c) = o;
        if (t >= T_S - 2) *(f32x4*)(F.out + O_NCONVS + (((size_t)li * NB_S + b) * 2 + (t - (T_S - 2))) * D_CONV + c) = zt;
    }
}
__device__ __forceinline__ void sfin_phase(Frame& F, const Args& args) {
    const int gw = F.vcu * NWAVES + F.wave;
    if (gw < MS) { const float* pss = (const float*)(F.ws + WS_PSS_S); float s = pss[gw * NPS + F.lane]; s = wave_sum(s);
        const float rstd = rsqrtf(s * (1.0f / DM) + EPS); float* y = F.out + O_YS + (size_t)gw * DM; const float* fg = args.in[18];
#pragma unroll
        for (int i = 0; i < 8; ++i) { const int c = 4 * (F.lane + 64 * i); f32x4 x = *(const f32x4*)(y + c); x = x * rstd * *(const f32x4*)(fg + c); *(f32x4*)(y + c) = x; } }
}
constexpr int PH_FIN = 2 + 4 * DEPTH, PH_END = PH_FIN + 1;
#define REP(id) for (int rep_ = 0; rep_ < ((EXP_PH == (id)) ? 2 : 1); ++rep_)
__global__ void __launch_bounds__(NWAVES * 64, 2) mk_fwd(Args args) {
    extern __shared__ __attribute__((aligned(16))) unsigned char lds[];
    Frame F0;
    F0.lds = (LAS unsigned char*)lds; F0.ldsg = nullptr;
    F0.wave = __builtin_amdgcn_readfirstlane((int)threadIdx.x >> 6); F0.lane = lane_id(); F0.tid = F0.wave * 64 + F0.lane;
    F0.G = gridDim.x; F0.bx = blockIdx.x; { const int bx = blockIdx.x; F0.vcu = (F0.G % 8 == 0) ? (bx % 8) * (F0.G / 8) + bx / 8 : bx; }
    F0.out = args.out; F0.ws = args.ws;
    volatile LAS unsigned* MISC = (volatile LAS unsigned*)(F0.lds + MISC_OFF);
    for (int u = F0.tid; u < (LDS_BYTES - LDSCTL_OFF) / 4; u += NWAVES * 64) ((LAS unsigned*)(F0.lds + LDSCTL_OFF))[u] = 0u;
    __syncthreads();
    unsigned* ctl = (unsigned*)(F0.ws + WS_CTL);
    XcdBarrier bar = xcd_barrier_post(ctl + CW_BAR + args.li * XCD_BAR_WORDS, MISC + 8, F0.wave);
    const int lo = args.ph_lo, hi = args.ph_hi;
#define IN(k) (lo <= (k) && (k) < hi)
#define SEAM(k) do { if (IN(k) && (k) + 1 < hi) { xcd_barrier(bar); if (EXP_PH == 10) xcd_barrier(bar); } } while (0)
    if (IN(0)) REP(0) { Frame F = fresh(F0); p0_phase(F, args); } SEAM(0);
    if (IN(1)) REP(1) { Frame F = fresh(F0); p1_phase(F, args); } SEAM(1);
#pragma unroll 1
    for (int l = 0; l < DEPTH; ++l) {
        const int pb = 2 + 4 * l, li = l >> 1;
        if ((l & 1) == 0) {
            if (IN(pb)) REP(2) { Frame F = fresh(F0);
                pg8::Gemm g{(const bf16_t*)(F.ws + WS_A), (const bf16_t*)(F.ws + WS_WIE) + (size_t)li * N_EVEN_IN * DM, MP, N_EVEN_IN, DM};
                pg8::StaticOrder S; S.init(MP, N_EVEN_IN, F.G, F.bx);
                const float* rope_c = (const float*)(F.ws + WS_ROPE);
                LAS float* rs_tab = (LAS float*)(F.lds + RING_BYTES + 1024); pg8::fill_rstd_table(rs_tab, (const float*)(F.ws + WS_PARTSS), S, F.tid);
                pg8::EpiG1E E{rs_tab, (const float*)(F.ws + WS_SHW) + (size_t)l * NSEQ * SHW_LD, rope_c, rope_c + (size_t)ROPE_ROWS * 64, (bf16_t*)(F.ws + WS_QR),
                              F.out + O_NKP + (size_t)li * NB_P * 2048 * D_ATTN, F.out + O_NVP + (size_t)li * NB_P * 2048 * D_ATTN, F.out + O_NPOOLP + (size_t)li * NB_P * 15 * D_POOL};
                pg8::gemm_phase<pg8::EpiG1E, pg8::StaticOrder, true, true>(F.lds, g, S, E, F.tid);
                REP(14) { LAS float* rs = sample_rstd_table(F); EpiSRaw<WK_IE> ES{(const float*)(F.ws + WS_SHW) + (size_t)l * NSEQ * SHW_LD, rs, (float*)(F.ws + WS_SRAW)};
                  skinny_gemm<WK_IE>(F, (const bf16_t*)(F.ws + WS_AS), g.Bt, N_EVEN_IN, ES); }
            } SEAM(pb);
            if (IN(pb + 1)) REP(3) { Frame F = fresh(F0); att_phase<false>(F); } if (IN(pb + 1)) REP(5) { Frame F = fresh(F0); pool_phase(F, args, li); } if (IN(pb + 1)) REP(4) { Frame F = fresh(F0); satt_phase(F, args, li); } SEAM(pb + 1);
            if (IN(pb + 2)) REP(18) { Frame F = fresh(F0); att_phase<true>(F); } if (IN(pb + 2)) REP(6) { Frame F = fresh(F0); scmb_phase(F, args, li); } SEAM(pb + 2);
        } else {
            if (IN(pb)) REP(8) { Frame F = fresh(F0);
                pg8::Gemm g{(const bf16_t*)(F.ws + WS_A), (const bf16_t*)(F.ws + WS_WIO) + (size_t)li * N_ODD_IN * DM, MP, N_ODD_IN, DM};
                pg8::StaticOrder S; S.init(MP, N_ODD_IN, F.G, F.bx);
                LAS float* rs_tab = (LAS float*)(F.lds + RING_BYTES + 1024); pg8::fill_rstd_table(rs_tab, (const float*)(F.ws + WS_PARTSS), S, F.tid);
                pg8::EpiG1O E{rs_tab, (const float*)(F.ws + WS_SHW) + (size_t)l * NSEQ * SHW_LD, (bf16_t*)(F.ws + WS_UO), (bf16_t*)(F.ws + WS_ZO), F.out + O_NCONVP + (size_t)li * NB_P * 2 * D_CONV};
                pg8::gemm_phase<pg8::EpiG1O, pg8::StaticOrder, true, true>(F.lds, g, S, E, F.tid);
                REP(14) { LAS float* rs = sample_rstd_table(F); EpiSRaw<WK_IO> ES{(const float*)(F.ws + WS_SHW) + (size_t)l * NSEQ * SHW_LD, rs, (float*)(F.ws + WS_SRAW)};
                  skinny_gemm<WK_IO>(F, (const bf16_t*)(F.ws + WS_AS), g.Bt, N_ODD_IN, ES); }
            } SEAM(pb);
            if (IN(pb + 1)) REP(9) { Frame F = fresh(F0); cnv_phase(F, args, li); } if (IN(pb + 1)) { Frame F = fresh(F0); scnv_phase(F, args, li); } SEAM(pb + 1);
        }
        if (IN(pb + 3)) for (int rep_ = 0; rep_ < ((EXP_PH == 7 && l == 0) ? 2 : 1); ++rep_) { Frame F = fresh(F0);
            const bf16_t* wt = (const bf16_t*)(F.ws + ((l & 1) ? WS_WOO : WS_WOE)) + (size_t)li * DM * DM;
            pg8::Gemm g{(const bf16_t*)(F.ws + WS_MERGED), wt, MP, DM, DM};
            pg8::StaticOrder S; S.init(MP, DM, F.G, F.bx);
            const bool last = (l == DEPTH - 1); const float* mod = (const float*)(F.ws + WS_MOD);
            pg8::EpiG2 E{l == 0 ? args.in[0] : F.out + O_YP, F.out + O_YP, last ? nullptr : (bf16_t*)(F.ws + WS_A), mod + (size_t)l * NSEQ * MODW,
                         mod + (size_t)(last ? l : l + 1) * NSEQ * MODW, args.in[10] + (size_t)(last ? l : l + 1) * DM, (float*)(F.ws + WS_PARTSS)};
            pg8::gemm_phase<pg8::EpiG2, pg8::StaticOrder, false, true>(F.lds, g, S, E, F.tid);
            { EpiSG2 ES{l == 0 ? args.in[1] : F.out + O_YS, F.out + O_YS, last ? nullptr : (bf16_t*)(F.ws + WS_AS), E.modl, E.modn, E.gn, (float*)(F.ws + WS_PSS_S)};
              __syncthreads(); skinny_gemm<WK_OE>(F, (const bf16_t*)(F.ws + WS_SMG), wt, DM, ES); }
        } SEAM(pb + 3);
    }
    if (IN(PH_FIN)) { Frame F = fresh(F0); fin_phase(F, args); sfin_phase(F, args); }
#undef IN
#undef SEAM
}
__global__ void k_siluc(const float* __restrict__ cp, const float* __restrict__ cs, float* __restrict__ sc) {
    const int i = blockIdx.x * blockDim.x + threadIdx.x;
    if (i < 10 * DM) { const int b = i / DM, k = i % DM; const float c = b < 2 ? cp[b * DM + k] : cs[(b - 2) * DM + k]; sc[i] = silu_f(c); }
}
__global__ void k_ada(const float* __restrict__ sc, const float* __restrict__ aw, const float* __restrict__ ab, float* __restrict__ mod) {
    const int j = blockIdx.x * blockDim.x + threadIdx.x;
    const int l = blockIdx.y;
    if (j >= 3 * DM) return;
    float acc[10];
#pragma unroll
    for (int b = 0; b < 10; ++b) acc[b] = 0.f;
    const float* w = aw + (size_t)l * DM * 3 * DM + j;
    for (int k = 0; k < DM; ++k) {
        const float wv = w[(size_t)k * 3 * DM];
#pragma unroll
        for (int b = 0; b < 10; ++b) {
            acc[b] += sc[b * DM + k] * wv;
        }
    }
#pragma unroll
    for (int b = 0; b < 10; ++b) mod[((size_t)l * 10 + b) * 3 * DM + j] = acc[b] + ab[l * 3 * DM + j];
}

__global__ void k_norm(const float* __restrict__ x, const float* __restrict__ g, const float* __restrict__ modp  , int T, float* __restrict__ h) {
    const int row = blockIdx.x, b = row / T;
    __shared__ float red[256];
    float s = 0.f;
    for (int c = threadIdx.x; c < DM; c += 256) { const float v = x[(size_t)row * DM + c]; s += v * v; }
    red[threadIdx.x] = s; __syncthreads();
    for (int o = 128; o > 0; o >>= 1) { if (threadIdx.x < o) red[threadIdx.x] += red[threadIdx.x + o]; __syncthreads(); }
    const float rstd = rsqrtf(red[0] / DM + EPS);
    for (int c = threadIdx.x; c < DM; c += 256) {
        float v = x[(size_t)row * DM + c] * rstd * g[c];
        if (modp) { const float sh = modp[(size_t)b * 3 * DM + c], sc = modp[(size_t)b * 3 * DM + DM + c]; v = v * (1.f + sc) + sh; }
        h[(size_t)row * DM + c] = v;
    }
}

__global__ void __launch_bounds__(256) k_gemm(const float* __restrict__ A, int lda, const float* __restrict__ W, int ldw, float* __restrict__ C, int ldc, int K) {
    __shared__ float As[16][64 + 4], Ws[16][64 + 4];
    const int tx = threadIdx.x & 15, ty = threadIdx.x >> 4;
    const int m0 = blockIdx.y * 64, n0 = blockIdx.x * 64;
    float acc[4][4] = {};
    for (int k0 = 0; k0 < K; k0 += 16) {
        for (int i = threadIdx.x; i < 64 * 16; i += 256) { const int r = i >> 4, kk = i & 15; As[kk][r] = A[(size_t)(m0 + r) * lda + k0 + kk]; }
        for (int i = threadIdx.x; i < 16 * 64; i += 256) { const int kk = i >> 6, c = i & 63; Ws[kk][c] = W[(size_t)(k0 + kk) * ldw + n0 + c]; }
        __syncthreads();
#pragma unroll
        for (int kk = 0; kk < 16; ++kk) {
            float a[4], w[4];
#pragma unroll
            for (int i = 0; i < 4; ++i) { a[i] = As[kk][ty * 4 + i]; w[i] = Ws[kk][tx * 4 + i]; }
#pragma unroll
            for (int i = 0; i < 4; ++i)
#pragma unroll
                for (int j = 0; j < 4; ++j) acc[i][j] += a[i] * w[j];
        }
        __syncthreads();
    }
#pragma unroll
    for (int i = 0; i < 4; ++i)
#pragma unroll
        for (int j = 0; j < 4; ++j) C[(size_t)(m0 + ty * 4 + i) * ldc + n0 + tx * 4 + j] = acc[i][j];
}

__global__ void k_rotary(float* __restrict__ proj, int T, int pos0) {
    const int row = blockIdx.x, t = row % T;
    const float pos = (float)(pos0 + t);
    for (int i = threadIdx.x; i < 2 * NH * 64; i += blockDim.x) {
        const int which = i / (NH * 64), r = i % (NH * 64), hh = r / 64, dd = r % 64;
        const float inv = powf(10000.f, -(float)dd / 64.f);
        const float ang = pos * inv, c = cosf(ang), s = sinf(ang);
        float* p = proj + (size_t)row * N_EVEN_IN + which * D_ATTN + hh * HD;
        const float x1 = p[dd], x2 = p[dd + 64];
        p[dd] = x1 * c - x2 * s; p[dd + 64] = x2 * c + x1 * s;
    }
}

__global__ void __launch_bounds__(64) k_attn(const float* __restrict__ proj, const float* __restrict__ stk, const float* __restrict__ stv, int T, int npre, float* __restrict__ attn) {
    const int row = blockIdx.x, h = blockIdx.y, b = row / T, t = row % T, lane = threadIdx.x;
    __shared__ float qs[HD];
    __shared__ float ps[3 * 129];
    __shared__ int pidx[3 * 129];
    const float scale = 0.08838834764831845f;
    for (int d = lane; d < HD; d += 64) qs[d] = proj[(size_t)row * N_EVEN_IN + h * HD + d] * scale;
    __syncthreads();
    const int e = npre + t;
    const int dil[3] = {1, 4, 16};
    float mymax = -1e30f;
    for (int i = lane; i < 3 * 129; i += 64) {
        const int p = i / 129, j = i % 129;
        const int idx = e - j * dil[p];
        float s = -1e30f;
        if (idx >= 0) {
            const float* kr = idx < npre ? stk + (((size_t)b * npre + idx) * NH + h) * HD : proj + (size_t)(b * T + idx - npre) * N_EVEN_IN + D_ATTN + h * HD;
            float a = 0.f;
            for (int d = 0; d < HD; ++d) a += qs[d] * kr[d];
            s = a;
        }
        ps[i] = s; pidx[i] = idx;
        mymax = fmaxf(mymax, s);
    }
    for (int o = 32; o > 0; o >>= 1) mymax = fmaxf(mymax, __shfl_xor(mymax, o));
    __syncthreads();
    float mysum = 0.f;
    for (int i = lane; i < 3 * 129; i += 64) { const float pv = pidx[i] >= 0 ? expf(ps[i] - mymax) : 0.f; ps[i] = pv; mysum += pv; }
    for (int o = 32; o > 0; o >>= 1) mysum += __shfl_xor(mysum, o);
    __syncthreads();
    float o0 = 0.f, o1 = 0.f;
    for (int i = 0; i < 3 * 129; ++i) {
        const int idx = pidx[i];
        if (idx < 0) continue;
        const float* vr = idx < npre ? stv + (((size_t)b * npre + idx) * NH + h) * HD : proj + (size_t)(b * T + idx - npre) * N_EVEN_IN + 2 * D_ATTN + h * HD;
        const float pv = ps[i];
        o0 += pv * vr[lane]; o1 += pv * vr[lane + 64];
    }
    attn[(size_t)row * D_ATTN + h * HD + lane] = o0 / mysum;
    attn[(size_t)row * D_ATTN + h * HD + lane + 64] = o1 / mysum;
}

__global__ void k_pooled(const float* __restrict__ proj, const float* __restrict__ prefix, int T, int pos0, float* __restrict__ pooled) {
    const int row = blockIdx.x, b = row / T, t = row % T;
    for (int c = threadIdx.x; c < D_POOL; c += blockDim.x) {
        const int gi = c / PG, w = 2 << gi;
        float s = 0.f;
        for (int j = 0; j < w; ++j) {
            const int tt = t - j;
            float v;
            if (tt >= 0) v = proj[(size_t)(b * T + tt) * N_EVEN_IN + 4 * D_ATTN + c];
            else v = prefix ? prefix[((size_t)b * 15 + (15 + tt)) * D_POOL + c] : 0.f;
            s += v;
        }
        const int pos = pos0 + t;
        const float cnt = (float)(w < pos + 1 ? w : pos + 1);
        pooled[(size_t)row * D_POOL + c] = s / cnt - proj[(size_t)row * N_EVEN_IN + 4 * D_ATTN + c];
    }
}

__global__ void k_merge(const float* __restrict__ proj, const float* __restrict__ attn, const float* __restrict__ mixed, const float* __restrict__ pscale, float* __restrict__ merged, int presilu) {
    const int row = blockIdx.x;
    for (int c = threadIdx.x; c < D_ATTN; c += blockDim.x) {
        { const float ga = proj[(size_t)row * N_EVEN_IN + 3 * D_ATTN + c]; merged[(size_t)row * DM + c] = attn[(size_t)row * D_ATTN + c] * (presilu ? ga : silu_f(ga)); }
        { const float gp = proj[(size_t)row * N_EVEN_IN + 4 * D_ATTN + D_POOL + c]; merged[(size_t)row * DM + D_ATTN + c] = mixed[(size_t)row * D_POOL + c] * pscale[c] * (presilu ? gp : silu_f(gp)); }
    }
}

__global__ void k_resid(float* __restrict__ x, const float* __restrict__ mix, const float* __restrict__ modp, int T) {
    const int row = blockIdx.x, b = row / T;
    for (int c = threadIdx.x; c < DM; c += blockDim.x) x[(size_t)row * DM + c] += modp[(size_t)b * 3 * DM + 2 * DM + c] * mix[(size_t)row * DM + c];
}

__global__ void k_convgate(const float* __restrict__ proj, const float* __restrict__ prefix, const float* __restrict__ cw, int T, float* __restrict__ v, float* __restrict__ newconv) {
    const int row = blockIdx.x, b = row / T, t = row % T;
    for (int c = threadIdx.x; c < D_CONV; c += blockDim.x) {
        float y = 0.f;
        for (int kk = 0; kk < 3; ++kk) {
            const int tt = t - 2 + kk;
            float z;
            if (tt >= 0) { const float* p = proj + (size_t)(b * T + tt) * N_ODD_IN; z = p[D_CONV + c] * p[2 * D_CONV + c]; }
            else z = prefix ? prefix[((size_t)b * 2 + (2 + tt)) * D_CONV + c] : 0.f;
            y += z * cw[kk * D_CONV + c];
        }
        const float* p = proj + (size_t)row * N_ODD_IN;
        v[(size_t)row * DM + c] = p[c] * y * silu_f(p[3 * D_CONV + c]);
        if (t >= T - 2) newconv[((size_t)b * 2 + (t - (T - 2))) * D_CONV + c] = p[D_CONV + c] * p[2 * D_CONV + c];
    }
}

__global__ void k_copykv(const float* __restrict__ proj, int T, int keep, float* __restrict__ ok, float* __restrict__ ov) {
    const int row = blockIdx.x, b = row / T, t = row % T;
    if (t < T - keep) return;
    for (int c = threadIdx.x; c < D_ATTN; c += blockDim.x) {
        ok[((size_t)b * keep + t - (T - keep)) * D_ATTN + c] = proj[(size_t)row * N_EVEN_IN + D_ATTN + c];
        ov[((size_t)b * keep + t - (T - keep)) * D_ATTN + c] = proj[(size_t)row * N_EVEN_IN + 2 * D_ATTN + c];
    }
}
__global__ void k_newpool(const float* __restrict__ proj, const float* __restrict__ prefix, int T, float* __restrict__ out) {
    const int b = blockIdx.x / 15, i = blockIdx.x % 15;
    const int e = T + i;
    for (int c = threadIdx.x; c < D_POOL; c += blockDim.x) {
        float v;
        if (e < 15) v = prefix ? prefix[((size_t)b * 15 + e) * D_POOL + c] : 0.f;
        else v = proj[(size_t)(b * T + e - 15) * N_EVEN_IN + 4 * D_ATTN + c];
        out[((size_t)b * 15 + i) * D_POOL + c] = v;
    }
}


__global__ void k_adapt_g1e(const bf16_t* __restrict__ QR, const bf16_t* __restrict__ KR, const bf16_t* __restrict__ VB, const bf16_t* __restrict__ GA, const bf16_t* __restrict__ UB, const bf16_t* __restrict__ GP, float* __restrict__ proj) {
    const int row = blockIdx.x;
    for (int c = threadIdx.x; c < D_ATTN; c += blockDim.x) {
        float* p = proj + (size_t)row * N_EVEN_IN; const size_t o = (size_t)row * D_ATTN + c;
        p[c] = bf2f(QR[o]); p[D_ATTN + c] = bf2f(KR[o]); p[2 * D_ATTN + c] = bf2f(VB[o]); p[3 * D_ATTN + c] = bf2f(GA[o]); p[4 * D_ATTN + c] = bf2f(UB[o]); p[5 * D_ATTN + c] = bf2f(GP[o]);
    }
}
__global__ void k_bf2f(const bf16_t* __restrict__ src, float* __restrict__ dst, size_t n) {
    for (size_t i = (size_t)blockIdx.x * blockDim.x + threadIdx.x; i < n; i += (size_t)gridDim.x * blockDim.x) dst[i] = bf2f(src[i]);
}
#ifndef MK_UPTO
#define MK_UPTO 19
#endif
struct NaiveBufs { float *xb, *hb, *proj, *attn, *pooled, *mixed, *merged, *mix, *scb, *mod; };
struct Trunk {
    int B, T, pos0, npre; const float* x_in; const float* st_k; const float* st_v; const float* st_pool; const float* st_conv; int bmod0;
    float *y, *nk, *nv, *npool, *nconv; size_t nk_l, npool_l, nconv_l; int keep;
};
static void naive_run(const Trunk& R, const NaiveBufs& N, void* const* d_in, int l0, int s0, bool final_norm, hipStream_t stream) {
    const float* norm_g = (const float*)d_in[10]; const float* w_in_even = (const float*)d_in[11]; const float* w_out_even = (const float*)d_in[12];
    const float* pool_w = (const float*)d_in[13]; const float* pool_scale = (const float*)d_in[14];
    const float* w_in_odd = (const float*)d_in[15]; const float* conv_w = (const float*)d_in[16]; const float* w_out_odd = (const float*)d_in[17]; const float* final_g = (const float*)d_in[18];
    const int M = R.B * R.T;
    for (int l = l0; l < DEPTH; ++l) {
        const int li = l / 2, s = (l == l0) ? s0 : 0;
        const float* modp = N.mod + ((size_t)l * 10 + R.bmod0) * 3 * DM;
        if (s == 0) k_norm<<<M, 256, 0, stream>>>(N.xb, norm_g + l * DM, modp, R.T, N.hb);
        if (l % 2 == 0) {
            if (s == 0) {
                k_gemm<<<dim3(N_EVEN_IN / 64, M / 64), 256, 0, stream>>>(N.hb, DM, w_in_even + (size_t)li * DM * N_EVEN_IN, N_EVEN_IN, N.proj, N_EVEN_IN, DM);
                k_rotary<<<M, 256, 0, stream>>>(N.proj, R.T, R.pos0);
                k_copykv<<<M, 256, 0, stream>>>(N.proj, R.T, R.keep, R.nk + li * R.nk_l, R.nv + li * R.nk_l);
            }
            if (s <= 1) {
                const float* sk = R.st_k ? R.st_k + (size_t)li * NB_S * WBUF * D_ATTN : nullptr;
                const float* sv = R.st_v ? R.st_v + (size_t)li * NB_S * WBUF * D_ATTN : nullptr;
                k_attn<<<dim3(M, NH), 64, 0, stream>>>(N.proj, sk, sv, R.T, R.npre, N.attn);
                const float* pp = R.st_pool ? R.st_pool + (size_t)li * NB_S * 15 * D_POOL : nullptr;
                k_pooled<<<M, 256, 0, stream>>>(N.proj, pp, R.T, R.pos0, N.pooled);
                if (s == 0) k_newpool<<<R.B * 15, 256, 0, stream>>>(N.proj, pp, R.T, R.npool + li * R.npool_l);
                for (int gi = 0; gi < 4; ++gi)
                    k_gemm<<<dim3(PG / 64, M / 64), 256, 0, stream>>>(N.pooled + gi * PG, D_POOL, pool_w + ((size_t)li * 4 + gi) * PG * PG, PG, N.mixed + gi * PG, D_POOL, PG);
                k_merge<<<M, 256, 0, stream>>>(N.proj, N.attn, N.mixed, pool_scale + li * D_POOL, N.merged, s == 1 ? 1 : 0);
            }
            k_gemm<<<dim3(DM / 64, M / 64), 256, 0, stream>>>(N.merged, DM, w_out_even + (size_t)li * DM * DM, DM, N.mix, DM, DM);
        } else {
            if (s == 0) {
                k_gemm<<<dim3(N_ODD_IN / 64, M / 64), 256, 0, stream>>>(N.hb, DM, w_in_odd + (size_t)li * DM * N_ODD_IN, N_ODD_IN, N.proj, N_ODD_IN, DM);
                const float* cp = R.st_conv ? R.st_conv + (size_t)li * NB_S * 2 * D_CONV : nullptr;
                k_convgate<<<M, 256, 0, stream>>>(N.proj, cp, conv_w + (size_t)li * 3 * D_CONV, R.T, N.merged, R.nconv + li * R.nconv_l);
            }
            k_gemm<<<dim3(DM / 64, M / 64), 256, 0, stream>>>(N.merged, DM, w_out_odd + (size_t)li * DM * DM, DM, N.mix, DM, DM);
        }
        k_resid<<<M, 256, 0, stream>>>(N.xb, N.mix, modp, R.T);
    }
    if (final_norm) k_norm<<<M, 256, 0, stream>>>(N.xb, final_g, nullptr, R.T, R.y);
}

extern "C" void kernel_launch(void* const* d_in, const int* in_sizes, int n_in, void* d_out, int out_size, void* d_ws, size_t ws_size, hipStream_t stream) {
    static int grid = 0;
    if (grid == 0) {
        int dev = 0, cus = 0, per_cu = 0;
        if (n_in != 19 || (size_t)out_size != O_END || ws_size < 700 * MiB) { fprintf(stderr, "kernel_launch: unexpected shapes (n_in %d out %d ws %zu)\n", n_in, out_size, ws_size); grid = -1; return; }
        if (hipGetDevice(&dev) != hipSuccess || hipDeviceGetAttribute(&cus, hipDeviceAttributeMultiprocessorCount, dev) != hipSuccess) { grid = -1; return; }
        if (hipFuncSetAttribute((const void*)mk_fwd, hipFuncAttributeMaxDynamicSharedMemorySize, LDS_BYTES) != hipSuccess) { fprintf(stderr, "kernel_launch: hipFuncSetAttribute failed\n"); grid = -1; return; }
        if (hipOccupancyMaxActiveBlocksPerMultiprocessor(&per_cu, (const void*)mk_fwd, NWAVES * 64, LDS_BYTES) != hipSuccess || per_cu < 1) { fprintf(stderr, "kernel_launch: occupancy query says %d blocks per CU\n", per_cu); }
        (void)hipGetLastError();
        grid = cus;
        if (grid != 256) fprintf(stderr, "kernel_launch: %d CUs (built for 256)\n", grid);
    }
    if (grid < 0) return;
    (void)hipMemsetAsync((char*)d_ws + WS_CTL, 0, CTL_ZERO_BYTES, stream);
    Args a{};
    for (int i = 0; i < 19; ++i) a.in[i] = (const float*)d_in[i];
    a.out = (float*)d_out; a.ws = (unsigned char*)d_ws;
    if (MK_UPTO == PH_END) { a.ph_lo = 0; a.ph_hi = PH_END; a.li = 0; hipLaunchKernelGGL(mk_fwd, dim3(grid), dim3(NWAVES * 64), LDS_BYTES, stream, a); }
    else { int li = 0;
      for (int ph = 0; ph < MK_UPTO; ++ph) {
          if (ph >= 2 && ph < PH_FIN) { const int l = (ph - 2) / 4, s = (ph - 2) % 4; if ((l & 1) && s == 2) continue; }
          a.ph_lo = ph; a.ph_hi = ph + 1; a.li = li++;
          hipLaunchKernelGGL(mk_fwd, dim3(grid), dim3(NWAVES * 64), LDS_BYTES, stream, a);
      } }
    float* out = (float*)d_out;
    float* nf = (float*)((char*)d_ws + WS_NAIVE); size_t w = 0;
    NaiveBufs N;
    const size_t MR = (size_t)T_P;
    N.xb = nf + w; w += MR * DM; N.hb = nf + w; N.mix = N.hb; w += MR * DM; N.proj = nf + w; w += MR * N_ODD_IN;
    N.attn = nf + w; w += MR * D_ATTN; N.pooled = nf + w; w += MR * D_POOL; N.mixed = nf + w; w += MR * D_POOL; N.merged = nf + w; w += MR * DM;
    N.scb = nf + w; w += (size_t)10 * DM;
    N.mod = (float*)((char*)d_ws + WS_MOD);
    if (MK_UPTO < 1) { k_siluc<<<10 * DM / 256, 256, 0, stream>>>((const float*)d_in[2], (const float*)d_in[3], N.scb); k_ada<<<dim3(3 * DM / 256, 4), 256, 0, stream>>>(N.scb, (const float*)d_in[8], (const float*)d_in[9], N.mod); }
    if (MK_UPTO < PH_END) {
        const int l0 = MK_UPTO < 2 ? 0 : (MK_UPTO - 2) / 4, s0 = MK_UPTO < 2 ? 0 : (MK_UPTO - 2) % 4;
        for (int b = 0; b < NB_P; ++b) {
            Trunk R{1, T_P, 0, 0, (const float*)d_in[0] + (size_t)b * T_P * DM, nullptr, nullptr, nullptr, nullptr, b,
                    out + O_YP + (size_t)b * T_P * DM, out + O_NKP + (size_t)b * 2048 * D_ATTN, out + O_NVP + (size_t)b * 2048 * D_ATTN, out + O_NPOOLP + (size_t)b * 15 * D_POOL, out + O_NCONVP + (size_t)b * 2 * D_CONV,
                    (size_t)NB_P * 2048 * D_ATTN, (size_t)NB_P * 15 * D_POOL, (size_t)NB_P * 2 * D_CONV, 2048};
            const float* xsrc = (l0 == 0) ? R.x_in : out + O_YP + (size_t)b * T_P * DM;
            (void)hipMemcpyAsync(N.xb, xsrc, (size_t)T_P * DM * sizeof(float), hipMemcpyDeviceToDevice, stream);
            const size_t ro = (size_t)b * T_P;
            if (l0 < DEPTH && (l0 % 2 == 0) && s0 == 1)
                k_adapt_g1e<<<T_P, 256, 0, stream>>>((const bf16_t*)((char*)d_ws + WS_QR) + ro * D_ATTN, (const bf16_t*)((char*)d_ws + WS_KR) + ro * D_ATTN, (const bf16_t*)((char*)d_ws + WS_VB) + ro * D_ATTN,
                                                      (const bf16_t*)((char*)d_ws + WS_GA) + ro * D_ATTN, (const bf16_t*)((char*)d_ws + WS_UB) + ro * D_ATTN, (const bf16_t*)((char*)d_ws + WS_GP) + ro * D_ATTN, N.proj);
            if (l0 < DEPTH && ((l0 % 2 == 0 && s0 == 3) || (l0 % 2 == 1 && s0 == 2)))
                k_bf2f<<<2048, 256, 0, stream>>>((const bf16_t*)((char*)d_ws + WS_MERGED) + ro * DM, N.merged, (size_t)T_P * DM);
            naive_run(R, N, d_in, l0, s0, true, stream);
        }
    }
    if (MK_UPTO < PH_END) {
        Trunk R{NB_S, T_S, PAST, WBUF, (const float*)d_in[1], (const float*)d_in[4], (const float*)d_in[5], (const float*)d_in[6], (const float*)d_in[7], 2,
                out + O_YS, out + O_NKS, out + O_NVS, out + O_NPOOLS, out + O_NCONVS, (size_t)NB_S * T_S * D_ATTN, (size_t)NB_S * 15 * D_POOL, (size_t)NB_S * 2 * D_CONV, T_S};
        (void)hipMemcpyAsync(N.xb, R.x_in, (size_t)MS * DM * sizeof(float), hipMemcpyDeviceToDevice, stream);
        naive_run(R, N, d_in, 0, 0, true, stream);
    }
}
```
